# Optimizing an MI355X kernel written in HIP

```python
import jax, jax.numpy as jnp
from jax import lax
import numpy as np

D_MODEL = 1024
BATCH = 8
SEQ = 4096
DEPTH = 4

D_MIX = D_MODEL
W_GROUP = D_MIX // 4
HEAD_DIM = 64
ROT_DIM = HEAD_DIM // 4
ROPE_THETA = 500000.0
Q_BLOCK = 128
EPS = 1e-6
DSA_HEADS = W_GROUP // HEAD_DIM
IDX_HEADS = 8
IDX_DIM = 32
IDX_ROT = IDX_DIM // 4
DSA_TOPK = 256
NSA_HEADS = W_GROUP // HEAD_DIM
CMP_LEN = 32
CMP_STRIDE = 16
SLC_BLOCK = 64
SLC_TOPN = 16
WINDOW = 512
CONV_WIDTH = 3
POOL_GROUPS = 4
POOL_WINDOWS = (2, 4, 8, 16)
POOL_CH = W_GROUP // POOL_GROUPS

IN_SPLITS = (
    ("a_q", DSA_HEADS * HEAD_DIM), ("a_k", HEAD_DIM), ("a_v", HEAD_DIM),
    ("a_qi", IDX_HEADS * IDX_DIM), ("a_ki", IDX_DIM), ("a_wi", IDX_HEADS), ("a_gate", W_GROUP),
    ("b_q", NSA_HEADS * HEAD_DIM), ("b_kc", HEAD_DIM), ("b_vc", HEAD_DIM), ("b_ks", HEAD_DIM),
    ("b_vs", HEAD_DIM), ("b_kw", HEAD_DIM), ("b_vw", HEAD_DIM), ("b_g", 3 * NSA_HEADS), ("b_gate", W_GROUP),
    ("c_b", W_GROUP), ("c_c", W_GROUP), ("c_x", W_GROUP), ("c_gate", W_GROUP),
    ("d_u", W_GROUP), ("d_gate", W_GROUP),
)
D_IN = sum(w for _, w in IN_SPLITS)

kernel_name = "hybrid_parallel_dsa_nsa_conv_pool"


def split_cols(z):
    offs = np.cumsum([w for _, w in IN_SPLITS])[:-1].tolist()
    return dict(zip([n for n, _ in IN_SPLITS], jnp.split(z, offs, axis=-1)))


def rmsnorm(x, g):
    xf = x.astype(jnp.float32)
    y = xf * lax.rsqrt(jnp.mean(xf * xf, axis=-1, keepdims=True) + EPS)
    return (y * g.astype(jnp.float32)).astype(x.dtype)


def rope(x, pos, rot):
    half = rot // 2
    inv = ROPE_THETA ** (-jnp.arange(half, dtype=jnp.float32) / half)
    ang = pos.astype(jnp.float32)[:, None] * inv[None, :]
    cos = jnp.cos(ang)[:, None, :].astype(x.dtype)
    sin = jnp.sin(ang)[:, None, :].astype(x.dtype)
    x1, x2, rest = x[..., :half], x[..., half:rot], x[..., rot:]
    return jnp.concatenate([x1 * cos - x2 * sin, x2 * cos + x1 * sin, rest], axis=-1)


def masked_softmax(s, valid):
    s = jnp.where(valid, s.astype(jnp.float32), -jnp.inf)
    m = jnp.max(s, axis=-1, keepdims=True)
    m = jnp.where(jnp.isfinite(m), m, 0.0)
    e = jnp.where(valid, jnp.exp(s - m), 0.0)
    return e / jnp.maximum(jnp.sum(e, axis=-1, keepdims=True), 1e-30)


take_rows = jax.vmap(lambda a, i: a[i])


def dsa_mixer(q, k, v, qi, ki, wi):
    B, T = q.shape[:2]
    topk = min(DSA_TOPK, T // 4)
    key_pos = jnp.arange(T)

    def block(i):
        q0 = i * Q_BLOCK
        t = q0 + jnp.arange(Q_BLOCK)
        qb = lax.dynamic_slice_in_dim(q, q0, Q_BLOCK, axis=1)
        qib = lax.dynamic_slice_in_dim(qi, q0, Q_BLOCK, axis=1)
        wib = lax.dynamic_slice_in_dim(wi, q0, Q_BLOCK, axis=1) * (IDX_HEADS ** -0.5)
        logits = jnp.einsum('bqhd,bsd->bqhs', qib, ki) * (IDX_DIM ** -0.5)
        score = jnp.einsum('bqhs,bqh->bqs', jax.nn.relu(logits), wib).astype(jnp.float32)
        causal = key_pos[None, :] <= t[:, None]
        score = jnp.where(causal[None], score, -jnp.inf)
        _, idx = lax.top_k(score, topk)
        k_sel = take_rows(k, idx)
        v_sel = take_rows(v, idx)
        s = jnp.einsum('bqhd,bqkd->bhqk', qb, k_sel) * (HEAD_DIM ** -0.5)
        valid = (idx <= t[None, :, None])[:, None]
        p = masked_softmax(s, valid).astype(v.dtype)
        return jnp.einsum('bhqk,bqkd->bqhd', p, v_sel)

    out = lax.map(block, jnp.arange(T // Q_BLOCK))
    return jnp.moveaxis(out, 0, 1).reshape(B, T, -1)


def nsa_mixer(q, kc_tok, vc_tok, ks, vs, kw, vw, gates, pe_cmp, w_cmp_k, w_cmp_v):
    B, T = q.shape[:2]
    dtype = q.dtype
    n_cmp = (T - CMP_LEN) // CMP_STRIDE + 1
    n_slc = T // SLC_BLOCK
    topn = min(SLC_TOPN, n_slc)
    scale = HEAD_DIM ** -0.5
    cmp_start = jnp.arange(n_cmp) * CMP_STRIDE
    cmp_end = cmp_start + CMP_LEN - 1
    cmp_idx = cmp_start[:, None] + jnp.arange(CMP_LEN)[None, :]

    def compress(tok, w):
        blocks = tok[:, cmp_idx] + pe_cmp
        return blocks.reshape(B, n_cmp, CMP_LEN * HEAD_DIM) @ w

    k_cmp = rope(compress(kc_tok, w_cmp_k)[:, :, None], cmp_end, ROT_DIM)[:, :, 0]
    v_cmp = compress(vc_tok, w_cmp_v)
    slc_start = jnp.arange(n_slc) * SLC_BLOCK
    overlap = ((cmp_start[:, None] < slc_start[None, :] + SLC_BLOCK)
               & (cmp_end[:, None] >= slc_start[None, :])).astype(jnp.float32)
    ks_blocks = ks.reshape(B, n_slc, SLC_BLOCK, HEAD_DIM)
    vs_blocks = vs.reshape(B, n_slc, SLC_BLOCK, HEAD_DIM)
    kw_pad = jnp.pad(kw, ((0, 0), (WINDOW, 0), (0, 0)))
    vw_pad = jnp.pad(vw, ((0, 0), (WINDOW, 0), (0, 0)))
    blk_ids = jnp.arange(n_slc)
    in_blk = jnp.arange(SLC_BLOCK)

    def block(i):
        q0 = i * Q_BLOCK
        t = q0 + jnp.arange(Q_BLOCK)
        qb = lax.dynamic_slice_in_dim(q, q0, Q_BLOCK, axis=1)
        gb = lax.dynamic_slice_in_dim(gates, q0, Q_BLOCK, axis=1)
        s_c = jnp.einsum('bqhd,bnd->bhqn', qb, k_cmp) * scale
        valid_c = (cmp_end[None, :] <= t[:, None])[None, None]
        p_c = masked_softmax(s_c, valid_c)
        o_c = jnp.einsum('bhqn,bnd->bqhd', p_c.astype(dtype), v_cmp)
        imp = jnp.einsum('bhqn,nj->bqj', p_c, overlap)
        blk_t = t // SLC_BLOCK
        forced = (blk_ids[None, :] == 0) | (blk_ids[None, :] == blk_t[:, None])
        admissible = blk_ids[None, :] <= blk_t[:, None]
        imp = jnp.where(forced, jnp.inf, jnp.where(admissible, imp, -jnp.inf))
        _, idx = lax.top_k(imp, topn)
        k_sel = take_rows(ks_blocks, idx).reshape(B, Q_BLOCK, topn * SLC_BLOCK, HEAD_DIM)
        v_sel = take_rows(vs_blocks, idx).reshape(B, Q_BLOCK, topn * SLC_BLOCK, HEAD_DIM)
        pos_sel = (idx[..., None] * SLC_BLOCK + in_blk).reshape(B, Q_BLOCK, topn * SLC_BLOCK)
        s_s = jnp.einsum('bqhd,bqkd->bhqk', qb, k_sel) * scale
        p_s = masked_softmax(s_s, (pos_sel <= t[None, :, None])[:, None]).astype(dtype)
        o_s = jnp.einsum('bhqk,bqkd->bqhd', p_s, v_sel)
        kwb = lax.dynamic_slice_in_dim(kw_pad, q0, Q_BLOCK + WINDOW, axis=1)
        vwb = lax.dynamic_slice_in_dim(vw_pad, q0, Q_BLOCK + WINDOW, axis=1)
        pos_w = q0 - WINDOW + jnp.arange(Q_BLOCK + WINDOW)
        valid_w = ((pos_w[None, :] >= 0) & (pos_w[None, :] <= t[:, None])
                   & (t[:, None] - pos_w[None, :] < WINDOW))
        s_w = jnp.einsum('bqhd,bkd->bhqk', qb, kwb) * scale
        p_w = masked_softmax(s_w, valid_w[None, None]).astype(dtype)
        o_w = jnp.einsum('bhqk,bkd->bqhd', p_w, vwb)
        g = jax.nn.sigmoid(gb.astype(jnp.float32)).astype(dtype)
        return g[..., 0:1] * o_c + g[..., 1:2] * o_s + g[..., 2:3] * o_w

    out = lax.map(block, jnp.arange(T // Q_BLOCK))
    return jnp.moveaxis(out, 0, 1).reshape(B, T, -1)


def shortconv_mixer(b_gate, c_gate, xc, conv_w):
    T = xc.shape[1]
    u = c_gate * xc
    up = jnp.pad(u, ((0, 0), (CONV_WIDTH - 1, 0), (0, 0)))
    y = up[:, 0:T] * conv_w[0]
    for j in range(1, CONV_WIDTH):
        y = y + up[:, j:j + T] * conv_w[j]
    return b_gate * y


def pool_mixer(u, pool_w, pool_scale):
    B, T, _ = u.shape
    ug = u.reshape(B, T, POOL_GROUPS, POOL_CH)
    cs = jnp.cumsum(ug.astype(jnp.float32), axis=1)
    cs = jnp.pad(cs, ((0, 0), (1, 0), (0, 0), (0, 0)))
    win = jnp.array(POOL_WINDOWS, dtype=jnp.int32)
    t = jnp.arange(T)
    start = jnp.maximum(t[:, None] + 1 - win[None, :], 0)
    lower = cs[:, start, jnp.arange(POOL_GROUPS)[None, :]]
    count = jnp.minimum(t[:, None] + 1, win[None, :]).astype(jnp.float32)
    mean = (cs[:, 1:] - lower) / count[None, :, :, None]
    pooled = (mean - ug.astype(jnp.float32)).astype(u.dtype)
    y = jnp.einsum('btgc,gcd->btgd', pooled, pool_w).reshape(B, T, W_GROUP)
    return y * pool_scale


def hybrid_layer(x, norm_w, w_in, w_out, conv_w, pe_cmp, w_cmp_k, w_cmp_v, pool_w, pool_scale):
    B, T, _ = x.shape
    pos = jnp.arange(T)
    h = rmsnorm(x, norm_w)
    p = split_cols(h @ w_in)
    heads = lambda a, n: a.reshape(B, T, n, -1)
    one_head_rope = lambda a, rot: rope(a[:, :, None], pos, rot)[:, :, 0]
    o_a = dsa_mixer(rope(heads(p['a_q'], DSA_HEADS), pos, ROT_DIM), one_head_rope(p['a_k'], ROT_DIM),
                    p['a_v'], rope(heads(p['a_qi'], IDX_HEADS), pos, IDX_ROT),
                    one_head_rope(p['a_ki'], IDX_ROT), p['a_wi'])
    o_b = nsa_mixer(rope(heads(p['b_q'], NSA_HEADS), pos, ROT_DIM), p['b_kc'], p['b_vc'],
                    one_head_rope(p['b_ks'], ROT_DIM), p['b_vs'],
                    one_head_rope(p['b_kw'], ROT_DIM), p['b_vw'],
                    heads(p['b_g'], NSA_HEADS), pe_cmp, w_cmp_k, w_cmp_v)
    o_c = shortconv_mixer(p['c_b'], p['c_c'], p['c_x'], conv_w)
    o_d = pool_mixer(p['d_u'], pool_w, pool_scale)
    mixed = jnp.concatenate([jax.nn.silu(p['a_gate']) * o_a, jax.nn.silu(p['b_gate']) * o_b,
                             jax.nn.silu(p['c_gate']) * o_c, jax.nn.silu(p['d_gate']) * o_d], axis=-1)
    return x + mixed @ w_out


def setup_inputs(seed: int = 0) -> dict:
    key = jax.random.key(seed)
    ks = jax.random.split(key, 11)
    f32 = jnp.float32
    x = jax.random.normal(ks[0], (BATCH, SEQ, D_MODEL), f32)
    norm_w = 1.0 + 0.1 * jax.random.normal(ks[1], (DEPTH, D_MODEL), f32)
    w_in = jax.random.normal(ks[2], (DEPTH, D_MODEL, D_IN), f32) * D_MODEL ** -0.5
    w_out = jax.random.normal(ks[3], (DEPTH, D_MIX, D_MODEL), f32) * D_MIX ** -0.5
    conv_w = jax.random.normal(ks[4], (DEPTH, CONV_WIDTH, W_GROUP), f32) * CONV_WIDTH ** -0.5
    pe_cmp = 0.02 * jax.random.normal(ks[5], (DEPTH, CMP_LEN, HEAD_DIM), f32)
    w_cmp_k = jax.random.normal(ks[6], (DEPTH, CMP_LEN * HEAD_DIM, HEAD_DIM), f32) * (CMP_LEN * HEAD_DIM) ** -0.5
    w_cmp_v = jax.random.normal(ks[7], (DEPTH, CMP_LEN * HEAD_DIM, HEAD_DIM), f32) * (CMP_LEN * HEAD_DIM) ** -0.5
    pool_w = jax.random.normal(ks[8], (DEPTH, POOL_GROUPS, POOL_CH, POOL_CH), f32) * POOL_CH ** -0.5
    pool_scale = 1.0 + 0.1 * jax.random.normal(ks[9], (DEPTH, W_GROUP), f32)
    final_norm_w = 1.0 + 0.1 * jax.random.normal(ks[10], (D_MODEL,), f32)
    return {"x": x, "norm_w": norm_w, "w_in": w_in, "w_out": w_out, "conv_w": conv_w,
            "pe_cmp": pe_cmp, "w_cmp_k": w_cmp_k, "w_cmp_v": w_cmp_v, "pool_w": pool_w,
            "pool_scale": pool_scale, "final_norm_w": final_norm_w}


def reference(x, norm_w, w_in, w_out, conv_w, pe_cmp, w_cmp_k, w_cmp_v, pool_w, pool_scale, final_norm_w):
    for l in range(DEPTH):
        x = hybrid_layer(x, norm_w[l], w_in[l], w_out[l], conv_w[l], pe_cmp[l],
                         w_cmp_k[l], w_cmp_v[l], pool_w[l], pool_scale[l])
    return rmsnorm(x, final_norm_w)
```

```cpp
#include <hip/hip_runtime.h>
#include <hip/hip_cooperative_groups.h>
#include <cstdio>
#include <cstdint>
namespace cg = cooperative_groups;

constexpr int BATCH = 8, SEQ = 4096, DM = 1024, DEPTH = 4, MROWS = BATCH * SEQ;
constexpr int D_IN = 3380, NZ = 3584;
constexpr int ZQA = 0, ZQI = 256, ZQB = 512, ZKA = 768, ZVA = 832, ZKS = 896, ZVS = 960, ZKW = 1024, ZVW = 1088, ZKC = 1152, ZVC = 1216,
              ZKI = 1280, ZWI = 1312, ZBG = 1320, ZGA = 1536, ZGB = 1792, ZCB = 2048, ZCC = 2304, ZCX = 2560, ZGC = 2816, ZDU = 3072, ZGD = 3328;
constexpr float C2 = 0.18033688011112042f;
constexpr int NPHASE = 2 + 4 * DEPTH;

constexpr size_t MiB = 1u << 20;
constexpr size_t WS_CTL = 0, CTL_BYTES = 64 * 1024;
constexpr size_t WS_WIT = 2 * MiB;
constexpr size_t WS_WOT = 30 * MiB;
constexpr size_t WS_WCT = 38 * MiB;
constexpr size_t WS_PWT = 40 * MiB;
constexpr size_t WS_CS = 40 * MiB + 256 * 1024;
constexpr size_t WS_KP = 41 * MiB;
constexpr size_t WS_RS = 42 * MiB;
constexpr size_t WS_WIF = 44 * MiB;
constexpr size_t WS_BGF = 45 * MiB;
constexpr size_t WS_KCMP = 47 * MiB;
constexpr size_t WS_VCMP = 47 * MiB + 512 * 1024;
constexpr size_t WS_XB = 48 * MiB;
constexpr size_t WS_Z = 112 * MiB;
constexpr size_t WS_MIXED = 336 * MiB;
constexpr size_t WS_MASK = 400 * MiB;
constexpr size_t WS_END = 416 * MiB;

constexpr int RING_BYTES = 131072;
constexpr int MISC_OFF = RING_BYTES;
constexpr int LDS_BYTES = 147456;
constexpr int L_K = 0, L_V = 32768, L_IMP = 65536, L_BM = MISC_OFF + 256;

typedef unsigned short bf16_t;
typedef short bf16x8 __attribute__((ext_vector_type(8)));
typedef short s16x4 __attribute__((ext_vector_type(4)));
typedef float f32x4 __attribute__((ext_vector_type(4)));
typedef float f32x2 __attribute__((ext_vector_type(2)));
typedef float f32x16 __attribute__((ext_vector_type(16)));
typedef unsigned u32x4 __attribute__((ext_vector_type(4)));
typedef unsigned u32x2 __attribute__((ext_vector_type(2)));
#define LAS __attribute__((address_space(3)))

__host__ __device__ __forceinline__ int perm64(int j) { return j < 16 ? ((j & ~12) | ((j & 4) << 1) | ((j & 8) >> 1)) : j; }
__host__ __device__ __forceinline__ int src_col(int p) {
    if (p < 256) return 0 + (p >> 6) * 64 + perm64(p & 63);
    if (p < 512) return 384 + (p - 256);
    if (p < 768) { const int q = p - 512; return 936 + (q >> 6) * 64 + perm64(q & 63); }
    if (p < 832) return 256 + perm64(p - 768);
    if (p < 896) return 320 + (p - 832);
    if (p < 960) return 1320 + perm64(p - 896);
    if (p < 1024) return 1384 + (p - 960);
    if (p < 1088) return 1448 + perm64(p - 1024);
    if (p < 1152) return 1512 + (p - 1088);
    if (p < 1216) return 1192 + (p - 1152);
    if (p < 1280) return 1256 + (p - 1216);
    if (p < 1312) return 640 + (p - 1280);
    if (p < 1320) return 672 + (p - 1312);
    if (p < 1332) return 1576 + (p - 1320);
    if (p < 1536) return -1;
    if (p < 1792) return 680 + (p - 1536);
    if (p < 2048) return 1588 + (p - 1792);
    if (p < 2304) return 1844 + (p - 2048);
    if (p < 2560) return 2100 + (p - 2304);
    if (p < 2816) return 2356 + (p - 2560);
    if (p < 3072) return 2612 + (p - 2816);
    if (p < 3328) return 2868 + (p - 3072);
    return 3124 + (p - 3328);
}
#define N_LAUNCH_MODE 0
namespace pg8 {
#define PG8_LAS __attribute__((address_space(3)))
typedef unsigned short bf16_t;
typedef short bf16x8 __attribute__((ext_vector_type(8)));
typedef float f32x4 __attribute__((ext_vector_type(4)));
typedef unsigned u32x4 __attribute__((ext_vector_type(4)));
constexpr int BM = 256, BK = 64, HALF = 128, HTB = HALF * BK * 2  , STAGE_BYTES = 8 * HTB, NXCD = 8, WGM = 8;

__host__ __device__ __forceinline__ int lds_byte(int r, int c) { const int st = (r >> 4) * 2 + (c >> 5), rr = r & 15, cc = c & 31, ob = rr * 64 + cc * 2; return st * 1024 + (ob ^ (((ob >> 9) & 1) << 5)); }
__host__ __device__ __forceinline__ void stage_rc(int b, int& R, int& C) { const int st = b / 1024, sb = b % 1024, swz = sb ^ (((sb >> 9) & 1) << 5); R = (st >> 1) * 16 + swz / 64; C = (st & 1) * 32 + (swz % 64) / 2; }
__host__ __device__ __forceinline__ int perm32(int rho) { const int n = rho >> 4, i = rho & 15; return 8 * (i >> 2) + 4 * n + (i & 3); }

struct Unit { int pm, pn; };
struct Gemm { const bf16_t* A; const bf16_t* Bt; int M, N, K; };

struct StaticOrder {
    int nM, nN, nwg, G, c;
    __host__ __device__ void init(int M, int N, int G_, int c_) { nM = M / BM; nN = N / BM; nwg = nM * nN; G = G_; c = c_; }
    __host__ __device__ bool next(int i, Unit& u) const {
        const long L = (long)i * G + c; if (L >= nwg) return false;
        int wgid = (int)L; { const int q = nwg / NXCD, r = nwg % NXCD, xcd = wgid % NXCD, off = wgid / NXCD; wgid = (xcd < r ? xcd * (q + 1) : r * (q + 1) + (xcd - r) * q) + off; }
        const int nig = WGM * nN, gid = wgid / nig, fm = gid * WGM, gsz = (nM - fm) < WGM ? (nM - fm) : WGM;
        u.pm = fm + ((wgid % nig) % gsz); u.pn = (wgid % nig) / gsz; return true;
    }
    __device__ __forceinline__ void a_ready(const Unit&) const {}
    __device__ __forceinline__ void done(const Unit&) const {}
};
}
namespace pg8 {
template <class Epi, class Sched, bool ALIGN_EPI = false, bool SP2 = false>
__device__ __forceinline__ void gemm_phase(PG8_LAS unsigned char* lds, const Gemm g, const Sched& S, const Epi& E, const int wave_s) {
    int lane_; asm volatile("v_mbcnt_lo_u32_b32 %0, -1, 0\n\tv_mbcnt_hi_u32_b32 %0, -1, %0" : "=v"(lane_));
    const int tid = wave_s * 64 + lane_, wid = wave_s, lane = lane_, wr = wid >> 2, wc = wid & 3, fr = lane & 15, fq = lane >> 4;
    const int K = g.K, nt = K / BK;
    unsigned voffA[2], voffB[2];
#pragma unroll
    for (int i = 0; i < 2; ++i) { int R, C; stage_rc(tid * 16 + i * 8192, R, C); const int Rb = Epi::PERM ? ((R & ~31) + perm32(R & 31)) : R;
        voffA[i] = (unsigned)(R * K + C) * 2u; voffB[i] = (unsigned)(Rb * K + C) * 2u; }
    const size_t kstep = (size_t)(BK * 2);
    const size_t hstep = (size_t)HALF * K * 2;
    const size_t tstep = 2 * hstep;
    const unsigned ldsw = (unsigned)wid * 1024u;
    const int aoff = lds_byte(wr * 64 + fr, fq * 8), boff = lds_byte(wc * 32 + fr, fq * 8);
#define PG8_SA(b, h) (((b) * 2 + (h)) * HTB)
#define PG8_SB(b, h) ((4 + (b) * 2 + (h)) * HTB)
#define PG8_STAGE(bufoff, gbase, voff) do { _Pragma("unroll") for (int _i = 0; _i < 2; ++_i) \
        __builtin_amdgcn_global_load_lds((const unsigned*)((const char*)(gbase) + (voff)[_i]), (PG8_LAS unsigned*)(lds + (bufoff) + ldsw + _i * 8192), 16, 0, 0); } while (0)
#define PG8_LDA(dst, b, h) do { _Pragma("unroll") for (int m = 0; m < 4; ++m) _Pragma("unroll") for (int k = 0; k < 2; ++k) dst[m][k] = *(const PG8_LAS bf16x8*)(lds + PG8_SA(b, h) + aoff + m * 2048 + k * 1024); } while (0)
#define PG8_LDB(dst, b, h) do { _Pragma("unroll") for (int n = 0; n < 2; ++n) _Pragma("unroll") for (int k = 0; k < 2; ++k) dst[n][k] = *(const PG8_LAS bf16x8*)(lds + PG8_SB(b, h) + boff + n * 2048 + k * 1024); } while (0)
#define PG8_MMA(ai, bj, At, Bt) do { __builtin_amdgcn_s_setprio(1); _Pragma("unroll") for (int m = 0; m < 4; ++m) _Pragma("unroll") for (int n = 0; n < 2; ++n) _Pragma("unroll") for (int k = 0; k < 2; ++k) \
        acc[ai][bj][m][n] = __builtin_amdgcn_mfma_f32_16x16x32_bf16(Bt[n][k], At[m][k], acc[ai][bj][m][n], 0, 0, 0); __builtin_amdgcn_s_setprio(0); } while (0)
#define PG8_WAIT_V(n) asm volatile("s_waitcnt vmcnt(" #n ")" ::: "memory")
#define PG8_WAIT_L(n) asm volatile("s_waitcnt lgkmcnt(" #n ")" ::: "memory")
#define PG8_BAR __builtin_amdgcn_s_barrier()
#define PG8_SCHED __builtin_amdgcn_sched_barrier(0)
    Unit cur, nxt; int ui = 0; int par_ = 0;
    if (!S.next(0, cur)) return;
    f32x4 acc[2][2][4][2];
    if constexpr (Epi::HAS_INIT) E.init(acc, cur, wr, wc, fr, fq);
    else {
#pragma unroll
    for (int a = 0; a < 2; ++a)
#pragma unroll
        for (int b = 0; b < 2; ++b)
#pragma unroll
            for (int m = 0; m < 4; ++m)
#pragma unroll
                for (int n = 0; n < 2; ++n) acc[a][b][m][n] = (f32x4){0.f, 0.f, 0.f, 0.f};
    }
    bf16x8 At[4][2], B0[2][2], B1[2][2];
    const char* cA = (const char*)g.A + (size_t)cur.pm * tstep; const char* cB = (const char*)g.Bt + (size_t)cur.pn * tstep;
    S.a_ready(cur);
    if constexpr (SP2) {
        PG8_STAGE(PG8_SB(0, 0), cB, voffB); PG8_STAGE(PG8_SB(0, 1), cB + hstep, voffB); PG8_STAGE(PG8_SA(0, 0), cA, voffA); PG8_STAGE(PG8_SA(0, 1), cA + hstep, voffA);
        if constexpr (Epi::HAS_ROWS) { typename Epi::Rows r0_ = E.rows_issue(cur, tid); E.rows_commit(r0_, tid, 0, true); }
        if (wr == 1) PG8_BAR;
        PG8_WAIT_V(2); PG8_BAR;
        PG8_STAGE(PG8_SB(1, 0), cB + kstep, voffB); PG8_STAGE(PG8_SA(1, 0), cA + kstep, voffA); PG8_STAGE(PG8_SB(1, 1), cB + hstep + kstep, voffB);
        PG8_WAIT_V(6); PG8_BAR;
    } else {
        PG8_STAGE(PG8_SB(0, 0), cB, voffB); PG8_STAGE(PG8_SA(0, 0), cA, voffA); PG8_STAGE(PG8_SB(0, 1), cB + hstep, voffB); PG8_STAGE(PG8_SA(0, 1), cA + hstep, voffA);
        if (wr == 1) PG8_BAR;
        PG8_WAIT_V(4); PG8_BAR;
        PG8_STAGE(PG8_SB(1, 0), cB + kstep, voffB); PG8_STAGE(PG8_SA(1, 0), cA + kstep, voffA); PG8_STAGE(PG8_SB(1, 1), cB + hstep + kstep, voffB);
        PG8_WAIT_V(6); PG8_BAR;
    }
    for (;;) {
        const bool has_next = S.next(ui + 1, nxt);
        const char* nA = has_next ? (const char*)g.A + (size_t)nxt.pm * tstep : cA; const char* nB = has_next ? (const char*)g.Bt + (size_t)nxt.pn * tstep : cB;
        for (int t = 0; t < nt; t += 2) {
            const bool last = (t == nt - 2);
            const char* a1 = cA + (size_t)(t + 1) * kstep;
            const char* a2 = last ? nA : cA + (size_t)(t + 2) * kstep; const char* b2 = last ? nB : cB + (size_t)(t + 2) * kstep;
            const char* a3 = a2 + kstep; const char* b3 = b2 + kstep;
            if (last && has_next) S.a_ready(nxt);
            if constexpr (SP2) {
            PG8_LDB(B0, 0, 0); PG8_LDB(B1, 0, 1); PG8_SCHED; PG8_LDA(At, 0, 0); PG8_STAGE(PG8_SA(1, 1), a1 + hstep, voffA);
            PG8_WAIT_V(8); PG8_WAIT_L(0); PG8_BAR; PG8_MMA(0, 0, At, B0); PG8_MMA(0, 1, At, B1); PG8_BAR; PG8_SCHED;
            PG8_LDA(At, 0, 1); PG8_STAGE(PG8_SB(0, 0), b2, voffB); PG8_STAGE(PG8_SB(0, 1), b2 + hstep, voffB); PG8_STAGE(PG8_SA(0, 0), a2, voffA);
            PG8_WAIT_V(8); PG8_WAIT_L(0); PG8_BAR; PG8_MMA(1, 0, At, B0); PG8_MMA(1, 1, At, B1); PG8_BAR; PG8_SCHED;
            PG8_LDB(B0, 1, 0); PG8_LDB(B1, 1, 1); PG8_SCHED; PG8_LDA(At, 1, 0); PG8_STAGE(PG8_SA(0, 1), a2 + hstep, voffA);
            PG8_WAIT_V(8); PG8_WAIT_L(0); PG8_BAR; PG8_MMA(0, 0, At, B0); PG8_MMA(0, 1, At, B1); PG8_BAR; PG8_SCHED;
            PG8_LDA(At, 1, 1); PG8_STAGE(PG8_SB(1, 0), b3, voffB); PG8_STAGE(PG8_SB(1, 1), b3 + hstep, voffB); PG8_STAGE(PG8_SA(1, 0), a3, voffA);
            PG8_WAIT_V(8); PG8_WAIT_L(0); PG8_BAR; PG8_MMA(1, 0, At, B0); PG8_MMA(1, 1, At, B1); PG8_BAR; PG8_SCHED;
            } else {
            PG8_LDB(B0, 0, 0); PG8_SCHED; PG8_LDA(At, 0, 0); PG8_STAGE(PG8_SA(1, 1), a1 + hstep, voffA);
            PG8_WAIT_L(8); PG8_BAR; PG8_WAIT_L(0); PG8_MMA(0, 0, At, B0); PG8_BAR; PG8_SCHED;
            PG8_LDB(B1, 0, 1); PG8_STAGE(PG8_SB(0, 0), b2, voffB);
            PG8_BAR; PG8_WAIT_L(0); PG8_MMA(0, 1, At, B1); PG8_BAR;
            PG8_LDA(At, 0, 1); PG8_STAGE(PG8_SA(0, 0), a2, voffA);
            PG8_BAR; PG8_WAIT_L(0); PG8_MMA(1, 0, At, B0); PG8_BAR; PG8_SCHED;
            PG8_STAGE(PG8_SB(0, 1), b2 + hstep, voffB);
            PG8_WAIT_V(6); PG8_BAR; PG8_MMA(1, 1, At, B1); PG8_BAR;
            PG8_LDB(B0, 1, 0); PG8_SCHED; PG8_LDA(At, 1, 0); PG8_STAGE(PG8_SA(0, 1), a2 + hstep, voffA);
            PG8_WAIT_L(8); PG8_BAR; PG8_WAIT_L(0); PG8_MMA(0, 0, At, B0); PG8_BAR; PG8_SCHED;
            PG8_LDB(B1, 1, 1); PG8_STAGE(PG8_SB(1, 0), b3, voffB);
            PG8_BAR; PG8_WAIT_L(0); PG8_MMA(0, 1, At, B1); PG8_BAR;
            PG8_LDA(At, 1, 1); PG8_STAGE(PG8_SA(1, 0), a3, voffA);
            PG8_BAR; PG8_WAIT_L(0); PG8_MMA(1, 0, At, B0); PG8_BAR; PG8_SCHED;
            PG8_STAGE(PG8_SB(1, 1), b3 + hstep, voffB);
            PG8_WAIT_V(6); PG8_BAR; PG8_MMA(1, 1, At, B1); PG8_BAR;
            }
        }
        if constexpr (ALIGN_EPI) { if (wr == 0) PG8_BAR; }
        if constexpr (Epi::HAS_ROWS) {
            typename Epi::Rows rn_ = E.rows_issue(has_next ? nxt : cur, tid);
            E.run(acc, cur, wr, wc, fr, fq, par_); S.done(cur);
            E.rows_commit(rn_, tid, par_ ^ 1, false); par_ ^= 1;
        } else
        if constexpr (!Epi::AFTER_DRAIN) { E(acc, cur, wr, wc, fr, fq); S.done(cur); }
        if (!has_next) break;
        if constexpr (Epi::HAS_INIT) E.init(acc, nxt, wr, wc, fr, fq);
        else {
#pragma unroll
        for (int a = 0; a < 2; ++a)
#pragma unroll
            for (int b = 0; b < 2; ++b)
#pragma unroll
                for (int m = 0; m < 4; ++m)
#pragma unroll
                    for (int n = 0; n < 2; ++n) acc[a][b][m][n] = (f32x4){0.f, 0.f, 0.f, 0.f};
        }
        cur = nxt; cA = nA; cB = nB; ++ui;
        if constexpr (ALIGN_EPI) { if (wr == 1) PG8_BAR; }
    }
    PG8_WAIT_V(0);
    if constexpr (!ALIGN_EPI) { if (wr == 0) PG8_BAR; }
    PG8_BAR;
    if constexpr (Epi::AFTER_DRAIN) { E.fused(acc, cur, wr, wc, fr, fq, lds, wid, lane); S.done(cur); }
#undef PG8_SA
#undef PG8_SB
#undef PG8_STAGE
#undef PG8_LDA
#undef PG8_LDB
#undef PG8_MMA
#undef PG8_WAIT_V
#undef PG8_WAIT_L
#undef PG8_BAR
#undef PG8_SCHED
}
}

__device__ __forceinline__ float bf2f(unsigned short h) { return __uint_as_float((unsigned)h << 16); }
typedef __bf16 bf16x2_t __attribute__((ext_vector_type(2)));
__device__ __forceinline__ unsigned cvtpk(float lo, float hi) { f32x2 v = {lo, hi}; bf16x2_t b = __builtin_convertvector(v, bf16x2_t); return __builtin_bit_cast(unsigned, b); }
__device__ __forceinline__ float fast_exp2(float x) { return __builtin_amdgcn_exp2f(x); }
__device__ __forceinline__ float fast_rcp(float x) { return __builtin_amdgcn_rcpf(x); }
__device__ __forceinline__ float sigmoidf_(float x) { return fast_rcp(1.f + fast_exp2(-1.4426950408889634f * x)); }
__device__ __forceinline__ float siluf_(float x) { return x * sigmoidf_(x); }
__device__ __forceinline__ int lane_id() { int l; asm volatile("v_mbcnt_lo_u32_b32 %0, -1, 0\n\tv_mbcnt_hi_u32_b32 %0, -1, %0" : "=v"(l)); return l; }
__device__ __forceinline__ float xhalf_(float v, int hi) {
    auto rr = __builtin_amdgcn_permlane32_swap(__float_as_uint(v), __float_as_uint(v), false, false);
    return hi ? __uint_as_float(rr[0]) : __uint_as_float(rr[1]);
}
#define xhalf(v) xhalf_((v), A.hi)
template <int CTRL> __device__ __forceinline__ int dpp_i(int v) { return __builtin_amdgcn_update_dpp(0, v, CTRL, 0xf, 0xf, true); }
template <int CTRL> __device__ __forceinline__ float dpp_f(float v) { return __int_as_float(__builtin_amdgcn_update_dpp(0, __float_as_int(v), CTRL, 0xf, 0xf, true)); }
__device__ __forceinline__ int sum32_i(int v) {
    v += dpp_i<0xB1>(v); v += dpp_i<0x4E>(v); v += dpp_i<0x141>(v); v += dpp_i<0x140>(v);
    const auto r = __builtin_amdgcn_permlane16_swap((unsigned)v, (unsigned)v, false, false);
    return (int)(r[0] + r[1]);
}
__device__ __forceinline__ float sum16x_f(float v) {
    const auto r = __builtin_amdgcn_permlane16_swap(__float_as_uint(v), __float_as_uint(v), false, false);
    return __uint_as_float(r[0]) + __uint_as_float(r[1]);
}
__device__ __forceinline__ float sum32x_f(float v) {
    const auto r = __builtin_amdgcn_permlane32_swap(__float_as_uint(v), __float_as_uint(v), false, false);
    return __uint_as_float(r[0]) + __uint_as_float(r[1]);
}
__device__ __forceinline__ float max16x_f(float v) {
    const auto r = __builtin_amdgcn_permlane16_swap(__float_as_uint(v), __float_as_uint(v), false, false);
    return fmaxf(__uint_as_float(r[0]), __uint_as_float(r[1]));
}
__device__ __forceinline__ float max32x_f(float v) {
    const auto r = __builtin_amdgcn_permlane32_swap(__float_as_uint(v), __float_as_uint(v), false, false);
    return fmaxf(__uint_as_float(r[0]), __uint_as_float(r[1]));
}
__device__ __forceinline__ float wave_sum_f(float v) {
    v += dpp_f<0xB1>(v); v += dpp_f<0x4E>(v); v += dpp_f<0x141>(v); v += dpp_f<0x140>(v);
    return sum32x_f(sum16x_f(v));
}
__device__ __forceinline__ void unpack8(bf16x8 v, float (&f)[8]) {
#pragma unroll
    for (int j = 0; j < 8; ++j) f[j] = bf2f((unsigned short)v[j]);
}

struct Params {
    const float* x; const float* norm_w; const float* w_in; const float* w_out; const float* conv_w; const float* pe_cmp;
    const float* w_cmp_k; const float* w_cmp_v; const float* pool_w; const float* pool_scale; const float* final_norm_w;
    float* out; unsigned char* ws; int ph_lo, ph_hi;
};

struct EpiIn {
    static constexpr bool PERM = true, AFTER_DRAIN = false, HAS_INIT = false, HAS_ROWS = true;
    bf16_t* Z; const float* RS; const f32x2* CS; float* WIF; float* BGF; unsigned char* lds;
    struct Rows { f32x4 rs; f32x2 cs; };
    __device__ __forceinline__ Rows rows_issue(const pg8::Unit& u, int tid) const {
        Rows r; r.rs = (f32x4){1.f, 1.f, 1.f, 1.f}; r.cs = (f32x2){1.f, 0.f};
        if (tid < 256) {
            r.rs = *(const f32x4*)(RS + (size_t)(u.pm * 256 + tid) * 4);
            const int rr = tid >> 3, t0 = (u.pm * 256 + (rr >> 4) * 64 + (rr & 15)) & (SEQ - 1);
            r.cs = CS[t0 * 8 + (tid & 7)];
        }
        return r;
    }
    __device__ __forceinline__ void rows_commit(const Rows& r, int tid, int par, bool first) const {
        LAS float* lrs = (LAS float*)((LAS unsigned char*)lds + MISC_OFF + 1024) + par * 256;
        LAS f32x2* lcs = (LAS f32x2*)((LAS unsigned char*)lds + MISC_OFF + 4096) + par * 256;
        if (tid < 256) {
            lrs[tid] = 1.0f / sqrtf(((r.rs[0] + r.rs[1]) + (r.rs[2] + r.rs[3])) * (1.0f / 1024.0f) + 1e-6f);
            lcs[tid] = r.cs;
        }
        if (first && tid < 8) ((LAS f32x2*)((LAS unsigned char*)lds + MISC_OFF + 3072))[tid] = CS[16 * 8 + tid];
    }
    __device__ __forceinline__ void run(const f32x4 (&acc)[2][2][4][2], const pg8::Unit& u, int wr, int wc, int fr, int fq, int par) const {
        const int pn = u.pn;
        float rrv[2][4];
        {
            const LAS float* lrs = (const LAS float*)((LAS unsigned char*)lds + MISC_OFF + 1024) + par * 256;
#pragma unroll
            for (int ai = 0; ai < 2; ++ai)
#pragma unroll
                for (int m = 0; m < 4; ++m) rrv[ai][m] = lrs[ai * 128 + wr * 64 + m * 16 + fr];
        }
        const int cl0 = wc * 32 + fq * 8, hp0 = cl0 & 63;
        bool rope0 = false, rope1 = false; int fb = 0, fs = 1;
        if (pn == 0 || pn == 2) { if (hp0 < 16) { rope0 = rope1 = true; fb = hp0 >> 1; } }
        else if (pn == 1) { if ((cl0 & 31) == 0) { rope0 = rope1 = true; fs = 2; } }
        else if (pn == 3) { if (((cl0 >> 6) & 1) == 0 && hp0 < 16) { rope0 = rope1 = true; fb = hp0 >> 1; } }
        else if (pn == 4) { if ((cl0 >> 6) == 0 && hp0 < 16) { rope0 = true; fb = hp0 >> 1; } }
        else if (pn == 5) { if (cl0 == 0) { rope0 = true; fs = 2; } }
        f32x2 csc[4], cst[4];
        if (rope0) {
            const LAS f32x2* lcs = (const LAS f32x2*)((LAS unsigned char*)lds + MISC_OFF + 4096) + par * 256 + (wr * 16 + fr) * 8;
            const LAS f32x2* lst = (const LAS f32x2*)((LAS unsigned char*)lds + MISC_OFF + 3072);
#pragma unroll
            for (int e = 0; e < 4; ++e) { csc[e] = lcs[fb + e * fs]; cst[e] = lst[fb + e * fs]; }
        }
#pragma unroll
        for (int aim = 0; aim < 4; ++aim) {
            const int ai = aim >> 1;
#pragma unroll
            for (int m2 = 0; m2 < 2; ++m2) {
                const int m = 2 * (aim & 1) + m2;
                const int row = u.pm * 256 + ai * 128 + wr * 64 + m * 16 + fr;
                const float rr = rrv[ai][m];
#pragma unroll
                for (int bj = 0; bj < 2; ++bj) {
                    float v[8];
#pragma unroll
                    for (int e = 0; e < 4; ++e) { v[e] = acc[ai][bj][m][0][e] * rr; v[4 + e] = acc[ai][bj][m][1][e] * rr; }
                    const int cl = bj * 128 + wc * 32 + fq * 8;
                    if (bj == 0 ? rope0 : rope1) {
#pragma unroll
                        for (int e = 0; e < 4; ++e) {
                            const f32x2 cs = csc[e];
                            const float x1 = v[e], x2 = v[4 + e];
                            v[e] = x1 * cs[0] - x2 * cs[1]; v[4 + e] = x2 * cs[0] + x1 * cs[1];
                        }
                    }
                    if (pn == 0 || pn == 2) {
#pragma unroll
                        for (int e = 0; e < 8; ++e) v[e] *= C2;
                    } else if (pn == 6 || pn == 7 || pn == 11 || pn == 13) {
#pragma unroll
                        for (int e = 0; e < 8; ++e) v[e] = siluf_(v[e]);
                    } else if (pn == 5) {
                        if (cl == 32) { *(f32x4*)(WIF + (size_t)row * 8) = (f32x4){v[0], v[1], v[2], v[3]}; *(f32x4*)(WIF + (size_t)row * 8 + 4) = (f32x4){v[4], v[5], v[6], v[7]}; }
                        else if (cl == 40) { *(f32x4*)(BGF + (size_t)row * 16) = (f32x4){sigmoidf_(v[0]), sigmoidf_(v[1]), sigmoidf_(v[2]), sigmoidf_(v[3])};
                                             *(f32x4*)(BGF + (size_t)row * 16 + 4) = (f32x4){sigmoidf_(v[4]), sigmoidf_(v[5]), sigmoidf_(v[6]), sigmoidf_(v[7])}; }
                        else if (cl == 48) { *(f32x4*)(BGF + (size_t)row * 16 + 8) = (f32x4){sigmoidf_(v[0]), sigmoidf_(v[1]), sigmoidf_(v[2]), sigmoidf_(v[3])}; }
                    }
                    u32x4 w; w[0] = cvtpk(v[0], v[1]); w[1] = cvtpk(v[2], v[3]); w[2] = cvtpk(v[4], v[5]); w[3] = cvtpk(v[6], v[7]);
                    *(u32x4*)(Z + (size_t)row * NZ + pn * 256 + cl) = w;
                }
                if (rope0 && !(ai == 1 && m == 3)) {
#pragma unroll
                    for (int st = 0; st < (m == 3 ? 5 : 1); ++st)
#pragma unroll
                        for (int e = 0; e < 4; ++e) { const float c = csc[e][0], sn = csc[e][1]; csc[e][0] = c * cst[e][0] - sn * cst[e][1]; csc[e][1] = sn * cst[e][0] + c * cst[e][1]; }
                }
            }
        }
    }
};

struct EpiOut {
    static constexpr bool PERM = true, AFTER_DRAIN = false, HAS_INIT = true, HAS_ROWS = false;
    bf16_t* XB; float* RS; unsigned char* lds;
    __device__ __forceinline__ void init(f32x4 (&acc)[2][2][4][2], const pg8::Unit& u, int wr, int wc, int fr, int fq) const {
        bf16x8 xold[2][4][2];
#pragma unroll
        for (int ai = 0; ai < 2; ++ai)
#pragma unroll
            for (int m = 0; m < 4; ++m)
#pragma unroll
                for (int bj = 0; bj < 2; ++bj) xold[ai][m][bj] = *(const bf16x8*)(XB + (size_t)(u.pm * 256 + ai * 128 + wr * 64 + m * 16 + fr) * DM + u.pn * 256 + bj * 128 + wc * 32 + fq * 8);
#pragma unroll
        for (int ai = 0; ai < 2; ++ai)
#pragma unroll
            for (int m = 0; m < 4; ++m)
#pragma unroll
                for (int bj = 0; bj < 2; ++bj) {
                    float xo[8]; unpack8(xold[ai][m][bj], xo);
                    acc[ai][bj][m][0] = (f32x4){xo[0], xo[1], xo[2], xo[3]}; acc[ai][bj][m][1] = (f32x4){xo[4], xo[5], xo[6], xo[7]};
                }
    }
    __device__ __forceinline__ void operator()(const f32x4 (&acc)[2][2][4][2], const pg8::Unit& u, int wr, int wc, int fr, int fq) const {
        LAS float* part = (LAS float*)((LAS unsigned char*)lds + MISC_OFF + 1024);
#pragma unroll
        for (int aim = 0; aim < 4; ++aim) {
            const int ai = aim >> 1;
#pragma unroll
            for (int m2 = 0; m2 < 2; ++m2) {
                const int m = 2 * (aim & 1) + m2;
                const int rt = ai * 128 + wr * 64 + m * 16 + fr, row = u.pm * 256 + rt;
                float ssq = 0.f;
#pragma unroll
                for (int bj = 0; bj < 2; ++bj) {
                    const int col = u.pn * 256 + bj * 128 + wc * 32 + fq * 8;
                    const size_t off = (size_t)row * DM + col;
                    u32x4 w;
                    w[0] = cvtpk(acc[ai][bj][m][0][0], acc[ai][bj][m][0][1]); w[1] = cvtpk(acc[ai][bj][m][0][2], acc[ai][bj][m][0][3]);
                    w[2] = cvtpk(acc[ai][bj][m][1][0], acc[ai][bj][m][1][1]); w[3] = cvtpk(acc[ai][bj][m][1][2], acc[ai][bj][m][1][3]);
                    *(u32x4*)(XB + off) = w;
                    float xr[8]; unpack8(__builtin_bit_cast(bf16x8, w), xr);
#pragma unroll
                    for (int e = 0; e < 8; ++e) ssq = fmaf(xr[e], xr[e], ssq);
                }
                ssq = sum32x_f(sum16x_f(ssq));
                if (fq == 0) part[rt * 4 + wc] = ssq;
            }
            asm volatile("" ::: "memory");
        }
        __syncthreads();
        const int tid = (wr * 4 + wc) * 64 + fq * 16 + fr;
        if (tid < 256) { const f32x4 p4 = *(const LAS f32x4*)(part + tid * 4); RS[(size_t)(u.pm * 256 + tid) * 4 + u.pn] = (p4[0] + p4[1]) + (p4[2] + p4[3]); }
    }
};

struct Frame {
    unsigned char* lds; int wave, G;
    unsigned char* ws;
    __device__ __forceinline__ int lane_() const { return lane_id(); }
    __device__ __forceinline__ int tid_() const { return wave * 64 + lane_id(); }
    __device__ __forceinline__ unsigned* ctl_() const { return (unsigned*)(ws + WS_CTL); }
    __device__ __forceinline__ bf16_t* WIT_() const { return (bf16_t*)(ws + WS_WIT); }
    __device__ __forceinline__ bf16_t* WOT_() const { return (bf16_t*)(ws + WS_WOT); }
    __device__ __forceinline__ bf16_t* WCT_() const { return (bf16_t*)(ws + WS_WCT); }
    __device__ __forceinline__ bf16_t* PWT_() const { return (bf16_t*)(ws + WS_PWT); }
    __device__ __forceinline__ bf16_t* KCMP_() const { return (bf16_t*)(ws + WS_KCMP); }
    __device__ __forceinline__ bf16_t* VCMP_() const { return (bf16_t*)(ws + WS_VCMP); }
    __device__ __forceinline__ bf16_t* XB_() const { return (bf16_t*)(ws + WS_XB); }
    __device__ __forceinline__ bf16_t* Z_() const { return (bf16_t*)(ws + WS_Z); }
    __device__ __forceinline__ bf16_t* MIXED_() const { return (bf16_t*)(ws + WS_MIXED); }
    __device__ __forceinline__ f32x2* CS_() const { return (f32x2*)(ws + WS_CS); }
    __device__ __forceinline__ float* RS_() const { return (float*)(ws + WS_RS); }
    __device__ __forceinline__ float* WIF_() const { return (float*)(ws + WS_WIF); }
    __device__ __forceinline__ float* BGF_() const { return (float*)(ws + WS_BGF); }
    __device__ __forceinline__ unsigned* MASK_() const { return (unsigned*)(ws + WS_MASK); }
    __device__ __forceinline__ float* KP_() const { return (float*)(ws + WS_KP); }
    __device__ __forceinline__ unsigned* KMAX_() const { return (unsigned*)(ws + WS_CTL) + 8192; }
};

__device__ __forceinline__ int next_item(Frame& F, int q) {
    volatile unsigned* slot = (volatile unsigned*)(F.lds + MISC_OFF);
    __syncthreads();
    if (F.tid_() == 0) slot[0] = atomicAdd(F.ctl_() + 64 * q, 1u);
    __syncthreads();
    return __builtin_amdgcn_readfirstlane((int)slot[0]);
}
__device__ __forceinline__ unsigned xcc_id() { return (unsigned)__builtin_amdgcn_s_getreg((3 << 11) | 20) & 0xFu; }
__device__ __forceinline__ bool next_item_batch(Frame& F, int qfirst, int nitems, int& b, int& it) {
    const int home = (int)(xcc_id() & 7u);
    { const int v = next_item(F, qfirst + home); if (v < nitems) { b = home; it = v; return true; } }
    volatile unsigned* slot = (volatile unsigned*)(F.lds + MISC_OFF);
    for (;;) {
        __syncthreads();
        if (F.wave == 0) {
            const int l = F.lane_();
            unsigned c = 0xffffffffu;
            if (l < 8) c = __hip_atomic_load(F.ctl_() + 64 * (qfirst + l), __ATOMIC_RELAXED, __HIP_MEMORY_SCOPE_AGENT);
            const unsigned long long m = __ballot(c < (unsigned)nitems);
            if (l == 0) slot[1] = (unsigned)m;
        }
        __syncthreads();
        const unsigned mask = (unsigned)__builtin_amdgcn_readfirstlane((int)slot[1]) & 0xffu;
        if (mask == 0u) return false;
        const unsigned rot = ((mask >> home) | (mask << (8 - home))) & 0xffu;
        const int bq = (home + __builtin_ctz(rot)) & 7;
        const int v = next_item(F, qfirst + bq);
        if (v < nitems) { b = bq; it = v; return true; }
    }
}

template <int MAP>
__device__ __forceinline__ void transpose_item(const float* W, int K, int Nsrc, bf16_t* WT, int nblk, const float* kscale, float* scr, int item, int lane) {
    const int kb = item / nblk, nb = item % nblk, k0 = 64 * kb, n0 = 32 * nb;
    int sc = n0 + (lane & 31);
    if (MAP == 1) sc = src_col(sc);
    float vv[32], ks_[32];
    const int scc = sc >= 0 ? sc : 0;
#pragma unroll
    for (int i = 0; i < 32; ++i) { const int kk = 2 * i + (lane >> 5); vv[i] = W[(size_t)(k0 + kk) * Nsrc + scc]; ks_[i] = kscale ? kscale[k0 + kk] : 1.f; }
#pragma unroll
    for (int i = 0; i < 32; ++i) { const int kk = 2 * i + (lane >> 5); scr[kk * 33 + (lane & 31)] = (sc >= 0) ? vv[i] * ks_[i] : 0.f; }
    asm volatile("s_waitcnt lgkmcnt(0)" ::: "memory");
    const int c = lane & 7;
#pragma unroll
    for (int j = 0; j < 4; ++j) {
        const int n = (lane >> 3) + 8 * j; const float* s = scr + (8 * c) * 33 + n;
        u32x4 o; o[0] = cvtpk(s[0 * 33], s[1 * 33]); o[1] = cvtpk(s[2 * 33], s[3 * 33]); o[2] = cvtpk(s[4 * 33], s[5 * 33]); o[3] = cvtpk(s[6 * 33], s[7 * 33]);
        *(u32x4*)(WT + (size_t)(n0 + n) * K + k0 + 8 * c) = o;
    }
    asm volatile("s_waitcnt lgkmcnt(0)" ::: "memory");
}

__device__ __forceinline__ void sincos_d(double x, float& c, float& s) {
    const double TWO_OVER_PI = 0.63661977236758134308, PIO2_HI = 1.57079632679489655800e+00, PIO2_LO = 6.12323399573676603587e-17;
    const double kd = __builtin_rint(x * TWO_OVER_PI);
    const double r = (x - kd * PIO2_HI) - kd * PIO2_LO;
    const double r2 = r * r;
    double sp = -1.0 / 1307674368000.0;
    sp = sp * r2 + 1.0 / 6227020800.0;
    sp = sp * r2 - 1.0 / 39916800.0;
    sp = sp * r2 + 1.0 / 362880.0;
    sp = sp * r2 - 1.0 / 5040.0;
    sp = sp * r2 + 1.0 / 120.0;
    sp = sp * r2 - 1.0 / 6.0;
    const double sn = r + r * r2 * sp;
    double cp = 1.0 / 20922789888000.0;
    cp = cp * r2 - 1.0 / 87178291200.0;
    cp = cp * r2 + 1.0 / 479001600.0;
    cp = cp * r2 - 1.0 / 3628800.0;
    cp = cp * r2 + 1.0 / 40320.0;
    cp = cp * r2 - 1.0 / 720.0;
    cp = cp * r2 + 1.0 / 24.0;
    cp = cp * r2 - 0.5;
    const double cn = 1.0 + r2 * cp;
    const int q = ((int)kd) & 3;
    const double cc = (q == 0) ? cn : (q == 1) ? -sn : (q == 2) ? -cn : sn;
    const double ss = (q == 0) ? sn : (q == 1) ? cn : (q == 2) ? -sn : -cn;
    c = (float)cc; s = (float)ss;
}

__device__ __forceinline__ void phase_prologue(Frame& F, const Params& P) {
    float* scr = (float*)(F.lds + F.wave * 16384);
    const int gw = blockIdx.x * 8 + F.wave, NGW = F.G * 8;
    constexpr int I_IN = 16 * 112, I_OUT = 16 * 32, I_CMP = 32 * 2, I_POOL = 1 * 2;
    constexpr int N_IN = DEPTH * I_IN, N_OUT = DEPTH * I_OUT, N_CMP = DEPTH * 2 * I_CMP, N_POOL = DEPTH * 4 * I_POOL;
    for (int it = gw; it < N_IN + N_OUT + N_CMP + N_POOL; it += NGW) {
        int r = it;
        if (r < N_IN) { const int l = r / I_IN; transpose_item<1>(P.w_in + (size_t)l * DM * D_IN, DM, D_IN, F.WIT_() + (size_t)l * NZ * DM, 112, P.norm_w + l * DM, scr, r % I_IN, F.lane_()); continue; }
        r -= N_IN;
        if (r < N_OUT) { const int l = r / I_OUT; transpose_item<0>(P.w_out + (size_t)l * DM * DM, DM, DM, F.WOT_() + (size_t)l * DM * DM, 32, nullptr, scr, r % I_OUT, F.lane_()); continue; }
        r -= N_OUT;
        if (r < N_CMP) { const int lk = r / I_CMP, l = lk >> 1, kv = lk & 1; const float* W = (kv ? P.w_cmp_v : P.w_cmp_k) + (size_t)l * 2048 * 64;
            transpose_item<0>(W, 2048, 64, F.WCT_() + (size_t)lk * 64 * 2048, 2, nullptr, scr, r % I_CMP, F.lane_()); continue; }
        r -= N_CMP;
        { const int lg = r / I_POOL; transpose_item<0>(P.pool_w + (size_t)lg * 64 * 64, 64, 64, F.PWT_() + (size_t)lg * 64 * 64, 2, nullptr, scr, r % I_POOL, F.lane_()); }
    }
    {
        const float inv[8] = {1.000000000e+00f, 1.939227432e-01f, 3.760603070e-02f, 7.292664610e-03f, 1.414213562e-03f, 2.742481884e-04f, 5.318296098e-05f, 1.031338616e-05f};
        for (int i = blockIdx.x * 512 + F.tid_(); i < SEQ * 8; i += F.G * 512) {
            const int t = i >> 3, f = i & 7;
            float iv = inv[0];
#pragma unroll
            for (int k = 1; k < 8; ++k) iv = (f == k) ? inv[k] : iv;
            const float ang = (float)t * iv;
            float c, s; sincos_d((double)ang, c, s);
            F.CS_()[i] = (f32x2){c, s};
        }
    }
    for (int row0 = gw * 4; row0 < MROWS; row0 += NGW * 4) {
        f32x4 v[4][4];
#pragma unroll
        for (int r = 0; r < 4; ++r) { const f32x4* xr = (const f32x4*)(P.x + (size_t)(row0 + r) * DM) + F.lane_();
#pragma unroll
            for (int j = 0; j < 4; ++j) v[r][j] = xr[64 * j]; }
#pragma unroll
        for (int r = 0; r < 4; ++r) {
            u32x2* o8 = (u32x2*)(F.XB_() + (size_t)(row0 + r) * DM) + F.lane_();
            float s = 0.f;
#pragma unroll
            for (int j = 0; j < 4; ++j) {
                u32x2 w; w[0] = cvtpk(v[r][j][0], v[r][j][1]); w[1] = cvtpk(v[r][j][2], v[r][j][3]); o8[64 * j] = w;
                const float a0 = __uint_as_float(w[0] << 16), a1 = __uint_as_float(w[0] & 0xffff0000u), a2 = __uint_as_float(w[1] << 16), a3 = __uint_as_float(w[1] & 0xffff0000u);
                s += (a0 * a0 + a1 * a1) + (a2 * a2 + a3 * a3);
            }
            s = wave_sum_f(s);
            if (F.lane_() < 4) F.RS_()[(size_t)(row0 + r) * 4 + F.lane_()] = (F.lane_() == 0) ? s : 0.f;
        }
    }
}

__device__ __forceinline__ void compress_item(Frame& F, const Params& P, int layer, int bitem) {
    const int witem = bitem;
    const int kv = witem & 1, ng = (witem >> 1) & 15, b = witem >> 5;
    int tid_ = F.tid_(); asm volatile("" : "+v"(tid_));
    const int lane = tid_ & 63, c = lane & 15, G = lane >> 4;
    const int n = 16 * ng + c, nc = n > 254 ? 254 : n;
    const bf16_t* zrow = F.Z_() + ((size_t)b * SEQ + 16 * nc) * NZ + (kv ? ZVC : ZKC) + 8 * G;
    const float* pe = P.pe_cmp + (size_t)layer * 32 * 64 + 8 * G;
    const bf16_t* wt = F.WCT_() + (size_t)(layer * 2 + kv) * 64 * 2048 + (size_t)c * 2048 + 8 * G;
    f32x4 acc[4];
#pragma unroll
    for (int nt = 0; nt < 4; ++nt) acc[nt] = (f32x4){0.f, 0.f, 0.f, 0.f};
#pragma unroll
    for (int kk = 0; kk < 8; ++kk) {
        const int ks = 8 * F.wave + kk;
        const int i = ks >> 1, d0 = 32 * (ks & 1);
        const bf16x8 zr = *(const bf16x8*)(zrow + (size_t)i * NZ + d0);
        const f32x4 p0 = *(const f32x4*)(pe + i * 64 + d0), p1 = *(const f32x4*)(pe + i * 64 + d0 + 4);
        float f[8]; unpack8(zr, f);
        u32x4 aw; aw[0] = cvtpk(f[0] + p0[0], f[1] + p0[1]); aw[1] = cvtpk(f[2] + p0[2], f[3] + p0[3]); aw[2] = cvtpk(f[4] + p1[0], f[5] + p1[1]); aw[3] = cvtpk(f[6] + p1[2], f[7] + p1[3]);
        const bf16x8 af = __builtin_bit_cast(bf16x8, aw);
#pragma unroll
        for (int nt = 0; nt < 4; ++nt) {
            const bf16x8 bf = *(const bf16x8*)(wt + (size_t)nt * 16 * 2048 + ks * 32);
            acc[nt] = __builtin_amdgcn_mfma_f32_16x16x32_bf16(af, bf, acc[nt], 0, 0, 0);
        }
    }
    {
        LAS float* red = (LAS float*)((LAS unsigned char*)F.lds) + F.wave * 1024 + lane;
#pragma unroll
        for (int nt = 0; nt < 4; ++nt)
#pragma unroll
            for (int e = 0; e < 4; ++e) red[(nt * 4 + e) * 64] = acc[nt][e];
    }
    __syncthreads();
    if (__builtin_amdgcn_readfirstlane(F.wave) == 0) {
    {
        const LAS float* red = (const LAS float*)((LAS unsigned char*)F.lds) + lane;
#pragma unroll
        for (int nt = 0; nt < 4; ++nt)
#pragma unroll
            for (int e = 0; e < 4; ++e) {
                float sacc = red[(nt * 4 + e) * 64];
#pragma unroll
                for (int w = 1; w < 8; ++w) sacc += red[w * 1024 + (nt * 4 + e) * 64];
                acc[nt][e] = sacc;
            }
    }
    bf16_t* dst = (kv ? F.VCMP_() : F.KCMP_()) + (size_t)b * 256 * 64;
#pragma unroll
    for (int nt = 0; nt < 4; ++nt)
#pragma unroll
        for (int e = 0; e < 4; ++e) {
            const int nn = 16 * ng + 4 * G + e;
            float v = acc[nt][e];
            int dcol = 16 * nt + c;
            if (kv == 0) {
                if (nt == 0) {
                    const float partner = dpp_f<0x128>(v);
                    const int tpos = 16 * nn + 31;
                    const f32x2 cs = F.CS_()[(tpos & (SEQ - 1)) * 8 + (c & 7)];
                    v = (c < 8) ? (v * cs[0] - partner * cs[1]) : (v * cs[0] + partner * cs[1]);
                }
                dcol = perm64(dcol);
            }
            if (nn > 254) v = 0.f;
            dst[(size_t)nn * 64 + dcol] = (bf16_t)(cvtpk(v, 0.f) & 0xffffu);
        }
    }
}

__device__ __forceinline__ void select_item(Frame& F, int b, int qg) {
    int tid_ = F.tid_(); asm volatile("" : "+v"(tid_));
    const int lane = tid_ & 63, half = lane >> 5, idx = lane & 31, c = lane & 15, G = lane >> 4;
    const int tA = qg * 16 + F.wave * 2, tq = tA + half;
    const size_t rowbase = (size_t)b * SEQ;
#if defined(ABL_SC2)
    const bf16x8 afrag = (bf16x8){(short)0x3f80, (short)0xbf80, (short)0x3f00, (short)0x3f80, (short)0x4000, (short)0xbf00, (short)0x3f80, (short)0x3e80};
#else
    const bf16x8 afrag = *(const bf16x8*)(F.Z_() + (rowbase + tA + (c >> 3)) * NZ + ZQI + (c & 7) * 32 + G * 8);
#endif
#if !(defined(ABL_SC1))
    s16x4 wX, wY;
    {
        const int wrow = c, kg = G;
        const f32x4 wv = *(const f32x4*)(F.WIF_() + (rowbase + tA + (kg >> 1)) * 8 + 4 * (kg & 1));
        const unsigned p01 = cvtpk(wv[0], wv[1]), p23 = cvtpk(wv[2], wv[3]);
        const bool onX = (wrow == 8 * (kg >> 1)), onY = (wrow == 8 * (kg >> 1) + 4);
        const unsigned x01 = onX ? p01 : 0u, x23 = onX ? p23 : 0u, y01 = onY ? p01 : 0u, y23 = onY ? p23 : 0u;
        wX = __builtin_bit_cast(s16x4, (u32x2){x01, x23}); wY = __builtin_bit_cast(s16x4, (u32x2){y01, y23});
    }
    const bf16x8 wXY = (bf16x8){wX[0], wX[1], wX[2], wX[3], wY[0], wY[1], wY[2], wY[3]};
#endif
#if defined(ABL_SC1)
    const f32x4 w4 = (f32x4){1.f, 0.5f, -0.25f, 2.f};
#endif
    const int nchunks = ((qg * 16) >> 8) + 1;
    constexpr int SEL_NBUF = 6, SEL_D = 4;
    LAS unsigned char* kl = (LAS unsigned char*)F.lds;
    const unsigned char* zb = (const unsigned char*)F.Z_();
    const int pk0 = 32 * F.wave + (lane >> 2);
#define SEL_G(k_) ((0x78u >> (2 * (k_))) & 3u)
    const int pG = (lane & 3) ^ (int)SEL_G((lane >> 4) & 3);
    unsigned soff = (unsigned)(((rowbase + pk0) * NZ + ZKI + pG * 8) * 2);
    const unsigned rbase = c * 64 + ((G ^ SEL_G((c >> 2) & 3)) << 4);
#undef SEL_G
    const int nch1 = nchunks - 1;
#define SEL_DMA(chunk_) do { const int cc_ = (chunk_) < nch1 ? (chunk_) : nch1; const unsigned so_ = soff + (unsigned)cc_ * (256u * NZ * 2u); \
        LAS unsigned char* dst_ = kl + ((chunk_) % SEL_NBUF) * 16384 + F.wave * 2048; \
        __builtin_amdgcn_global_load_lds((const unsigned*)(zb + so_), (LAS unsigned*)dst_, 16, 0, 0); \
        __builtin_amdgcn_global_load_lds((const unsigned*)(zb + so_ + 16u * NZ * 2u), (LAS unsigned*)(dst_ + 1024), 16, 0, 0); } while (0)
#pragma unroll
    for (int i = 0; i < SEL_D; ++i) SEL_DMA(i);
    unsigned u[128];
#pragma unroll
    for (int ch = 0; ch < 16; ++ch) {
        if (ch < nchunks) {
            SEL_DMA(ch + SEL_D);
            asm volatile("s_waitcnt vmcnt(%0)" :: "n"(2 * SEL_D) : "memory");
            __builtin_amdgcn_s_barrier();
            asm volatile("" ::: "memory");
            const LAS unsigned char* kb = kl + (ch % SEL_NBUF) * 16384 + rbase;
            typedef short s16x2_ __attribute__((ext_vector_type(2)));
            const s16x2_ z2 = (s16x2_){0, 0};
            bf16x8 kfr[3][2]; f32x4 xq[2], yq[2], scq[2];
            kfr[0][0] = *(const LAS bf16x8*)(kb); kfr[0][1] = *(const LAS bf16x8*)(kb + 1024);
            kfr[1][0] = *(const LAS bf16x8*)(kb + 2048); kfr[1][1] = *(const LAS bf16x8*)(kb + 3072);
#pragma unroll
            for (int t = 0; t < 10; ++t) {
                if (t + 2 < 8) { kfr[(t + 2) % 3][0] = *(const LAS bf16x8*)(kb + (2 * t + 4) * 1024); kfr[(t + 2) % 3][1] = *(const LAS bf16x8*)(kb + (2 * t + 5) * 1024); }
                if (t < 8) {
                    xq[t & 1] = __builtin_amdgcn_mfma_f32_16x16x32_bf16(afrag, kfr[t % 3][0], (f32x4){0.f, 0.f, 0.f, 0.f}, 0, 0, 0);
                    yq[t & 1] = __builtin_amdgcn_mfma_f32_16x16x32_bf16(afrag, kfr[t % 3][1], (f32x4){0.f, 0.f, 0.f, 0.f}, 0, 0, 0);
                }
                __builtin_amdgcn_sched_barrier(0);
                if (t >= 1 && t <= 8) {
                    const f32x4 x = xq[(t - 1) & 1], y = yq[(t - 1) & 1];
                    const unsigned bx0 = __builtin_bit_cast(unsigned, __builtin_elementwise_max(__builtin_bit_cast(s16x2_, cvtpk(x[0], x[1])), z2));
                    const unsigned bx1 = __builtin_bit_cast(unsigned, __builtin_elementwise_max(__builtin_bit_cast(s16x2_, cvtpk(x[2], x[3])), z2));
                    const unsigned by0 = __builtin_bit_cast(unsigned, __builtin_elementwise_max(__builtin_bit_cast(s16x2_, cvtpk(y[0], y[1])), z2));
                    const unsigned by1 = __builtin_bit_cast(unsigned, __builtin_elementwise_max(__builtin_bit_cast(s16x2_, cvtpk(y[2], y[3])), z2));
                    scq[(t - 1) & 1] = __builtin_amdgcn_mfma_f32_16x16x32_bf16(wXY, __builtin_bit_cast(bf16x8, (u32x4){bx0, bx1, by0, by1}), (f32x4){0.f, 0.f, 0.f, 0.f}, 0, 0, 0);
                }
                if (t >= 2) {
                    const int j = ch * 8 + t - 2;
                    const unsigned bits = __float_as_uint(scq[(t - 2) & 1][0]);
                    const unsigned ku = bits ^ ((unsigned)((int)bits >> 31) | 0x80000000u);
                    u[j] = ((32 * j + idx) <= tq) ? ku : 0u;
                }
                __builtin_amdgcn_sched_barrier(0);
            }
        } else {
#pragma unroll
            for (int jj = 0; jj < 8; ++jj) u[ch * 8 + jj] = 0u;
        }
    }
#undef SEL_DMA
    asm volatile("s_waitcnt vmcnt(0)" ::: "memory");
    unsigned myw[4] = {0u, 0u, 0u, 0u};
    if (qg < 16) {
#pragma unroll
        for (int jj = 0; jj < 8; ++jj) {
            const unsigned long long bal = __ballot(u[jj] != 0u);
            asm volatile("s_nop 1\n\tv_writelane_b32 %0, %1, %2" : "+v"(myw[0]) : "s"((unsigned)bal), "n"(jj));
            asm volatile("s_nop 1\n\tv_writelane_b32 %0, %1, %2" : "+v"(myw[0]) : "s"((unsigned)(bal >> 32)), "n"(32 + jj));
        }
    } else {
        const int nw = (nchunks + 3) >> 2;
#pragma unroll
        for (int w = 0; w < 4; ++w) {
            if (w < nw) {
#define TR_STAGE(J, M) _Pragma("unroll") for (int k = 0; k < 32; ++k) { if ((k & (J)) == 0) { \
                    const unsigned t_ = ((u[32 * w + k] >> (J)) ^ u[32 * w + k + (J)]) & (M); u[32 * w + k + (J)] ^= t_; u[32 * w + k] ^= (t_ << (J)); } }
#define TR_PERM(J, SA, SB) _Pragma("unroll") for (int k = 0; k < 32; ++k) { if ((k & (J)) == 0) { \
                    const unsigned a_ = u[32 * w + k], b_ = u[32 * w + k + (J)]; u[32 * w + k] = __builtin_amdgcn_perm(b_, a_, (SA)); u[32 * w + k + (J)] = __builtin_amdgcn_perm(b_, a_, (SB)); } }
                TR_PERM(16, 0x05040100u, 0x07060302u) TR_PERM(8, 0x06020400u, 0x07030501u) TR_STAGE(4, 0x0f0f0f0fu) TR_STAGE(2, 0x33333333u) TR_STAGE(1, 0x55555555u)
#undef TR_PERM
#undef TR_STAGE
            }
        }
        unsigned gt[4] = {0u, 0u, 0u, 0u}, eq[4];
#pragma unroll
        for (int w = 0; w < 4; ++w) eq[w] = (w < nw) ? 0xffffffffu : 0u;
        bool done = false, exact = false;
#pragma unroll
        for (int bit = 31; bit >= 0; --bit) {
            if (!__all(done)) {
                int cnt = 0;
#pragma unroll
                for (int w = 0; w < 4; ++w) { if (w < nw) cnt += __popc(gt[w] | (eq[w] & u[32 * w + bit])); }
                cnt = sum32_i(cnt);
                if (!done) {
                    const bool acc = cnt >= 256;
#pragma unroll
                    for (int w = 0; w < 4; ++w) {
                        if (w < nw) { const unsigned t_ = eq[w] & u[32 * w + bit]; gt[w] = acc ? gt[w] : (gt[w] | t_); eq[w] = acc ? t_ : (eq[w] ^ t_); }
                    }
                    if (cnt == 256) { done = true; exact = true; }
                }
            }
        }
        unsigned selw[4];
#pragma unroll
        for (int w = 0; w < 4; ++w) selw[w] = exact ? (gt[w] | eq[w]) : gt[w];
        if (!__all(exact)) {
            int ngt = 0;
#pragma unroll
            for (int w = 0; w < 4; ++w) ngt += __popc(gt[w]);
            ngt = sum32_i(ngt);
            const int need = 256 - ngt;
            int run = 0;
#pragma unroll
            for (int w = 0; w < 4; ++w) {
                if (w < nw) {
#pragma unroll
                    for (int i = 0; i < 32; ++i) {
                        const bool e = (!exact) && ((eq[w] >> i) & 1u);
                        const unsigned long long bq = __ballot(e);
                        const unsigned hm = half ? (unsigned)(bq >> 32) : (unsigned)bq;
                        const int below = __popc(hm & ((1u << idx) - 1u));
                        if (e && (run + below < need)) selw[w] |= (1u << i);
                        run += __popc(hm);
                    }
                }
            }
        }
#pragma unroll
        for (int w = 0; w < 4; ++w) {
            if (w < nw) {
#pragma unroll
                for (int i = 0; i < 32; ++i) {
                    const unsigned long long bal = __ballot((selw[w] >> i) & 1u);
                    asm volatile("s_nop 1\n\tv_writelane_b32 %0, %1, %2" : "+v"(myw[w]) : "s"((unsigned)bal), "n"(i));
                    asm volatile("s_nop 1\n\tv_writelane_b32 %0, %1, %2" : "+v"(myw[w]) : "s"((unsigned)(bal >> 32)), "n"(32 + i));
                }
            }
        }
    }
    unsigned* mrow = F.MASK_() + (rowbase + tq) * 128;
#pragma unroll
    for (int k = 0; k < 4; ++k) mrow[32 * k + idx] = myw[k];
}

template <int VAR>
__device__ __forceinline__ void convpool_item(Frame& F, const Params& P, int layer, int item) {
    int tid_ = F.tid_(); asm volatile("" : "+v"(tid_));
    const int lane = tid_ & 63;
    const int tok0 = item * 128 + F.wave * 16;
    LAS unsigned char* dub = (LAS unsigned char*)F.lds;
#pragma unroll
    for (int i = 0; i < 9; ++i) {
        const int r = 18 * F.wave + 2 * i + (lane >> 5), p = lane & 31;
        int grow = item * 128 - 16 + r; grow = grow < 0 ? 0 : grow;
        __builtin_amdgcn_global_load_lds((const unsigned*)(F.Z_() + (size_t)grow * NZ + ZDU + 8 * (p ^ (r & 15))), (LAS unsigned*)(dub + (18 * F.wave + 2 * i) * 512), 16, 0, 0);
    }
    if (VAR != 2) {
        const int h = lane >> 5, ch = lane & 31;
        const int t0h = tok0 + 8 * h, tp0 = t0h & (SEQ - 1);
        const bf16_t* zb = F.Z_() + (size_t)t0h * NZ + 8 * ch;
        const float* cw = P.conv_w + (size_t)layer * 3 * 256 + 8 * ch;
        bf16x8 rc[10], rx[10], ra[8], rg[8];
#pragma unroll
        for (int i = 0; i < 10; ++i) { const int d = i - 2; const int dd = (tp0 + d >= 0) ? d : 0;
            rc[i] = *(const bf16x8*)(zb + (ptrdiff_t)dd * NZ + ZCC); rx[i] = *(const bf16x8*)(zb + (ptrdiff_t)dd * NZ + ZCX); }
#pragma unroll
        for (int i = 0; i < 8; ++i) { ra[i] = *(const bf16x8*)(zb + (size_t)i * NZ + ZCB); rg[i] = *(const bf16x8*)(zb + (size_t)i * NZ + ZGC); }
        float w0[8], w1[8], w2[8];
        { const f32x4 a0 = *(const f32x4*)(cw), a1 = *(const f32x4*)(cw + 4), b0 = *(const f32x4*)(cw + 256), b1 = *(const f32x4*)(cw + 260), c0 = *(const f32x4*)(cw + 512), c1 = *(const f32x4*)(cw + 516);
#pragma unroll
          for (int e = 0; e < 4; ++e) { w0[e] = a0[e]; w0[4 + e] = a1[e]; w1[e] = b0[e]; w1[4 + e] = b1[e]; w2[e] = c0[e]; w2[4 + e] = c1[e]; } }
        float um2[8], um1[8];
        { float cc[8], cx[8]; unpack8(rc[0], cc); unpack8(rx[0], cx); const float z = (tp0 >= 2) ? 1.f : 0.f;
#pragma unroll
          for (int e = 0; e < 8; ++e) um2[e] = cc[e] * cx[e] * z; }
        { float cc[8], cx[8]; unpack8(rc[1], cc); unpack8(rx[1], cx); const float z = (tp0 >= 1) ? 1.f : 0.f;
#pragma unroll
          for (int e = 0; e < 8; ++e) um1[e] = cc[e] * cx[e] * z; }
#pragma unroll
        for (int i = 0; i < 8; ++i) {
            float cc[8], cx[8], a[8], bq[8], u[8], o[8];
            unpack8(rc[i + 2], cc); unpack8(rx[i + 2], cx); unpack8(ra[i], a); unpack8(rg[i], bq);
#pragma unroll
            for (int e = 0; e < 8; ++e) { u[e] = cc[e] * cx[e]; o[e] = bq[e] * (a[e] * (um2[e] * w0[e] + um1[e] * w1[e] + u[e] * w2[e])); }
            u32x4 w; w[0] = cvtpk(o[0], o[1]); w[1] = cvtpk(o[2], o[3]); w[2] = cvtpk(o[4], o[5]); w[3] = cvtpk(o[6], o[7]);
            *(u32x4*)(F.MIXED_() + (size_t)(t0h + i) * DM + 512 + 8 * ch) = w;
#pragma unroll
            for (int e = 0; e < 8; ++e) { um2[e] = um1[e]; um1[e] = u[e]; }
        }
    }
    const int tk = lane & 15, G = lane >> 4, row = tok0 + tk, tpos = row & (SEQ - 1);
    const bf16_t* zr = F.Z_() + (size_t)row * NZ;
    {
        const int zk[3] = {ZKA, ZKS, ZKW};
#pragma unroll
        for (int ty = 0; ty < 3; ++ty) {
            float f0[8], f1[8]; unpack8(*(const bf16x8*)(zr + zk[ty] + 16 * G), f0); unpack8(*(const bf16x8*)(zr + zk[ty] + 16 * G + 8), f1);
            float ss = 0.f;
#pragma unroll
            for (int e = 0; e < 8; ++e) ss += f0[e] * f0[e] + f1[e] * f1[e];
            ss = sum32x_f(sum16x_f(ss));
            ss = fmaxf(ss, dpp_f<0xB1>(ss)); ss = fmaxf(ss, dpp_f<0x4E>(ss)); ss = fmaxf(ss, dpp_f<0x141>(ss)); ss = fmaxf(ss, dpp_f<0x140>(ss));
            if (lane == 0) F.KP_()[((layer * 8 + (row >> 12)) * 3 + ty) * 256 + (item & 31) * 8 + F.wave] = ss;
        }
    }
    asm volatile("s_waitcnt vmcnt(0)" ::: "memory");
    __syncthreads();
    const int lr = 16 + 16 * F.wave + tk;
    bf16x8 wfr[2][4]; f32x4 scv[4]; s16x4 gtv[4];
#define POOL_LOAD_W(GG) do { _Pragma("unroll") for (int ks = 0; ks < 2; ++ks) _Pragma("unroll") for (int dt = 0; dt < 4; ++dt) \
            wfr[ks][dt] = *(const bf16x8*)(F.PWT_() + (size_t)(layer * 4 + (GG)) * 4096 + (size_t)(16 * dt + tk) * 64 + 32 * ks + 8 * G); \
        _Pragma("unroll") for (int dt = 0; dt < 4; ++dt) { const int dcol = (GG) * 64 + 16 * dt + 4 * G; scv[dt] = *(const f32x4*)(P.pool_scale + (size_t)layer * 256 + dcol); gtv[dt] = *(const s16x4*)(zr + ZGD + dcol); } } while (0)
    POOL_LOAD_W(0);
#pragma unroll
    for (int g = 0; g < (VAR == 3 ? 0 : 4); ++g) {
        const int win = 2 << g;
        const int cntw = (tpos + 1 < win) ? (tpos + 1) : win;
        const float invc = 1.0f / (float)cntw;
        f32x4 acc[4];
#pragma unroll
        for (int dt = 0; dt < 4; ++dt) acc[dt] = (f32x4){0.f, 0.f, 0.f, 0.f};
        u32x4 pwk[2];
#pragma unroll
        for (int ks = 0; ks < 2; ++ks) {
            const int c = g * 8 + 4 * ks + G;
            float sum[8], self[8];
            unpack8(*(const LAS bf16x8*)(dub + lr * 512 + ((c ^ (lr & 15)) << 4)), self);
#pragma unroll
            for (int e = 0; e < 8; ++e) sum[e] = self[e];
#pragma unroll
            for (int j = 1; j < win; ++j) { const bool in = (j <= tpos); const int rr = lr - (in ? j : 0); float f[8]; unpack8(*(const LAS bf16x8*)(dub + rr * 512 + ((c ^ (rr & 15)) << 4)), f); const float wgt = in ? 1.f : 0.f;
#pragma unroll
                for (int e = 0; e < 8; ++e) sum[e] = fmaf(wgt, f[e], sum[e]); }
#pragma unroll
            for (int e = 0; e < 4; ++e) pwk[ks][e] = cvtpk(sum[2 * e] * invc - self[2 * e], sum[2 * e + 1] * invc - self[2 * e + 1]);
        }
#pragma unroll
        for (int ks = 0; ks < 2; ++ks) {
            const bf16x8 pf = __builtin_bit_cast(bf16x8, pwk[ks]);
#pragma unroll
            for (int dt = 0; dt < 4; ++dt) acc[dt] = __builtin_amdgcn_mfma_f32_16x16x32_bf16(wfr[ks][dt], pf, acc[dt], 0, 0, 0);
        }
        u32x2 wo[4];
#pragma unroll
        for (int dt = 0; dt < 4; ++dt) {
            const f32x4 sc = scv[dt]; const s16x4 gt = gtv[dt];
            wo[dt][0] = cvtpk(acc[dt][0] * sc[0] * bf2f((unsigned short)gt[0]), acc[dt][1] * sc[1] * bf2f((unsigned short)gt[1]));
            wo[dt][1] = cvtpk(acc[dt][2] * sc[2] * bf2f((unsigned short)gt[2]), acc[dt][3] * sc[3] * bf2f((unsigned short)gt[3]));
        }
        if (g < 3) POOL_LOAD_W(g + 1);
#pragma unroll
        for (int dt = 0; dt < 4; ++dt) *(u32x2*)(F.MIXED_() + (size_t)row * DM + 768 + g * 64 + 16 * dt + 4 * G) = wo[dt];
    }
#undef POOL_LOAD_W
    __syncthreads();
}

__device__ __forceinline__ int crow(int r, int hi) { return (r & 3) + 8 * (r >> 2) + 4 * hi; }
__device__ __forceinline__ s16x4 vtr(const LAS unsigned char* p) { return __builtin_bit_cast(s16x4, __builtin_amdgcn_ds_read_tr16_b64_v4i16((LAS s16x4*)p)); }

struct AttnCtx {
    int tid, lane, r32, hi, wave, qs, h;
    int b, qb, t;
    unsigned char* lds;
    int st_key, st_chunk;
    unsigned kwoff, vwoff;
    unsigned kroff[2];
    unsigned vbase;
    int vq;
};

__device__ __forceinline__ void attn_ctx_init(AttnCtx& A, Frame& F, int b, int qb) {
    int tid_ = F.tid_(); asm volatile("" : "+v"(tid_));
    A.tid = tid_; A.lane = tid_ & 63; A.r32 = A.lane & 31; A.hi = A.lane >> 5; A.wave = F.wave; A.qs = F.wave >> 2; A.h = F.wave & 3;
    A.b = b; A.qb = qb; A.t = qb * 64 + A.qs * 32 + A.r32; A.lds = F.lds;
    A.st_key = tid_ >> 3; A.st_chunk = tid_ & 7;
    A.kwoff = A.st_key * 128 + ((A.st_chunk ^ ((A.st_key >> 1) & 7)) << 4);
    A.vwoff = A.st_key * 128 + ((A.st_chunk ^ (((A.st_key >> 1) & 1) << 2)) << 4);
    const int i = A.lane & 15, q = i >> 2, p = i & 3, g1 = (A.lane >> 4) & 1;
    A.vq = (q >> 1) & 1;
    A.vbase = (4 * A.hi + q) * 128 + (2 * g1 + (p >> 1)) * 16 + (p & 1) * 8;
}

__device__ __forceinline__ void k_frags(const AttnCtx& A, const LAS unsigned char* kb, bf16x8 (&kf)[8]) {
    const int k0 = A.r32, k1 = 32 + A.r32;
#pragma unroll
    for (int ks = 0; ks < 4; ++ks) {
        kf[2 * ks + 0] = *(const LAS bf16x8*)(kb + k0 * 128 + (((2 * ks + A.hi) ^ ((k0 >> 1) & 7)) << 4));
        kf[2 * ks + 1] = *(const LAS bf16x8*)(kb + k1 * 128 + (((2 * ks + A.hi) ^ ((k1 >> 1) & 7)) << 4));
    }
}
__device__ __forceinline__ void qk_mma(const bf16x8 (&kf)[8], const bf16x8 (&qf)[4], f32x16& p0, f32x16& p1) {
    p0 = (f32x16){0.f}; p1 = (f32x16){0.f};
#pragma unroll
    for (int ks = 0; ks < 4; ++ks) {
        p0 = __builtin_amdgcn_mfma_f32_32x32x16_bf16(kf[2 * ks + 0], qf[ks], p0, 0, 0, 0);
        p1 = __builtin_amdgcn_mfma_f32_32x32x16_bf16(kf[2 * ks + 1], qf[ks], p1, 0, 0, 0);
    }
}
__device__ __forceinline__ void qk_tile(const AttnCtx& A, const LAS unsigned char* kb, const bf16x8 (&qf)[4], f32x16& p0, f32x16& p1) {
    bf16x8 kf[8]; k_frags(A, kb, kf); qk_mma(kf, qf, p0, p1);
}
__device__ __forceinline__ void v_frags(const AttnCtx& A, const LAS unsigned char* vb, bf16x8 (&vf)[8]) {
#pragma unroll
    for (int s = 0; s < 4; ++s)
#pragma unroll
        for (int dt = 0; dt < 2; ++dt) {
            const LAS unsigned char* base = vb + A.vbase + (16 * s) * 128 + ((dt ^ A.vq) * 64);
            const s16x4 lo = vtr(base), hi4 = vtr(base + 8 * 128);
            vf[2 * s + dt] = (bf16x8){lo[0], lo[1], lo[2], lo[3], hi4[0], hi4[1], hi4[2], hi4[3]};
        }
}
__device__ __forceinline__ void p_pack(const f32x16& p0, const f32x16& p1, bf16x8 (&pf)[4]) {
#pragma unroll
    for (int s = 0; s < 4; ++s) {
        const f32x16& pp = (s >> 1) ? p1 : p0; const int rb = 8 * (s & 1);
        u32x4 pw; pw[0] = cvtpk(pp[rb + 0], pp[rb + 1]); pw[1] = cvtpk(pp[rb + 2], pp[rb + 3]); pw[2] = cvtpk(pp[rb + 4], pp[rb + 5]); pw[3] = cvtpk(pp[rb + 6], pp[rb + 7]);
        pf[s] = __builtin_bit_cast(bf16x8, pw);
    }
}
__device__ __forceinline__ void pv_mma(const bf16x8 (&vf)[8], const bf16x8 (&pf)[4], f32x16& o0, f32x16& o1) {
#pragma unroll
    for (int s = 0; s < 4; ++s) {
        o0 = __builtin_amdgcn_mfma_f32_32x32x16_bf16(vf[2 * s + 0], pf[s], o0, 0, 0, 0);
        o1 = __builtin_amdgcn_mfma_f32_32x32x16_bf16(vf[2 * s + 1], pf[s], o1, 0, 0, 0);
    }
}
__device__ __forceinline__ void pv_tile(const AttnCtx& A, const LAS unsigned char* vb, const f32x16& p0, const f32x16& p1, f32x16& o0, f32x16& o1) {
    bf16x8 vf[8], pf[4]; v_frags(A, vb, vf); p_pack(p0, p1, pf); pv_mma(vf, pf, o0, o1);
}
__device__ __forceinline__ float max16(const f32x16& p) {
    float a = fmaxf(fmaxf(p[0], p[1]), fmaxf(p[2], p[3])), b = fmaxf(fmaxf(p[4], p[5]), fmaxf(p[6], p[7]));
    float c = fmaxf(fmaxf(p[8], p[9]), fmaxf(p[10], p[11])), d = fmaxf(fmaxf(p[12], p[13]), fmaxf(p[14], p[15]));
    return fmaxf(fmaxf(a, b), fmaxf(c, d));
}
__device__ __forceinline__ float sum16(const f32x16& p) {
    return (((p[0] + p[1]) + (p[2] + p[3])) + ((p[4] + p[5]) + (p[6] + p[7]))) + (((p[8] + p[9]) + (p[10] + p[11])) + ((p[12] + p[13]) + (p[14] + p[15])));
}

__device__ __forceinline__ float mask_bit(float p, unsigned w, int pos) {
    const unsigned mk = (unsigned)__builtin_amdgcn_sbfe((int)w, pos, 1);
    return __uint_as_float((__float_as_uint(p) & mk) | (0xff800000u & ~mk));
}
template <int MODE>
__device__ __forceinline__ void tile_mask(const AttnCtx& A, f32x16& p0, f32x16& p1, bool active, unsigned w0, unsigned w1, bool blk, int kt, int iq) {
    if (active) {
        if (MODE == 0) {
#pragma unroll
            for (int r = 0; r < 16; ++r) { const int cpos = (r & 3) + 8 * (r >> 2); p0[r] = mask_bit(p0[r], w0, cpos); p1[r] = mask_bit(p1[r], w1, cpos); }
        } else if (MODE == 1) {
            const bool diag = (kt == A.qb);
#pragma unroll
            for (int r = 0; r < 16; ++r) { const int kp = crow(r, A.hi);
                p0[r] = (blk && (!diag || kp <= iq)) ? p0[r] : -INFINITY; p1[r] = (blk && (!diag || (kp + 32) <= iq)) ? p1[r] : -INFINITY; }
        } else {
            const bool diag = (kt == A.qb), tail = (kt == A.qb - 8);
            if (diag || tail) {
#pragma unroll
                for (int r = 0; r < 16; ++r) { const int kp = crow(r, A.hi);
                    const bool v0 = diag ? (kp <= iq) : (kp > iq), v1 = diag ? ((kp + 32) <= iq) : ((kp + 32) > iq);
                    p0[r] = v0 ? p0[r] : -INFINITY; p1[r] = v1 ? p1[r] : -INFINITY; }
            }
        }
    } else {
#pragma unroll
        for (int r = 0; r < 16; ++r) { p0[r] = -INFINITY; p1[r] = -INFINITY; }
    }
}

__device__ __forceinline__ void qk_mma_c(const bf16x8 (&kf)[8], const bf16x8 (&qf)[4], const f32x16& c0, const f32x16& c1, f32x16& p0, f32x16& p1) {
    p0 = __builtin_amdgcn_mfma_f32_32x32x16_bf16(kf[0], qf[0], c0, 0, 0, 0);
    p1 = __builtin_amdgcn_mfma_f32_32x32x16_bf16(kf[1], qf[0], c1, 0, 0, 0);
#pragma unroll
    for (int ks = 1; ks < 4; ++ks) {
        p0 = __builtin_amdgcn_mfma_f32_32x32x16_bf16(kf[2 * ks + 0], qf[ks], p0, 0, 0, 0);
        p1 = __builtin_amdgcn_mfma_f32_32x32x16_bf16(kf[2 * ks + 1], qf[ks], p1, 0, 0, 0);
    }
}
__device__ __forceinline__ float init_bit(float negref, unsigned w, int pos) {
    const unsigned mk = (unsigned)__builtin_amdgcn_sbfe((int)w, pos, 1);
    return __uint_as_float((__float_as_uint(negref) & mk) | (0xff800000u & ~mk));
}
__device__ __forceinline__ float q_norm2(const AttnCtx& A, const bf16x8 (&qf)[4]) {
    float ss = 0.f;
#pragma unroll
    for (int ks = 0; ks < 4; ++ks) { float f[8]; unpack8(qf[ks], f);
#pragma unroll
        for (int e = 0; e < 8; ++e) ss = fmaf(f[e], f[e], ss); }
    return sum32x_f(ss);
}

template <int MODE>
__device__ __forceinline__ void attn_stream(const AttnCtx& A, const bf16_t* Kg, const bf16_t* Vg, int kt0, int kt1, const bf16x8 (&qf)[4], float negref,
                                            f32x16& o0, f32x16& o1, float& lsum, const unsigned* mrow, unsigned long long bm) {
    LAS unsigned char* kbuf = (LAS unsigned char*)A.lds + L_K; LAS unsigned char* vbuf = (LAS unsigned char*)A.lds + L_V;
    LAS unsigned char* mbuf = (LAS unsigned char*)A.lds + L_IMP;
    const int iq = A.qs * 32 + A.r32;
    const int nsteps = (kt1 - kt0 + 2) >> 1;
    const int dkey = 8 * A.wave + (A.lane >> 3), dpc = A.lane & 7;
    const bf16_t* kgl = Kg + (size_t)dkey * NZ + 8 * (dpc ^ ((dkey >> 1) & 7));
    const bf16_t* vgl = Vg + (size_t)dkey * NZ + 8 * (dpc ^ (((dkey >> 1) & 1) << 2));
    const int wofs = A.wave * 1024;
    if (__builtin_amdgcn_readfirstlane(A.wave) >= 4) __builtin_amdgcn_s_setprio(1);
#define ATTN_DMA(STEP) do { const int ka_ = kt0 + 2 * (STEP), kb2_ = ka_ + 1; const int bo_ = ((STEP) & 1) * 16384 + wofs; \
        __builtin_amdgcn_global_load_lds((const unsigned*)(kgl + (size_t)ka_ * 64 * NZ), (LAS unsigned*)(kbuf + bo_), 16, 0, 0); \
        __builtin_amdgcn_global_load_lds((const unsigned*)(vgl + (size_t)ka_ * 64 * NZ), (LAS unsigned*)(vbuf + bo_), 16, 0, 0); \
        { const int kb3_ = kb2_ <= kt1 ? kb2_ : ka_;        \
            __builtin_amdgcn_global_load_lds((const unsigned*)(kgl + (size_t)kb3_ * 64 * NZ), (LAS unsigned*)(kbuf + bo_ + 8192), 16, 0, 0); \
            __builtin_amdgcn_global_load_lds((const unsigned*)(vgl + (size_t)kb3_ * 64 * NZ), (LAS unsigned*)(vbuf + bo_ + 8192), 16, 0, 0); } \
        if (MODE == 0) __builtin_amdgcn_global_load_lds((const unsigned*)(mrow + 2 * ka_), (LAS unsigned*)(mbuf + ((STEP) & 1) * 8192 + wofs), 16, 0, 0); \
    } while (0)
    ATTN_DMA(0);
    for (int s = 0; s < nsteps; ++s) {
        __syncthreads();
        if (s + 1 < nsteps) ATTN_DMA(s + 1);
        const int ktA = kt0 + 2 * s, ktB = ktA + 1; const bool haveB = ktB <= kt1;
        u32x2 cwA = (u32x2){0u, 0u}, cwB = (u32x2){0u, 0u};
        if (MODE == 0) { const u32x4 mw = *(const LAS u32x4*)(mbuf + (s & 1) * 8192 + wofs + 16 * A.lane); cwA[0] = mw[0]; cwA[1] = mw[1]; cwB[0] = haveB ? mw[2] : 0u; cwB[1] = haveB ? mw[3] : 0u; }
        const LAS unsigned char* kb = kbuf + (s & 1) * 16384; const LAS unsigned char* vb = vbuf + (s & 1) * 16384;
        bool blkA = true, blkB = haveB;
        if (MODE == 1) { blkA = (bm >> ktA) & 1ull; blkB = haveB && ((bm >> ktB) & 1ull); }
#define ATTN_CINIT(C0, C1, W0, W1, BLK) do { \
            if (MODE == 0) { _Pragma("unroll") for (int r = 0; r < 16; ++r) { const int cpos = (r & 3) + 8 * (r >> 2); C0[r] = init_bit(negref, (W0), cpos); C1[r] = init_bit(negref, (W1), cpos); } } \
            else { const float base = (BLK) ? negref : -INFINITY; _Pragma("unroll") for (int r = 0; r < 16; ++r) { C0[r] = base; C1[r] = base; } } } while (0)
#define ATTN_SOFT(P0, P1, PF, KT) do { \
            if (MODE == 1) { if ((KT) == A.qb) { _Pragma("unroll") for (int r = 0; r < 16; ++r) { const int kp = crow(r, A.hi); P0[r] = (kp <= iq) ? P0[r] : -INFINITY; P1[r] = ((kp + 32) <= iq) ? P1[r] : -INFINITY; } } } \
            if (MODE == 2) { const bool diag = ((KT) == A.qb), tail = ((KT) == A.qb - 8); if (diag || tail) { _Pragma("unroll") for (int r = 0; r < 16; ++r) { const int kp = crow(r, A.hi); \
                const bool v0 = diag ? (kp <= iq) : (kp > iq), v1 = diag ? ((kp + 32) <= iq) : ((kp + 32) > iq); P0[r] = v0 ? P0[r] : -INFINITY; P1[r] = v1 ? P1[r] : -INFINITY; } } } \
            _Pragma("unroll") for (int r = 0; r < 16; ++r) { P0[r] = fast_exp2(P0[r]); P1[r] = fast_exp2(P1[r]); } \
            lsum += sum16(P0) + sum16(P1); \
            p_pack(P0, P1, PF); } while (0)
        bf16x8 kf[8]; k_frags(A, kb, kf);
        f32x16 pA0, pA1; ATTN_CINIT(pA0, pA1, cwA[0] >> (4 * A.hi), cwA[1] >> (4 * A.hi), blkA);
        __builtin_amdgcn_sched_barrier(0);
        qk_mma_c(kf, qf, pA0, pA1, pA0, pA1);
        f32x16 pB0, pB1; ATTN_CINIT(pB0, pB1, cwB[0] >> (4 * A.hi), cwB[1] >> (4 * A.hi), blkB);
        __builtin_amdgcn_sched_barrier(0);
        k_frags(A, kb + 8192, kf);
        qk_mma_c(kf, qf, pB0, pB1, pB0, pB1);
        bf16x8 pfA[4]; ATTN_SOFT(pA0, pA1, pfA, ktA);
        __builtin_amdgcn_sched_barrier(0);
        bf16x8 vf[8]; v_frags(A, vb, vf);
        pv_mma(vf, pfA, o0, o1);
        bf16x8 pfB[4]; ATTN_SOFT(pB0, pB1, pfB, ktB);
        __builtin_amdgcn_sched_barrier(0);
        v_frags(A, vb + 8192, vf);
        pv_mma(vf, pfB, o0, o1);
#undef ATTN_SOFT
#undef ATTN_CINIT
    }
#undef ATTN_DMA
    __builtin_amdgcn_s_setprio(0);
    __syncthreads();
}

__device__ __forceinline__ void load_q(const AttnCtx& A, const bf16_t* Zq  , bf16x8 (&qf)[4]) {
    const bf16_t* qp = Zq + ((size_t)A.b * SEQ + A.t) * NZ + 64 * A.h + 8 * A.hi;
#pragma unroll
    for (int ks = 0; ks < 4; ++ks) qf[ks] = *(const bf16x8*)(qp + 16 * ks);
}
__device__ __forceinline__ void store_out(const AttnCtx& A, Frame& F, const f32x16& o0, const f32x16& o1, int zgate, int colbase) {
    const size_t row = (size_t)A.b * SEQ + A.t;
#pragma unroll
    for (int dt = 0; dt < 2; ++dt)
#pragma unroll
        for (int k = 0; k < 4; ++k) {
            const int d = 32 * dt + 8 * k + 4 * A.hi;
            const s16x4 gt = *(const s16x4*)(F.Z_() + row * NZ + zgate + 64 * A.h + d);
            const f32x16& o = dt ? o1 : o0;
            u32x2 w; w[0] = cvtpk(o[4 * k + 0] * bf2f((unsigned short)gt[0]), o[4 * k + 1] * bf2f((unsigned short)gt[1]));
            w[1] = cvtpk(o[4 * k + 2] * bf2f((unsigned short)gt[2]), o[4 * k + 3] * bf2f((unsigned short)gt[3]));
            *(u32x2*)(F.MIXED_() + row * DM + colbase + 64 * A.h + d) = w;
        }
}

__device__ __forceinline__ float kmax_load(Frame& F, int layer, int b, int ty, int lane) {
    const f32x4 v = *(const f32x4*)(F.KP_() + ((layer * 8 + b) * 3 + ty) * 256 + 4 * lane);
    float m = fmaxf(fmaxf(v[0], v[1]), fmaxf(v[2], v[3]));
    m = fmaxf(m, dpp_f<0xB1>(m)); m = fmaxf(m, dpp_f<0x4E>(m)); m = fmaxf(m, dpp_f<0x141>(m)); m = fmaxf(m, dpp_f<0x140>(m));
    return max32x_f(max16x_f(m));
}
__device__ __forceinline__ void dsa_attn_item(Frame& F, int layer, int b, int qb) {
    AttnCtx A; attn_ctx_init(A, F, b, qb);
    bf16x8 qf[4]; load_q(A, F.Z_() + ZQA, qf);
    const float kmx = kmax_load(F, layer, b, 0, A.lane);
    const float negref = -sqrtf(q_norm2(A, qf) * kmx);
    f32x16 o0 = (f32x16){0.f}, o1 = (f32x16){0.f}; float ol = 0.f;
    const unsigned* mrow = F.MASK_() + ((size_t)b * SEQ + A.t) * 128;
    attn_stream<0>(A, F.Z_() + (size_t)b * SEQ * NZ + ZKA, F.Z_() + (size_t)b * SEQ * NZ + ZVA, 0, qb, qf, negref, o0, o1, ol, mrow, 0ull);
    const float l = sum32x_f(ol);
    const float il = l > 0.f ? 1.0f / l : 0.f;
#pragma unroll
    for (int r = 0; r < 16; ++r) { o0[r] *= il; o1[r] *= il; }
    store_out(A, F, o0, o1, ZGA, 0);
}

__device__ __forceinline__ void nsa_item(Frame& F, int layer, int b, int qb) {
    AttnCtx A; attn_ctx_init(A, F, b, qb);
    bf16x8 qf[4]; load_q(A, F.Z_() + ZQB, qf);
    const size_t row = (size_t)b * SEQ + A.t;
    const float g_c = F.BGF_()[row * 16 + 3 * A.h + 0], g_s = F.BGF_()[row * 16 + 3 * A.h + 1], g_w = F.BGF_()[row * 16 + 3 * A.h + 2];
    f32x16 out0 = (f32x16){0.f}, out1 = (f32x16){0.f};
    LAS unsigned char* kbuf = (LAS unsigned char*)F.lds + L_K; LAS unsigned char* vbuf = (LAS unsigned char*)F.lds + L_V;
    float* impw = (float*)(F.lds + L_IMP);
    {
        const bf16_t* kc = F.KCMP_() + (size_t)b * 256 * 64; const bf16_t* vc = F.VCMP_() + (size_t)b * 256 * 64;
#pragma unroll
        for (int i = 0; i < 4; ++i) {
            const int key = 64 * i + A.st_key;
            const u32x4 kr = *(const u32x4*)(kc + (size_t)key * 64 + 8 * A.st_chunk), vr = *(const u32x4*)(vc + (size_t)key * 64 + 8 * A.st_chunk);
            *(LAS u32x4*)(kbuf + i * 8192 + A.kwoff) = kr; *(LAS u32x4*)(vbuf + i * 8192 + A.vwoff) = vr;
        }
        __syncthreads();
        const int nmax = (qb * 64 + 63 - 31) >> 4;
        const int ntile = (nmax >> 6) + 1;
        float mx = -1e30f, lsum = 0.f;
        for (int i = 0; i < ntile; ++i) {
            f32x16 p0, p1;
            qk_tile(A, kbuf + i * 8192, qf, p0, p1);
#pragma unroll
            for (int r = 0; r < 16; ++r) { const int n0 = 64 * i + crow(r, A.hi), n1 = n0 + 32;
                p0[r] = (16 * n0 + 31 <= A.t) ? p0[r] : -INFINITY; p1[r] = (16 * n1 + 31 <= A.t) ? p1[r] : -INFINITY; }
            float tm = fmaxf(max16(p0), max16(p1)); tm = fmaxf(tm, xhalf(tm));
            const float mn = fmaxf(mx, tm), alpha = fast_exp2(mx - mn);
#pragma unroll
            for (int r = 0; r < 16; ++r) { p0[r] = fast_exp2(p0[r] - mn); p1[r] = fast_exp2(p1[r] - mn); }
            float rs = sum16(p0) + sum16(p1); rs += xhalf(rs);
            lsum = lsum * alpha + rs; mx = mn;
        }
        const float il = lsum > 0.f ? 1.0f / lsum : 0.f;
        float* ip = impw + ((size_t)A.h * 64 + (A.qs * 32 + A.r32)) * 64;
        float prev_other = 0.f;
        for (int i = 0; i < 4; ++i) {
            if (i < ntile) {
                f32x16 p0, p1;
                qk_tile(A, kbuf + i * 8192, qf, p0, p1);
#pragma unroll
                for (int r = 0; r < 16; ++r) { const int n0 = 64 * i + crow(r, A.hi), n1 = n0 + 32;
                    p0[r] = (16 * n0 + 31 <= A.t) ? fast_exp2(p0[r] - mx) * il : 0.f; p1[r] = (16 * n1 + 31 <= A.t) ? fast_exp2(p1[r] - mx) * il : 0.f; }
#pragma unroll
                for (int rt = 0; rt < 2; ++rt)
#pragma unroll
                    for (int k = 0; k < 4; ++k) {
                        const f32x16& pp = rt ? p1 : p0;
                        const float gs = (pp[4 * k] + pp[4 * k + 1]) + (pp[4 * k + 2] + pp[4 * k + 3]);
                        const float other = xhalf(pp[4 * k + 3]);
                        ip[16 * i + 8 * rt + 2 * k + A.hi] = gs + (A.hi ? other : prev_other);
                        prev_other = other;
                    }
                pv_tile(A, vbuf + i * 8192, p0, p1, out0, out1);
            } else {
#pragma unroll
                for (int j = 0; j < 8; ++j) ip[16 * i + 2 * j + A.hi] = 0.f;
            }
        }
#pragma unroll
        for (int r = 0; r < 16; ++r) { out0[r] *= g_c; out1[r] *= g_c; }
    }
    __syncthreads();
    {
        unsigned long long* bmp = (unsigned long long*)(F.lds + L_BM);
        for (int qq = 0; qq < 8; ++qq) {
            const int q = F.wave * 8 + qq, j = A.lane;
            float v = ((impw[(0 * 64 + q) * 64 + j] + impw[(1 * 64 + q) * 64 + j]) + impw[(2 * 64 + q) * 64 + j]) + impw[(3 * 64 + q) * 64 + j];
            if (j == 0 || j == qb) v = INFINITY; else if (j > qb) v = -INFINITY;
            const unsigned bits = __float_as_uint(v);
            const unsigned key = (bits & 0x80000000u) ? ~bits : (bits | 0x80000000u);
            unsigned T = 0u;
            for (int bit = 31; bit >= 0; --bit) {
                const unsigned cand = T | (1u << bit);
                const int cnt = __popcll(__ballot(key >= cand));
                if (cnt >= 16) T = cand;
                if (cnt == 16) break;
            }
            const unsigned long long gtm = __ballot(key > T), eqm = __ballot(key == T);
            const int need = 16 - __popcll(gtm);
            const int below = __popcll(eqm & ((1ull << j) - 1ull));
            const unsigned long long sel = __ballot((j <= qb) && ((key > T) || ((key == T) && below < need)));
            if (A.lane == 0) bmp[q] = sel;
        }
    }
    __syncthreads();
    const unsigned long long bm = ((const unsigned long long*)(F.lds + L_BM))[A.qs * 32 + A.r32];
    LAS float* ow = (LAS float*)((LAS unsigned char*)F.lds + L_IMP) + F.wave * 2048 + A.lane;
#pragma unroll
    for (int r = 0; r < 16; ++r) { ow[r * 64] = out0[r]; ow[(16 + r) * 64] = out1[r]; }
    const float qn2 = q_norm2(A, qf);
    const float kmx_s = kmax_load(F, layer, b, 1, A.lane), kmx_w = kmax_load(F, layer, b, 2, A.lane);
    {
        f32x16 o0 = (f32x16){0.f}, o1 = (f32x16){0.f}; float ol = 0.f;
        const float negref = -sqrtf(qn2 * kmx_s);
        attn_stream<1>(A, F.Z_() + (size_t)b * SEQ * NZ + ZKS, F.Z_() + (size_t)b * SEQ * NZ + ZVS, 0, qb, qf, negref, o0, o1, ol, nullptr, bm);
        const float l = sum32x_f(ol);
        const float sc = (l > 0.f ? 1.0f / l : 0.f) * g_s;
#pragma unroll
        for (int r = 0; r < 16; ++r) { ow[r * 64] += o0[r] * sc; ow[(16 + r) * 64] += o1[r] * sc; }
    }
    {
        f32x16 o0 = (f32x16){0.f}, o1 = (f32x16){0.f}; float ol = 0.f;
        const float negref = -sqrtf(qn2 * kmx_w);
        const int k0 = qb - 8 < 0 ? 0 : qb - 8;
        attn_stream<2>(A, F.Z_() + (size_t)b * SEQ * NZ + ZKW, F.Z_() + (size_t)b * SEQ * NZ + ZVW, k0, qb, qf, negref, o0, o1, ol, nullptr, 0ull);
        const float l = sum32x_f(ol);
        const float sc = (l > 0.f ? 1.0f / l : 0.f) * g_w;
#pragma unroll
        for (int r = 0; r < 16; ++r) { o0[r] = ow[r * 64] + o0[r] * sc; o1[r] = ow[(16 + r) * 64] + o1[r] * sc; }
        store_out(A, F, o0, o1, ZGB, 256);
    }
}

__device__ __forceinline__ void zero_item(Frame& F, int b, int qb, int colbase) {
    const int tid = F.tid_();
    for (int i = tid; i < 64 * 32; i += 512) { const int r = i >> 5, c = i & 31;
        *(u32x4*)(F.MIXED_() + ((size_t)b * SEQ + qb * 64 + r) * DM + colbase + 8 * c) = (u32x4){0u, 0u, 0u, 0u}; }
}

__device__ __forceinline__ void phase_final(Frame& F, const Params& P) {
    const int gw = blockIdx.x * 8 + F.wave, NGW = F.G * 8;
#ifdef ABL_DUMP
    for (int row = gw; row < MROWS; row += NGW) {
        for (int c = F.lane_(); c < DM; c += 64) P.out[(size_t)row * DM + c] = bf2f(F.Z_()[(size_t)row * NZ + ABL_DUMP + (c & 255)]);
    }
    return;
#endif
    for (int row = gw; row < MROWS; row += NGW) {
        const f32x4 a = *(const f32x4*)(F.RS_() + (size_t)row * 4);
        const float ss = (a[0] + a[1]) + (a[2] + a[3]);
        const float rr = 1.0f / sqrtf(ss * (1.0f / 1024.0f) + 1e-6f);
        const u32x2* xb = (const u32x2*)(F.XB_() + (size_t)row * DM) + F.lane_();
        f32x4* xo = (f32x4*)(P.out + (size_t)row * DM) + F.lane_();
        const f32x4* gw4 = (const f32x4*)P.final_norm_w + F.lane_();
#pragma unroll
        for (int j = 0; j < 4; ++j) { const u32x2 w = xb[64 * j]; const f32x4 g = gw4[64 * j];
            xo[64 * j] = (f32x4){__uint_as_float(w[0] << 16) * rr * g[0], __uint_as_float(w[0] & 0xffff0000u) * rr * g[1], __uint_as_float(w[1] << 16) * rr * g[2], __uint_as_float(w[1] & 0xffff0000u) * rr * g[3]}; }
    }
}

#define XB_TMO      128
#define XB_XCNT(j)  (256  + 64 * (j))
#define XB_XSUB(j)  (1280 + 64 * (j))
#define XB_XGEN(j)  (2304 + 64 * (j))
#define XB_TOP      3328
#define XB_TOPGEN   3392
#define XCD_BAR_WORDS 3456
#define XB_SPIN_CAP (1u << 18)

__device__ __forceinline__ unsigned xb_ld(unsigned* p)              { return __hip_atomic_load(p, __ATOMIC_RELAXED, __HIP_MEMORY_SCOPE_AGENT); }
__device__ __forceinline__ unsigned xb_add(unsigned* p, unsigned v) { return __hip_atomic_fetch_add(p, v, __ATOMIC_RELAXED, __HIP_MEMORY_SCOPE_AGENT); }
__device__ __forceinline__ unsigned xb_xcc_id() { return (unsigned)__builtin_amdgcn_s_getreg((3 << 11) | 20) & 0xFu; }
#define XB_SPIN(cond, bar) do { unsigned _sp = 0; while (cond) { __builtin_amdgcn_s_sleep(1); \
    if ((++_sp & 255u) == 0u) { if (xb_ld(&(bar)[XB_TMO])) break; if (_sp > XB_SPIN_CAP) { atomicAdd(&(bar)[XB_TMO], 1u); break; } } } } while (0)

struct XcdBarrier {
    unsigned* bar; unsigned x;
    volatile LAS unsigned* st;
};

__device__ __forceinline__ XcdBarrier xcd_barrier_post(unsigned* bar, volatile LAS unsigned* st) {
    XcdBarrier b; b.bar = bar; b.x = xb_xcc_id(); b.st = st;
    if (threadIdx.x == 0) (void)xb_add(&bar[XB_XCNT(b.x)], 1u);
    return b;
}
__device__ __forceinline__ void xcd_barrier_complete(unsigned* bar, unsigned x, unsigned& nloc, unsigned& nx) {
    const unsigned G = gridDim.x * gridDim.y * gridDim.z;
    unsigned sum, cnt, mine, sp = 0u;
    for (;;) {
        sum = 0u; cnt = 0u; mine = 0u;
#pragma unroll
        for (unsigned j = 0; j < 16; ++j) { const unsigned c = xb_ld(&bar[XB_XCNT(j)]); sum += c; cnt += (c > 0u) ? 1u : 0u; mine = (j == x) ? c : mine; }
        if (sum == G) break;
        __builtin_amdgcn_s_sleep(1);
        if ((++sp & 255u) == 0u) { if (xb_ld(&bar[XB_TMO])) break; if (sp > XB_SPIN_CAP) { atomicAdd(&bar[XB_TMO], 1u); break; } }
    }
    nloc = mine > 0u ? mine : 1u; nx = cnt > 0u ? cnt : 1u;
}

__device__ __forceinline__ void xcd_barrier(const XcdBarrier& b) {
    asm volatile("s_waitcnt vmcnt(0)" ::: "memory");
    __syncthreads();
    if (threadIdx.x == 0) {
        unsigned* bar = b.bar;
        __builtin_amdgcn_s_waitcnt(0);
        unsigned nloc = b.st[0], nx = b.st[1];
        if (nloc == 0u) { xcd_barrier_complete(bar, b.x, nloc, nx); b.st[0] = nloc; b.st[1] = nx; }
        const unsigned old = xb_add(&bar[XB_XSUB(b.x)], 1u);
        const unsigned gen = old / nloc;
        if (old + 1u == (gen + 1u) * nloc) {
            __builtin_amdgcn_fence(__ATOMIC_RELEASE, "agent");
            asm volatile("s_waitcnt vmcnt(0)" ::: "memory");
            const unsigned og = xb_add(&bar[XB_TOP], 1u);
            const unsigned tg = og / nx;
            if (og + 1u == (tg + 1u) * nx) xb_add(&bar[XB_TOPGEN], 1u);
            else XB_SPIN(xb_ld(&bar[XB_TOPGEN]) == tg, bar);
            __builtin_amdgcn_fence(__ATOMIC_ACQUIRE, "agent");
            xb_add(&bar[XB_XGEN(b.x)], 1u);
            asm volatile("s_waitcnt vmcnt(0)" ::: "memory");
        } else {
            XB_SPIN(xb_ld(&bar[XB_XGEN(b.x)]) == gen, bar);
            __builtin_amdgcn_fence(__ATOMIC_ACQUIRE, "agent");
            asm volatile("s_waitcnt vmcnt(0)" ::: "memory");
        }
    }
    __syncthreads();
}

template <int SUB>
__device__ __forceinline__ void run_phase(Frame& F, const Params& Q, int layer, unsigned char* lds) {
        constexpr int sub = SUB;
        if (sub == 0) {
            pg8::Gemm g{F.XB_(), F.WIT_() + (size_t)layer * NZ * DM, MROWS, NZ, DM};
            pg8::StaticOrder S; S.init(MROWS, NZ, F.G, (int)blockIdx.x);
            EpiIn E{F.Z_(), F.RS_(), F.CS_(), F.WIF_(), F.BGF_(), lds};
            pg8::gemm_phase<EpiIn, pg8::StaticOrder, true, true>((PG8_LAS unsigned char*)lds, g, S, E, F.wave);
#if defined(PROBE_DUP) && PROBE_DUP == 1
            __syncthreads();
            pg8::gemm_phase<EpiIn, pg8::StaticOrder, true, true>((PG8_LAS unsigned char*)lds, g, S, E, F.wave);
#endif
        } else if (sub == 1) {
            const int qbase = 32 * layer;
            for (int it = (int)blockIdx.x; it < 256; it += F.G) { compress_item(F, Q, layer, it); __syncthreads(); }
            for (int it = (int)blockIdx.x; it < 256; it += F.G) convpool_item<0>(F, Q, layer, it);
#ifndef ABL_NO_A
            { int b, it; while (next_item_batch(F, qbase + 8, 128, b, it)) {
_Pragma("nounroll")
                for (int k = 0; k < 2; ++k) { select_item(F, b, 255 - 2 * it - k); __syncthreads(); } } }
#endif
#if defined(PROBE_DUP) && PROBE_DUP == 7
            __syncthreads();
            for (;;) { const int it = next_item(F, qbase + 2); if (it >= 256) break; compress_item(F, Q, layer, it); }
            { int b, it; while (next_item_batch(F, qbase + 24, 256, b, it)) select_item(F, b, 255 - it); }
            for (;;) { const int it = next_item(F, qbase + 3); if (it >= 256) break; convpool_item<0>(F, Q, layer, it); }
#endif
#if defined(PROBE_DUP) && PROBE_DUP == 12
            { int b, it; while (next_item_batch(F, qbase + 24, 256, b, it)) select_item(F, b, 255 - it); }
#endif
#if defined(PROBE_DUP) && PROBE_DUP == 2
            { int b, it; while (next_item_batch(F, qbase + 24, 256, b, it)) select_item(F, b, 255 - it); }
#endif
#if defined(PROBE_DUP) && PROBE_DUP == 3
            for (;;) { const int it = next_item(F, qbase + 2); if (it >= 256) break; compress_item(F, Q, layer, it); }
#endif
#if defined(PROBE_DUP) && PROBE_DUP == 13
            { int acc_ = 0; for (int k = 0; k < 16; ++k) acc_ += next_item(F, qbase + 24 + (k & 7)); if (acc_ == 0x7fffffff) F.KMAX_()[127] = 1u; }
#endif
#if defined(PROBE_DUP) && PROBE_DUP == 11
            for (;;) { const int it = next_item(F, qbase + 3); if (it >= 256) break; convpool_item<PROBE_VAR>(F, Q, layer, it); }
#endif
        } else if (sub == 2) {
            const int qbase = 32 * layer;
            { int b, it;
              while (next_item_batch(F, qbase + 16, 128, b, it)) {
                const int qb = 63 - (it >> 1);
                if ((it & 1) == 0) nsa_item(F, layer, b, qb); else dsa_attn_item(F, layer, b, qb);
              } }
#if defined(PROBE_DUP) && (PROBE_DUP == 4 || PROBE_DUP == 5)
            __syncthreads();
            { int b, it;
              while (next_item_batch(F, qbase + 24, 64, b, it)) {
                const int qb = 63 - it;
                if (PROBE_DUP == 5) nsa_item(F, layer, b, qb); else dsa_attn_item(F, layer, b, qb);
              } }
#endif
#if defined(PROBE_DUP) && PROBE_DUP == 6
            __syncthreads();
            { int b, it;
              while (next_item_batch(F, qbase + 24, 128, b, it)) {
                const int qb = 63 - (it >> 1);
                if ((it & 1) == 0) nsa_item(F, layer, b, qb); else dsa_attn_item(F, layer, b, qb);
              } }
#endif
        } else {
            pg8::Gemm g{F.MIXED_(), F.WOT_() + (size_t)layer * DM * DM, MROWS, DM, DM};
            pg8::StaticOrder S; S.init(MROWS, DM, F.G, (int)blockIdx.x);
            EpiOut E{F.XB_(), F.RS_(), lds};
            pg8::gemm_phase<EpiOut, pg8::StaticOrder, true, true>((PG8_LAS unsigned char*)lds, g, S, E, F.wave);
#if defined(PROBE_DUP) && PROBE_DUP == 8
            __syncthreads();
            EpiOut E2{F.Z_() + (size_t)64 * 1024 * 1024, F.BGF_(), lds};
            pg8::gemm_phase<EpiOut, pg8::StaticOrder, true, true>((PG8_LAS unsigned char*)lds, g, S, E2, F.wave);
#endif
        }
}

template <bool COOP>
__global__ void __launch_bounds__(512, 2) fwd_kernel(Params P) {
    extern __shared__ __attribute__((aligned(16))) unsigned char lds[];
    Frame F;
    F.lds = lds; F.wave = __builtin_amdgcn_readfirstlane((int)(threadIdx.x >> 6)); F.G = gridDim.x;
    F.ws = P.ws;
    XcdBarrier bar; bar.bar = nullptr; bar.x = 0; bar.st = nullptr;
    if (COOP) {
        volatile LAS unsigned* misc = (volatile LAS unsigned*)((LAS unsigned char*)lds + MISC_OFF);
        if (threadIdx.x < 64) misc[threadIdx.x] = 0u;
        { unsigned* c = F.ctl_(); for (int i = (int)blockIdx.x * 512 + (int)threadIdx.x; i < (int)(CTL_BYTES / 4); i += (int)gridDim.x * 512) c[i] = 0u; }
        __syncthreads();
    }
#define GRID_SYNC() do { if (COOP) { xcd_barrier(bar); } } while (0)
#if defined(PROBE_DUP) && PROBE_DUP == 14
#define PROBE_XSYNC GRID_SYNC()
#else
#define PROBE_XSYNC (void)0
#endif

    if (COOP) {
        phase_prologue(F, P);
#if defined(PROBE_DUP) && PROBE_DUP == 9
        __syncthreads(); phase_prologue(F, P);
#endif
        cg::this_grid().sync();
        bar = xcd_barrier_post(F.ctl_() + 12288, (volatile LAS unsigned*)((LAS unsigned char*)lds + MISC_OFF) + 8);
#define RUN_PHASE(LAYER, SUB) do { Params Q = P; \
            asm volatile("" : "+s"(Q.x), "+s"(Q.norm_w), "+s"(Q.conv_w), "+s"(Q.pe_cmp), "+s"(Q.pool_scale), "+s"(Q.out), "+s"(Q.ws)); F.ws = Q.ws; \
            run_phase<SUB>(F, Q, LAYER, lds); GRID_SYNC(); PROBE_XSYNC; } while (0)
#define RUN_LAYER(LAYER) do { RUN_PHASE(LAYER, 0); RUN_PHASE(LAYER, 1); RUN_PHASE(LAYER, 2); RUN_PHASE(LAYER, 3); } while (0)
        RUN_LAYER(0); RUN_LAYER(1); RUN_LAYER(2); RUN_LAYER(3);
#undef RUN_LAYER
#undef RUN_PHASE
        phase_final(F, P);
    } else {
        int ph = P.ph_lo;
        if (ph == 0) { phase_prologue(F, P); ++ph; }
        for (; ph < P.ph_hi && ph < NPHASE - 1; ++ph) {
            int ph_ = ph; asm volatile("" : "+s"(ph_));
            Params Q = P;
            asm volatile("" : "+s"(Q.x), "+s"(Q.norm_w), "+s"(Q.conv_w), "+s"(Q.pe_cmp), "+s"(Q.pool_scale), "+s"(Q.out), "+s"(Q.ws));
            F.ws = Q.ws;
            const int layer = (ph_ - 1) >> 2, sub = (ph_ - 1) & 3;
            if (sub == 0) run_phase<0>(F, Q, layer, lds); else if (sub == 1) run_phase<1>(F, Q, layer, lds); else if (sub == 2) run_phase<2>(F, Q, layer, lds); else run_phase<3>(F, Q, layer, lds);
        }
        if (ph == NPHASE - 1 && ph < P.ph_hi) phase_final(F, P);
    }
}

#ifndef N_LAUNCH_MODE
#define N_LAUNCH_MODE 0
#endif
#if N_LAUNCH_MODE == 0
template __global__ void fwd_kernel<true>(Params);
#else
template __global__ void fwd_kernel<false>(Params);
#endif
extern "C" void kernel_launch(void* const* d_in, const int* in_sizes, int n_in, void* d_out, int out_size, void* d_ws, size_t ws_size, hipStream_t stream) {
    static int grid = 0;
    if (grid == 0) {
        if (n_in != 11 || out_size != MROWS * DM || ws_size < WS_END) { fprintf(stderr, "kernel_launch: unexpected shapes (n_in %d out %d ws %zu)\n", n_in, out_size, ws_size); grid = -1; return; }
        int dev = 0, cus = 0, per_cu = 0;
        hipGetDevice(&dev); hipDeviceGetAttribute(&cus, hipDeviceAttributeMultiprocessorCount, dev);
#if N_LAUNCH_MODE == 0
#define FWD_K fwd_kernel<true>
#else
#define FWD_K fwd_kernel<false>
#endif
        hipFuncSetAttribute((const void*)FWD_K, hipFuncAttributeMaxDynamicSharedMemorySize, LDS_BYTES);
        hipOccupancyMaxActiveBlocksPerMultiprocessor(&per_cu, (const void*)FWD_K, 512, LDS_BYTES);
        (void)hipGetLastError();
        if (per_cu < 1) { fprintf(stderr, "kernel_launch: occupancy query says %d blocks/CU\n", per_cu); per_cu = 1; }
        grid = cus;
    }
    if (grid < 0) return;
#if N_LAUNCH_MODE != 0
    hipMemsetAsync((char*)d_ws + WS_CTL, 0, CTL_BYTES, stream);
#endif
    Params p{};
    p.x = (const float*)d_in[0]; p.norm_w = (const float*)d_in[1]; p.w_in = (const float*)d_in[2]; p.w_out = (const float*)d_in[3]; p.conv_w = (const float*)d_in[4];
    p.pe_cmp = (const float*)d_in[5]; p.w_cmp_k = (const float*)d_in[6]; p.w_cmp_v = (const float*)d_in[7]; p.pool_w = (const float*)d_in[8]; p.pool_scale = (const float*)d_in[9];
    p.final_norm_w = (const float*)d_in[10]; p.out = (float*)d_out; p.ws = (unsigned char*)d_ws;
#if N_LAUNCH_MODE == 0
    p.ph_lo = 0; p.ph_hi = NPHASE;
    void* args[] = {&p};
    hipError_t e = hipLaunchCooperativeKernel((const void*)fwd_kernel<true>, dim3(grid), dim3(512), args, LDS_BYTES, stream);
    if (e != hipSuccess) fprintf(stderr, "cooperative launch failed: %s (grid %d)\n", hipGetErrorString(e), grid);
#else
    for (int ph = 0; ph < NPHASE; ++ph) {
#ifdef ABL_DUMP
        if (ph >= 2 && ph < NPHASE - 1) continue;
#endif
        p.ph_lo = ph; p.ph_hi = ph + 1;
        hipLaunchKernelGGL(fwd_kernel<false>, dim3(grid), dim3(512), LDS_BYTES, stream, p);
    }
#endif
}
```

```cpp
#include <hip/hip_runtime.h>
#include <hip/hip_cooperative_groups.h>
#include <cstdio>
#include <cstdint>
namespace cg = cooperative_groups;

constexpr int BATCH = 8, SEQ = 4096, DM = 1024, DEPTH = 4, MROWS = BATCH * SEQ;
constexpr int D_IN = 3380, NZ = 3584;
constexpr int ZQA = 0, ZQI = 256, ZQB = 512, ZKA = 768, ZVA = 832, ZKS = 896, ZVS = 960, ZKW = 1024, ZVW = 1088, ZKC = 1152, ZVC = 1216,
              ZKI = 1280, ZWI = 1312, ZBG = 1320, ZGA = 1536, ZGB = 1792, ZCB = 2048, ZCC = 2304, ZCX = 2560, ZGC = 2816, ZDU = 3072, ZGD = 3328;
constexpr float C2 = 0.18033688011112042f;
constexpr int NPHASE = 2 + 4 * DEPTH;

constexpr size_t MiB = 1u << 20;
constexpr size_t WS_CTL = 0, CTL_BYTES = 64 * 1024;
constexpr size_t WS_WIT = 2 * MiB;
constexpr size_t WS_WOT = 30 * MiB;
constexpr size_t WS_WCT = 38 * MiB;
constexpr size_t WS_PWT = 40 * MiB;
constexpr size_t WS_CS = 40 * MiB + 256 * 1024;
constexpr size_t WS_KP = 41 * MiB;
constexpr size_t WS_RS = 42 * MiB;
constexpr size_t WS_WIF = 44 * MiB;
constexpr size_t WS_BGF = 45 * MiB;
constexpr size_t WS_KCMP = 47 * MiB;
constexpr size_t WS_VCMP = 47 * MiB + 512 * 1024;
constexpr size_t WS_XB = 48 * MiB;
constexpr size_t WS_Z = 112 * MiB;
constexpr size_t WS_MIXED = 336 * MiB;
constexpr size_t WS_MASK = 400 * MiB;
constexpr size_t WS_END = 416 * MiB;

constexpr int RING_BYTES = 131072;
constexpr int MISC_OFF = RING_BYTES;
constexpr int LDS_BYTES = 147456;
constexpr int L_K = 0, L_V = 32768, L_IMP = 65536, L_BM = MISC_OFF + 256;

typedef unsigned short bf16_t;
typedef short bf16x8 __attribute__((ext_vector_type(8)));
typedef short s16x4 __attribute__((ext_vector_type(4)));
typedef float f32x4 __attribute__((ext_vector_type(4)));
typedef float f32x2 __attribute__((ext_vector_type(2)));
typedef float f32x16 __attribute__((ext_vector_type(16)));
typedef unsigned u32x4 __attribute__((ext_vector_type(4)));
typedef unsigned u32x2 __attribute__((ext_vector_type(2)));
#define LAS __attribute__((address_space(3)))

__host__ __device__ __forceinline__ int perm64(int j) { return j < 16 ? ((j & ~12) | ((j & 4) << 1) | ((j & 8) >> 1)) : j; }
__host__ __device__ __forceinline__ int src_col(int p) {
    if (p < 256) return 0 + (p >> 6) * 64 + perm64(p & 63);
    if (p < 512) return 384 + (p - 256);
    if (p < 768) { const int q = p - 512; return 936 + (q >> 6) * 64 + perm64(q & 63); }
    if (p < 832) return 256 + perm64(p - 768);
    if (p < 896) return 320 + (p - 832);
    if (p < 960) return 1320 + perm64(p - 896);
    if (p < 1024) return 1384 + (p - 960);
    if (p < 1088) return 1448 + perm64(p - 1024);
    if (p < 1152) return 1512 + (p - 1088);
    if (p < 1216) return 1192 + (p - 1152);
    if (p < 1280) return 1256 + (p - 1216);
    if (p < 1312) return 640 + (p - 1280);
    if (p < 1320) return 672 + (p - 1312);
    if (p < 1332) return 1576 + (p - 1320);
    if (p < 1536) return -1;
    if (p < 1792) return 680 + (p - 1536);
    if (p < 2048) return 1588 + (p - 1792);
    if (p < 2304) return 1844 + (p - 2048);
    if (p < 2560) return 2100 + (p - 2304);
    if (p < 2816) return 2356 + (p - 2560);
    if (p < 3072) return 2612 + (p - 2816);
    if (p < 3328) return 2868 + (p - 3072);
    return 3124 + (p - 3328);
}
#define N_LAUNCH_MODE 0
namespace pg8 {
#define PG8_LAS __attribute__((address_space(3)))
typedef unsigned short bf16_t;
typedef short bf16x8 __attribute__((ext_vector_type(8)));
typedef float f32x4 __attribute__((ext_vector_type(4)));
typedef unsigned u32x4 __attribute__((ext_vector_type(4)));
constexpr int BM = 256, BK = 64, HALF = 128, HTB = HALF * BK * 2  , STAGE_BYTES = 8 * HTB, NXCD = 8, WGM = 8;

__host__ __device__ __forceinline__ int lds_byte(int r, int c) { const int st = (r >> 4) * 2 + (c >> 5), rr = r & 15, cc = c & 31, ob = rr * 64 + cc * 2; return st * 1024 + (ob ^ (((ob >> 9) & 1) << 5)); }
__host__ __device__ __forceinline__ void stage_rc(int b, int& R, int& C) { const int st = b / 1024, sb = b % 1024, swz = sb ^ (((sb >> 9) & 1) << 5); R = (st >> 1) * 16 + swz / 64; C = (st & 1) * 32 + (swz % 64) / 2; }
__host__ __device__ __forceinline__ int perm32(int rho) { const int n = rho >> 4, i = rho & 15; return 8 * (i >> 2) + 4 * n + (i & 3); }

struct Unit { int pm, pn; };
struct Gemm { const bf16_t* A; const bf16_t* Bt; int M, N, K; };

struct StaticOrder {
    int nM, nN, nwg, G, c;
    __host__ __device__ void init(int M, int N, int G_, int c_) { nM = M / BM; nN = N / BM; nwg = nM * nN; G = G_; c = c_; }
    __host__ __device__ bool next(int i, Unit& u) const {
        const long L = (long)i * G + c; if (L >= nwg) return false;
        int wgid = (int)L; { const int q = nwg / NXCD, r = nwg % NXCD, xcd = wgid % NXCD, off = wgid / NXCD; wgid = (xcd < r ? xcd * (q + 1) : r * (q + 1) + (xcd - r) * q) + off; }
        const int nig = WGM * nN, gid = wgid / nig, fm = gid * WGM, gsz = (nM - fm) < WGM ? (nM - fm) : WGM;
        u.pm = fm + ((wgid % nig) % gsz); u.pn = (wgid % nig) / gsz; return true;
    }
    __device__ __forceinline__ void a_ready(const Unit&) const {}
    __device__ __forceinline__ void done(const Unit&) const {}
};
}
namespace pg8 {
template <class Epi, class Sched, bool ALIGN_EPI = false, bool SP2 = false>
__device__ __forceinline__ void gemm_phase(PG8_LAS unsigned char* lds, const Gemm g, const Sched& S, const Epi& E, const int wave_s) {
    int lane_; asm volatile("v_mbcnt_lo_u32_b32 %0, -1, 0\n\tv_mbcnt_hi_u32_b32 %0, -1, %0" : "=v"(lane_));
    const int tid = wave_s * 64 + lane_, wid = wave_s, lane = lane_, wr = wid >> 2, wc = wid & 3, fr = lane & 15, fq = lane >> 4;
    const int K = g.K, nt = K / BK;
    unsigned voffA[2], voffB[2];
#pragma unroll
    for (int i = 0; i < 2; ++i) { int R, C; stage_rc(tid * 16 + i * 8192, R, C); const int Rb = Epi::PERM ? ((R & ~31) + perm32(R & 31)) : R;
        voffA[i] = (unsigned)(R * K + C) * 2u; voffB[i] = (unsigned)(Rb * K + C) * 2u; }
    const size_t kstep = (size_t)(BK * 2);
    const size_t hstep = (size_t)HALF * K * 2;
    const size_t tstep = 2 * hstep;
    const unsigned ldsw = (unsigned)wid * 1024u;
    const int aoff = lds_byte(wr * 64 + fr, fq * 8), boff = lds_byte(wc * 32 + fr, fq * 8);
#define PG8_SA(b, h) (((b) * 2 + (h)) * HTB)
#define PG8_SB(b, h) ((4 + (b) * 2 + (h)) * HTB)
#define PG8_STAGE(bufoff, gbase, voff) do { _Pragma("unroll") for (int _i = 0; _i < 2; ++_i) \
        __builtin_amdgcn_global_load_lds((const unsigned*)((const char*)(gbase) + (voff)[_i]), (PG8_LAS unsigned*)(lds + (bufoff) + ldsw + _i * 8192), 16, 0, 0); } while (0)
#define PG8_LDA(dst, b, h) do { _Pragma("unroll") for (int m = 0; m < 4; ++m) _Pragma("unroll") for (int k = 0; k < 2; ++k) dst[m][k] = *(const PG8_LAS bf16x8*)(lds + PG8_SA(b, h) + aoff + m * 2048 + k * 1024); } while (0)
#define PG8_LDB(dst, b, h) do { _Pragma("unroll") for (int n = 0; n < 2; ++n) _Pragma("unroll") for (int k = 0; k < 2; ++k) dst[n][k] = *(const PG8_LAS bf16x8*)(lds + PG8_SB(b, h) + boff + n * 2048 + k * 1024); } while (0)
#define PG8_MMA(ai, bj, At, Bt) do { __builtin_amdgcn_s_setprio(1); _Pragma("unroll") for (int m = 0; m < 4; ++m) _Pragma("unroll") for (int n = 0; n < 2; ++n) _Pragma("unroll") for (int k = 0; k < 2; ++k) \
        acc[ai][bj][m][n] = __builtin_amdgcn_mfma_f32_16x16x32_bf16(Bt[n][k], At[m][k], acc[ai][bj][m][n], 0, 0, 0); __builtin_amdgcn_s_setprio(0); } while (0)
#define PG8_WAIT_V(n) asm volatile("s_waitcnt vmcnt(" #n ")" ::: "memory")
#define PG8_WAIT_L(n) asm volatile("s_waitcnt lgkmcnt(" #n ")" ::: "memory")
#define PG8_BAR __builtin_amdgcn_s_barrier()
#define PG8_SCHED __builtin_amdgcn_sched_barrier(0)
    Unit cur, nxt; int ui = 0; int par_ = 0;
    if (!S.next(0, cur)) return;
    f32x4 acc[2][2][4][2];
    if constexpr (Epi::HAS_INIT) E.init(acc, cur, wr, wc, fr, fq);
    else {
#pragma unroll
    for (int a = 0; a < 2; ++a)
#pragma unroll
        for (int b = 0; b < 2; ++b)
#pragma unroll
            for (int m = 0; m < 4; ++m)
#pragma unroll
                for (int n = 0; n < 2; ++n) acc[a][b][m][n] = (f32x4){0.f, 0.f, 0.f, 0.f};
    }
    bf16x8 At[4][2], B0[2][2], B1[2][2];
    const char* cA = (const char*)g.A + (size_t)cur.pm * tstep; const char* cB = (const char*)g.Bt + (size_t)cur.pn * tstep;
    S.a_ready(cur);
    if constexpr (SP2) {
        PG8_STAGE(PG8_SB(0, 0), cB, voffB); PG8_STAGE(PG8_SB(0, 1), cB + hstep, voffB); PG8_STAGE(PG8_SA(0, 0), cA, voffA); PG8_STAGE(PG8_SA(0, 1), cA + hstep, voffA);
        if constexpr (Epi::HAS_ROWS) { typename Epi::Rows r0_ = E.rows_issue(cur, tid); E.rows_commit(r0_, tid, 0, true); }
        if (wr == 1) PG8_BAR;
        PG8_WAIT_V(2); PG8_BAR;
        PG8_STAGE(PG8_SB(1, 0), cB + kstep, voffB); PG8_STAGE(PG8_SA(1, 0), cA + kstep, voffA); PG8_STAGE(PG8_SB(1, 1), cB + hstep + kstep, voffB);
        PG8_WAIT_V(6); PG8_BAR;
    } else {
        PG8_STAGE(PG8_SB(0, 0), cB, voffB); PG8_STAGE(PG8_SA(0, 0), cA, voffA); PG8_STAGE(PG8_SB(0, 1), cB + hstep, voffB); PG8_STAGE(PG8_SA(0, 1), cA + hstep, voffA);
        if (wr == 1) PG8_BAR;
        PG8_WAIT_V(4); PG8_BAR;
        PG8_STAGE(PG8_SB(1, 0), cB + kstep, voffB); PG8_STAGE(PG8_SA(1, 0), cA + kstep, voffA); PG8_STAGE(PG8_SB(1, 1), cB + hstep + kstep, voffB);
        PG8_WAIT_V(6); PG8_BAR;
    }
    for (;;) {
        const bool has_next = S.next(ui + 1, nxt);
        const char* nA = has_next ? (const char*)g.A + (size_t)nxt.pm * tstep : cA; const char* nB = has_next ? (const char*)g.Bt + (size_t)nxt.pn * tstep : cB;
        for (int t = 0; t < nt; t += 2) {
            const bool last = (t == nt - 2);
            const char* a1 = cA + (size_t)(t + 1) * kstep;
            const char* a2 = last ? nA : cA + (size_t)(t + 2) * kstep; const char* b2 = last ? nB : cB + (size_t)(t + 2) * kstep;
            const char* a3 = a2 + kstep; const char* b3 = b2 + kstep;
            if (last && has_next) S.a_ready(nxt);
            if constexpr (SP2) {
            PG8_LDB(B0, 0, 0); PG8_LDB(B1, 0, 1); PG8_SCHED; PG8_LDA(At, 0, 0); PG8_STAGE(PG8_SA(1, 1), a1 + hstep, voffA);
            PG8_WAIT_V(8); PG8_WAIT_L(0); PG8_BAR; PG8_MMA(0, 0, At, B0); PG8_MMA(0, 1, At, B1); PG8_BAR; PG8_SCHED;
            PG8_LDA(At, 0, 1); PG8_STAGE(PG8_SB(0, 0), b2, voffB); PG8_STAGE(PG8_SB(0, 1), b2 + hstep, voffB); PG8_STAGE(PG8_SA(0, 0), a2, voffA);
            PG8_WAIT_V(8); PG8_WAIT_L(0); PG8_BAR; PG8_MMA(1, 0, At, B0); PG8_MMA(1, 1, At, B1); PG8_BAR; PG8_SCHED;
            PG8_LDB(B0, 1, 0); PG8_LDB(B1, 1, 1); PG8_SCHED; PG8_LDA(At, 1, 0); PG8_STAGE(PG8_SA(0, 1), a2 + hstep, voffA);
            PG8_WAIT_V(8); PG8_WAIT_L(0); PG8_BAR; PG8_MMA(0, 0, At, B0); PG8_MMA(0, 1, At, B1); PG8_BAR; PG8_SCHED;
            PG8_LDA(At, 1, 1); PG8_STAGE(PG8_SB(1, 0), b3, voffB); PG8_STAGE(PG8_SB(1, 1), b3 + hstep, voffB); PG8_STAGE(PG8_SA(1, 0), a3, voffA);
            PG8_WAIT_V(8); PG8_WAIT_L(0); PG8_BAR; PG8_MMA(1, 0, At, B0); PG8_MMA(1, 1, At, B1); PG8_BAR; PG8_SCHED;
            } else {
            PG8_LDB(B0, 0, 0); PG8_SCHED; PG8_LDA(At, 0, 0); PG8_STAGE(PG8_SA(1, 1), a1 + hstep, voffA);
            PG8_WAIT_L(8); PG8_BAR; PG8_WAIT_L(0); PG8_MMA(0, 0, At, B0); PG8_BAR; PG8_SCHED;
            PG8_LDB(B1, 0, 1); PG8_STAGE(PG8_SB(0, 0), b2, voffB);
            PG8_BAR; PG8_WAIT_L(0); PG8_MMA(0, 1, At, B1); PG8_BAR;
            PG8_LDA(At, 0, 1); PG8_STAGE(PG8_SA(0, 0), a2, voffA);
            PG8_BAR; PG8_WAIT_L(0); PG8_MMA(1, 0, At, B0); PG8_BAR; PG8_SCHED;
            PG8_STAGE(PG8_SB(0, 1), b2 + hstep, voffB);
            PG8_WAIT_V(6); PG8_BAR; PG8_MMA(1, 1, At, B1); PG8_BAR;
            PG8_LDB(B0, 1, 0); PG8_SCHED; PG8_LDA(At, 1, 0); PG8_STAGE(PG8_SA(0, 1), a2 + hstep, voffA);
            PG8_WAIT_L(8); PG8_BAR; PG8_WAIT_L(0); PG8_MMA(0, 0, At, B0); PG8_BAR; PG8_SCHED;
            PG8_LDB(B1, 1, 1); PG8_STAGE(PG8_SB(1, 0), b3, voffB);
            PG8_BAR; PG8_WAIT_L(0); PG8_MMA(0, 1, At, B1); PG8_BAR;
            PG8_LDA(At, 1, 1); PG8_STAGE(PG8_SA(1, 0), a3, voffA);
            PG8_BAR; PG8_WAIT_L(0); PG8_MMA(1, 0, At, B0); PG8_BAR; PG8_SCHED;
            PG8_STAGE(PG8_SB(1, 1), b3 + hstep, voffB);
            PG8_WAIT_V(6); PG8_BAR; PG8_MMA(1, 1, At, B1); PG8_BAR;
            }
        }
        if constexpr (ALIGN_EPI) { if (wr == 0) PG8_BAR; }
        if constexpr (Epi::HAS_ROWS) {
            typename Epi::Rows rn_ = E.rows_issue(has_next ? nxt : cur, tid);
            E.run(acc, cur, wr, wc, fr, fq, par_); S.done(cur);
            E.rows_commit(rn_, tid, par_ ^ 1, false); par_ ^= 1;
        } else
        if constexpr (!Epi::AFTER_DRAIN) { E(acc, cur, wr, wc, fr, fq); S.done(cur); }
        if (!has_next) break;
        if constexpr (Epi::HAS_INIT) E.init(acc, nxt, wr, wc, fr, fq);
        else {
#pragma unroll
        for (int a = 0; a < 2; ++a)
#pragma unroll
            for (int b = 0; b < 2; ++b)
#pragma unroll
                for (int m = 0; m < 4; ++m)
#pragma unroll
                    for (int n = 0; n < 2; ++n) acc[a][b][m][n] = (f32x4){0.f, 0.f, 0.f, 0.f};
        }
        cur = nxt; cA = nA; cB = nB; ++ui;
        if constexpr (ALIGN_EPI) { if (wr == 1) PG8_BAR; }
    }
    PG8_WAIT_V(0);
    if constexpr (!ALIGN_EPI) { if (wr == 0) PG8_BAR; }
    PG8_BAR;
    if constexpr (Epi::AFTER_DRAIN) { E.fused(acc, cur, wr, wc, fr, fq, lds, wid, lane); S.done(cur); }
#undef PG8_SA
#undef PG8_SB
#undef PG8_STAGE
#undef PG8_LDA
#undef PG8_LDB
#undef PG8_MMA
#undef PG8_WAIT_V
#undef PG8_WAIT_L
#undef PG8_BAR
#undef PG8_SCHED
}
}

__device__ __forceinline__ float bf2f(unsigned short h) { return __uint_as_float((unsigned)h << 16); }
typedef __bf16 bf16x2_t __attribute__((ext_vector_type(2)));
__device__ __forceinline__ unsigned cvtpk(float lo, float hi) { f32x2 v = {lo, hi}; bf16x2_t b = __builtin_convertvector(v, bf16x2_t); return __builtin_bit_cast(unsigned, b); }
__device__ __forceinline__ float fast_exp2(float x) { return __builtin_amdgcn_exp2f(x); }
__device__ __forceinline__ float fast_rcp(float x) { return __builtin_amdgcn_rcpf(x); }
__device__ __forceinline__ float sigmoidf_(float x) { return fast_rcp(1.f + fast_exp2(-1.4426950408889634f * x)); }
__device__ __forceinline__ float siluf_(float x) { return x * sigmoidf_(x); }
__device__ __forceinline__ int lane_id() { int l; asm volatile("v_mbcnt_lo_u32_b32 %0, -1, 0\n\tv_mbcnt_hi_u32_b32 %0, -1, %0" : "=v"(l)); return l; }
__device__ __forceinline__ float xhalf_(float v, int hi) {
    auto rr = __builtin_amdgcn_permlane32_swap(__float_as_uint(v), __float_as_uint(v), false, false);
    return hi ? __uint_as_float(rr[0]) : __uint_as_float(rr[1]);
}
#define xhalf(v) xhalf_((v), A.hi)
template <int CTRL> __device__ __forceinline__ int dpp_i(int v) { return __builtin_amdgcn_update_dpp(0, v, CTRL, 0xf, 0xf, true); }
template <int CTRL> __device__ __forceinline__ float dpp_f(float v) { return __int_as_float(__builtin_amdgcn_update_dpp(0, __float_as_int(v), CTRL, 0xf, 0xf, true)); }
__device__ __forceinline__ int sum32_i(int v) {
    v += dpp_i<0xB1>(v); v += dpp_i<0x4E>(v); v += dpp_i<0x141>(v); v += dpp_i<0x140>(v);
    const auto r = __builtin_amdgcn_permlane16_swap((unsigned)v, (unsigned)v, false, false);
    return (int)(r[0] + r[1]);
}
__device__ __forceinline__ float sum16x_f(float v) {
    const auto r = __builtin_amdgcn_permlane16_swap(__float_as_uint(v), __float_as_uint(v), false, false);
    return __uint_as_float(r[0]) + __uint_as_float(r[1]);
}
__device__ __forceinline__ float sum32x_f(float v) {
    const auto r = __builtin_amdgcn_permlane32_swap(__float_as_uint(v), __float_as_uint(v), false, false);
    return __uint_as_float(r[0]) + __uint_as_float(r[1]);
}
__device__ __forceinline__ float max16x_f(float v) {
    const auto r = __builtin_amdgcn_permlane16_swap(__float_as_uint(v), __float_as_uint(v), false, false);
    return fmaxf(__uint_as_float(r[0]), __uint_as_float(r[1]));
}
__device__ __forceinline__ float max32x_f(float v) {
    const auto r = __builtin_amdgcn_permlane32_swap(__float_as_uint(v), __float_as_uint(v), false, false);
    return fmaxf(__uint_as_float(r[0]), __uint_as_float(r[1]));
}
__device__ __forceinline__ float wave_sum_f(float v) {
    v += dpp_f<0xB1>(v); v += dpp_f<0x4E>(v); v += dpp_f<0x141>(v); v += dpp_f<0x140>(v);
    return sum32x_f(sum16x_f(v));
}
__device__ __forceinline__ void unpack8(bf16x8 v, float (&f)[8]) {
#pragma unroll
    for (int j = 0; j < 8; ++j) f[j] = bf2f((unsigned short)v[j]);
}

struct Params {
    const float* x; const float* norm_w; const float* w_in; const float* w_out; const float* conv_w; const float* pe_cmp;
    const float* w_cmp_k; const float* w_cmp_v; const float* pool_w; const float* pool_scale; const float* final_norm_w;
    float* out; unsigned char* ws; int ph_lo, ph_hi;
};

struct EpiIn {
    static constexpr bool PERM = true, AFTER_DRAIN = false, HAS_INIT = false, HAS_ROWS = true;
    bf16_t* Z; const float* RS; const f32x2* CS; float* WIF; float* BGF; unsigned char* lds;
    struct Rows { f32x4 rs; f32x2 cs; };
    __device__ __forceinline__ Rows rows_issue(const pg8::Unit& u, int tid) const {
        Rows r; r.rs = (f32x4){1.f, 1.f, 1.f, 1.f}; r.cs = (f32x2){1.f, 0.f};
        if (tid < 256) {
            r.rs = *(const f32x4*)(RS + (size_t)(u.pm * 256 + tid) * 4);
            const int rr = tid >> 3, t0 = (u.pm * 256 + (rr >> 4) * 64 + (rr & 15)) & (SEQ - 1);
            r.cs = CS[t0 * 8 + (tid & 7)];
        }
        return r;
    }
    __device__ __forceinline__ void rows_commit(const Rows& r, int tid, int par, bool first) const {
        LAS float* lrs = (LAS float*)((LAS unsigned char*)lds + MISC_OFF + 1024) + par * 256;
        LAS f32x2* lcs = (LAS f32x2*)((LAS unsigned char*)lds + MISC_OFF + 4096) + par * 256;
        if (tid < 256) {
            lrs[tid] = 1.0f / sqrtf(((r.rs[0] + r.rs[1]) + (r.rs[2] + r.rs[3])) * (1.0f / 1024.0f) + 1e-6f);
            lcs[tid] = r.cs;
        }
        if (first && tid < 8) ((LAS f32x2*)((LAS unsigned char*)lds + MISC_OFF + 3072))[tid] = CS[16 * 8 + tid];
    }
    __device__ __forceinline__ void run(const f32x4 (&acc)[2][2][4][2], const pg8::Unit& u, int wr, int wc, int fr, int fq, int par) const {
        const int pn = u.pn;
        float rrv[2][4];
        {
            const LAS float* lrs = (const LAS float*)((LAS unsigned char*)lds + MISC_OFF + 1024) + par * 256;
#pragma unroll
            for (int ai = 0; ai < 2; ++ai)
#pragma unroll
                for (int m = 0; m < 4; ++m) rrv[ai][m] = lrs[ai * 128 + wr * 64 + m * 16 + fr];
        }
        const int cl0 = wc * 32 + fq * 8, hp0 = cl0 & 63;
        bool rope0 = false, rope1 = false; int fb = 0, fs = 1;
        if (pn == 0 || pn == 2) { if (hp0 < 16) { rope0 = rope1 = true; fb = hp0 >> 1; } }
        else if (pn == 1) { if ((cl0 & 31) == 0) { rope0 = rope1 = true; fs = 2; } }
        else if (pn == 3) { if (((cl0 >> 6) & 1) == 0 && hp0 < 16) { rope0 = rope1 = true; fb = hp0 >> 1; } }
        else if (pn == 4) { if ((cl0 >> 6) == 0 && hp0 < 16) { rope0 = true; fb = hp0 >> 1; } }
        else if (pn == 5) { if (cl0 == 0) { rope0 = true; fs = 2; } }
        f32x2 csc[4], cst[4];
        if (rope0) {
            const LAS f32x2* lcs = (const LAS f32x2*)((LAS unsigned char*)lds + MISC_OFF + 4096) + par * 256 + (wr * 16 + fr) * 8;
            const LAS f32x2* lst = (const LAS f32x2*)((LAS unsigned char*)lds + MISC_OFF + 3072);
#pragma unroll
            for (int e = 0; e < 4; ++e) { csc[e] = lcs[fb + e * fs]; cst[e] = lst[fb + e * fs]; }
        }
#pragma unroll
        for (int aim = 0; aim < 4; ++aim) {
            const int ai = aim >> 1;
#pragma unroll
            for (int m2 = 0; m2 < 2; ++m2) {
                const int m = 2 * (aim & 1) + m2;
                const int row = u.pm * 256 + ai * 128 + wr * 64 + m * 16 + fr;
                const float rr = rrv[ai][m];
#pragma unroll
                for (int bj = 0; bj < 2; ++bj) {
                    float v[8];
#pragma unroll
                    for (int e = 0; e < 4; ++e) { v[e] = acc[ai][bj][m][0][e] * rr; v[4 + e] = acc[ai][bj][m][1][e] * rr; }
                    const int cl = bj * 128 + wc * 32 + fq * 8;
                    if (bj == 0 ? rope0 : rope1) {
#pragma unroll
                        for (int e = 0; e < 4; ++e) {
                            const f32x2 cs = csc[e];
                            const float x1 = v[e], x2 = v[4 + e];
                            v[e] = x1 * cs[0] - x2 * cs[1]; v[4 + e] = x2 * cs[0] + x1 * cs[1];
                        }
                    }
                    if (pn == 0 || pn == 2) {
#pragma unroll
                        for (int e = 0; e < 8; ++e) v[e] *= C2;
                    } else if (pn == 6 || pn == 7 || pn == 11 || pn == 13) {
#pragma unroll
                        for (int e = 0; e < 8; ++e) v[e] = siluf_(v[e]);
                    } else if (pn == 5) {
                        if (cl == 32) { *(f32x4*)(WIF + (size_t)row * 8) = (f32x4){v[0], v[1], v[2], v[3]}; *(f32x4*)(WIF + (size_t)row * 8 + 4) = (f32x4){v[4], v[5], v[6], v[7]}; }
                        else if (cl == 40) { *(f32x4*)(BGF + (size_t)row * 16) = (f32x4){sigmoidf_(v[0]), sigmoidf_(v[1]), sigmoidf_(v[2]), sigmoidf_(v[3])};
                                             *(f32x4*)(BGF + (size_t)row * 16 + 4) = (f32x4){sigmoidf_(v[4]), sigmoidf_(v[5]), sigmoidf_(v[6]), sigmoidf_(v[7])}; }
                        else if (cl == 48) { *(f32x4*)(BGF + (size_t)row * 16 + 8) = (f32x4){sigmoidf_(v[0]), sigmoidf_(v[1]), sigmoidf_(v[2]), sigmoidf_(v[3])}; }
                    }
                    u32x4 w; w[0] = cvtpk(v[0], v[1]); w[1] = cvtpk(v[2], v[3]); w[2] = cvtpk(v[4], v[5]); w[3] = cvtpk(v[6], v[7]);
                    *(u32x4*)(Z + (size_t)row * NZ + pn * 256 + cl) = w;
                }
                if (rope0 && !(ai == 1 && m == 3)) {
#pragma unroll
                    for (int st = 0; st < (m == 3 ? 5 : 1); ++st)
#pragma unroll
                        for (int e = 0; e < 4; ++e) { const float c = csc[e][0], sn = csc[e][1]; csc[e][0] = c * cst[e][0] - sn * cst[e][1]; csc[e][1] = sn * cst[e][0] + c * cst[e][1]; }
                }
            }
        }
    }
};

struct EpiOut {
    static constexpr bool PERM = true, AFTER_DRAIN = false, HAS_INIT = true, HAS_ROWS = false;
    bf16_t* XB; float* RS; unsigned char* lds;
    __device__ __forceinline__ void init(f32x4 (&acc)[2][2][4][2], const pg8::Unit& u, int wr, int wc, int fr, int fq) const {
        bf16x8 xold[2][4][2];
#pragma unroll
        for (int ai = 0; ai < 2; ++ai)
#pragma unroll
            for (int m = 0; m < 4; ++m)
#pragma unroll
                for (int bj = 0; bj < 2; ++bj) xold[ai][m][bj] = *(const bf16x8*)(XB + (size_t)(u.pm * 256 + ai * 128 + wr * 64 + m * 16 + fr) * DM + u.pn * 256 + bj * 128 + wc * 32 + fq * 8);
#pragma unroll
        for (int ai = 0; ai < 2; ++ai)
#pragma unroll
            for (int m = 0; m < 4; ++m)
#pragma unroll
                for (int bj = 0; bj < 2; ++bj) {
                    float xo[8]; unpack8(xold[ai][m][bj], xo);
                    acc[ai][bj][m][0] = (f32x4){xo[0], xo[1], xo[2], xo[3]}; acc[ai][bj][m][1] = (f32x4){xo[4], xo[5], xo[6], xo[7]};
                }
    }
    __device__ __forceinline__ void operator()(const f32x4 (&acc)[2][2][4][2], const pg8::Unit& u, int wr, int wc, int fr, int fq) const {
        LAS float* part = (LAS float*)((LAS unsigned char*)lds + MISC_OFF + 1024);
#pragma unroll
        for (int aim = 0; aim < 4; ++aim) {
            const int ai = aim >> 1;
#pragma unroll
            for (int m2 = 0; m2 < 2; ++m2) {
                const int m = 2 * (aim & 1) + m2;
                const int rt = ai * 128 + wr * 64 + m * 16 + fr, row = u.pm * 256 + rt;
                float ssq = 0.f;
#pragma unroll
                for (int bj = 0; bj < 2; ++bj) {
                    const int col = u.pn * 256 + bj * 128 + wc * 32 + fq * 8;
                    const size_t off = (size_t)row * DM + col;
                    u32x4 w;
                    w[0] = cvtpk(acc[ai][bj][m][0][0], acc[ai][bj][m][0][1]); w[1] = cvtpk(acc[ai][bj][m][0][2], acc[ai][bj][m][0][3]);
                    w[2] = cvtpk(acc[ai][bj][m][1][0], acc[ai][bj][m][1][1]); w[3] = cvtpk(acc[ai][bj][m][1][2], acc[ai][bj][m][1][3]);
                    *(u32x4*)(XB + off) = w;
                    float xr[8]; unpack8(__builtin_bit_cast(bf16x8, w), xr);
#pragma unroll
                    for (int e = 0; e < 8; ++e) ssq = fmaf(xr[e], xr[e], ssq);
                }
                ssq = sum32x_f(sum16x_f(ssq));
                if (fq == 0) part[rt * 4 + wc] = ssq;
            }
            asm volatile("" ::: "memory");
        }
        __syncthreads();
        const int tid = (wr * 4 + wc) * 64 + fq * 16 + fr;
        if (tid < 256) { const f32x4 p4 = *(const LAS f32x4*)(part + tid * 4); RS[(size_t)(u.pm * 256 + tid) * 4 + u.pn] = (p4[0] + p4[1]) + (p4[2] + p4[3]); }
    }
};

struct Frame {
    unsigned char* lds; int wave, G;
    unsigned char* ws;
    __device__ __forceinline__ int lane_() const { return lane_id(); }
    __device__ __forceinline__ int tid_() const { return wave * 64 + lane_id(); }
    __device__ __forceinline__ unsigned* ctl_() const { return (unsigned*)(ws + WS_CTL); }
    __device__ __forceinline__ bf16_t* WIT_() const { return (bf16_t*)(ws + WS_WIT); }
    __device__ __forceinline__ bf16_t* WOT_() const { return (bf16_t*)(ws + WS_WOT); }
    __device__ __forceinline__ bf16_t* WCT_() const { return (bf16_t*)(ws + WS_WCT); }
    __device__ __forceinline__ bf16_t* PWT_() const { return (bf16_t*)(ws + WS_PWT); }
    __device__ __forceinline__ bf16_t* KCMP_() const { return (bf16_t*)(ws + WS_KCMP); }
    __device__ __forceinline__ bf16_t* VCMP_() const { return (bf16_t*)(ws + WS_VCMP); }
    __device__ __forceinline__ bf16_t* XB_() const { return (bf16_t*)(ws + WS_XB); }
    __device__ __forceinline__ bf16_t* Z_() const { return (bf16_t*)(ws + WS_Z); }
    __device__ __forceinline__ bf16_t* MIXED_() const { return (bf16_t*)(ws + WS_MIXED); }
    __device__ __forceinline__ f32x2* CS_() const { return (f32x2*)(ws + WS_CS); }
    __device__ __forceinline__ float* RS_() const { return (float*)(ws + WS_RS); }
    __device__ __forceinline__ float* WIF_() const { return (float*)(ws + WS_WIF); }
    __device__ __forceinline__ float* BGF_() const { return (float*)(ws + WS_BGF); }
    __device__ __forceinline__ unsigned* MASK_() const { return (unsigned*)(ws + WS_MASK); }
    __device__ __forceinline__ float* KP_() const { return (float*)(ws + WS_KP); }
    __device__ __forceinline__ unsigned* KMAX_() const { return (unsigned*)(ws + WS_CTL) + 8192; }
};

__device__ __forceinline__ int next_item(Frame& F, int q) {
    volatile unsigned* slot = (volatile unsigned*)(F.lds + MISC_OFF);
    __syncthreads();
    if (F.tid_() == 0) slot[0] = atomicAdd(F.ctl_() + 64 * q, 1u);
    __syncthreads();
    return __builtin_amdgcn_readfirstlane((int)slot[0]);
}
__device__ __forceinline__ unsigned xcc_id() { return (unsigned)__builtin_amdgcn_s_getreg((3 << 11) | 20) & 0xFu; }
__device__ __forceinline__ bool next_item_batch(Frame& F, int qfirst, int nitems, int& b, int& it) {
    const int home = (int)(xcc_id() & 7u);
    { const int v = next_item(F, qfirst + home); if (v < nitems) { b = home; it = v; return true; } }
    volatile unsigned* slot = (volatile unsigned*)(F.lds + MISC_OFF);
    for (;;) {
        __syncthreads();
        if (F.wave == 0) {
            const int l = F.lane_();
            unsigned c = 0xffffffffu;
            if (l < 8) c = __hip_atomic_load(F.ctl_() + 64 * (qfirst + l), __ATOMIC_RELAXED, __HIP_MEMORY_SCOPE_AGENT);
            const unsigned long long m = __ballot(c < (unsigned)nitems);
            if (l == 0) slot[1] = (unsigned)m;
        }
        __syncthreads();
        const unsigned mask = (unsigned)__builtin_amdgcn_readfirstlane((int)slot[1]) & 0xffu;
        if (mask == 0u) return false;
        const unsigned rot = ((mask >> home) | (mask << (8 - home))) & 0xffu;
        const int bq = (home + __builtin_ctz(rot)) & 7;
        const int v = next_item(F, qfirst + bq);
        if (v < nitems) { b = bq; it = v; return true; }
    }
}

template <int MAP>
__device__ __forceinline__ void transpose_item(const float* W, int K, int Nsrc, bf16_t* WT, int nblk, const float* kscale, float* scr, int item, int lane) {
    const int kb = item / nblk, nb = item % nblk, k0 = 64 * kb, n0 = 32 * nb;
    int sc = n0 + (lane & 31);
    if (MAP == 1) sc = src_col(sc);
    float vv[32], ks_[32];
    const int scc = sc >= 0 ? sc : 0;
#pragma unroll
    for (int i = 0; i < 32; ++i) { const int kk = 2 * i + (lane >> 5); vv[i] = W[(size_t)(k0 + kk) * Nsrc + scc]; ks_[i] = kscale ? kscale[k0 + kk] : 1.f; }
#pragma unroll
    for (int i = 0; i < 32; ++i) { const int kk = 2 * i + (lane >> 5); scr[kk * 33 + (lane & 31)] = (sc >= 0) ? vv[i] * ks_[i] : 0.f; }
    asm volatile("s_waitcnt lgkmcnt(0)" ::: "memory");
    const int c = lane & 7;
#pragma unroll
    for (int j = 0; j < 4; ++j) {
        const int n = (lane >> 3) + 8 * j; const float* s = scr + (8 * c) * 33 + n;
        u32x4 o; o[0] = cvtpk(s[0 * 33], s[1 * 33]); o[1] = cvtpk(s[2 * 33], s[3 * 33]); o[2] = cvtpk(s[4 * 33], s[5 * 33]); o[3] = cvtpk(s[6 * 33], s[7 * 33]);
        *(u32x4*)(WT + (size_t)(n0 + n) * K + k0 + 8 * c) = o;
    }
    asm volatile("s_waitcnt lgkmcnt(0)" ::: "memory");
}

__device__ __forceinline__ void sincos_d(double x, float& c, float& s) {
    const double TWO_OVER_PI = 0.63661977236758134308, PIO2_HI = 1.57079632679489655800e+00, PIO2_LO = 6.12323399573676603587e-17;
    const double kd = __builtin_rint(x * TWO_OVER_PI);
    const double r = (x - kd * PIO2_HI) - kd * PIO2_LO;
    const double r2 = r * r;
    double sp = -1.0 / 1307674368000.0;
    sp = sp * r2 + 1.0 / 6227020800.0;
    sp = sp * r2 - 1.0 / 39916800.0;
    sp = sp * r2 + 1.0 / 362880.0;
    sp = sp * r2 - 1.0 / 5040.0;
    sp = sp * r2 + 1.0 / 120.0;
    sp = sp * r2 - 1.0 / 6.0;
    const double sn = r + r * r2 * sp;
    double cp = 1.0 / 20922789888000.0;
    cp = cp * r2 - 1.0 / 87178291200.0;
    cp = cp * r2 + 1.0 / 479001600.0;
    cp = cp * r2 - 1.0 / 3628800.0;
    cp = cp * r2 + 1.0 / 40320.0;
    cp = cp * r2 - 1.0 / 720.0;
    cp = cp * r2 + 1.0 / 24.0;
    cp = cp * r2 - 0.5;
    const double cn = 1.0 + r2 * cp;
    const int q = ((int)kd) & 3;
    const double cc = (q == 0) ? cn : (q == 1) ? -sn : (q == 2) ? -cn : sn;
    const double ss = (q == 0) ? sn : (q == 1) ? cn : (q == 2) ? -sn : -cn;
    c = (float)cc; s = (float)ss;
}

__device__ __forceinline__ void phase_prologue(Frame& F, const Params& P) {
    float* scr = (float*)(F.lds + F.wave * 16384);
    const int gw = blockIdx.x * 8 + F.wave, NGW = F.G * 8;
    constexpr int I_IN = 16 * 112, I_OUT = 16 * 32, I_CMP = 32 * 2, I_POOL = 1 * 2;
    constexpr int N_IN = DEPTH * I_IN, N_OUT = DEPTH * I_OUT, N_CMP = DEPTH * 2 * I_CMP, N_POOL = DEPTH * 4 * I_POOL;
    for (int it = gw; it < N_IN + N_OUT + N_CMP + N_POOL; it += NGW) {
        int r = it;
        if (r < N_IN) { const int l = r / I_IN; transpose_item<1>(P.w_in + (size_t)l * DM * D_IN, DM, D_IN, F.WIT_() + (size_t)l * NZ * DM, 112, P.norm_w + l * DM, scr, r % I_IN, F.lane_()); continue; }
        r -= N_IN;
        if (r < N_OUT) { const int l = r / I_OUT; transpose_item<0>(P.w_out + (size_t)l * DM * DM, DM, DM, F.WOT_() + (size_t)l * DM * DM, 32, nullptr, scr, r % I_OUT, F.lane_()); continue; }
        r -= N_OUT;
        if (r < N_CMP) { const int lk = r / I_CMP, l = lk >> 1, kv = lk & 1; const float* W = (kv ? P.w_cmp_v : P.w_cmp_k) + (size_t)l * 2048 * 64;
            transpose_item<0>(W, 2048, 64, F.WCT_() + (size_t)lk * 64 * 2048, 2, nullptr, scr, r % I_CMP, F.lane_()); continue; }
        r -= N_CMP;
        { const int lg = r / I_POOL; transpose_item<0>(P.pool_w + (size_t)lg * 64 * 64, 64, 64, F.PWT_() + (size_t)lg * 64 * 64, 2, nullptr, scr, r % I_POOL, F.lane_()); }
    }
    {
        const float inv[8] = {1.000000000e+00f, 1.939227432e-01f, 3.760603070e-02f, 7.292664610e-03f, 1.414213562e-03f, 2.742481884e-04f, 5.318296098e-05f, 1.031338616e-05f};
        for (int i = blockIdx.x * 512 + F.tid_(); i < SEQ * 8; i += F.G * 512) {
            const int t = i >> 3, f = i & 7;
            float iv = inv[0];
#pragma unroll
            for (int k = 1; k < 8; ++k) iv = (f == k) ? inv[k] : iv;
            const float ang = (float)t * iv;
            float c, s; sincos_d((double)ang, c, s);
            F.CS_()[i] = (f32x2){c, s};
        }
    }
    for (int row0 = gw * 4; row0 < MROWS; row0 += NGW * 4) {
        f32x4 v[4][4];
#pragma unroll
        for (int r = 0; r < 4; ++r) { const f32x4* xr = (const f32x4*)(P.x + (size_t)(row0 + r) * DM) + F.lane_();
#pragma unroll
            for (int j = 0; j < 4; ++j) v[r][j] = xr[64 * j]; }
#pragma unroll
        for (int r = 0; r < 4; ++r) {
            u32x2* o8 = (u32x2*)(F.XB_() + (size_t)(row0 + r) * DM) + F.lane_();
            float s = 0.f;
#pragma unroll
            for (int j = 0; j < 4; ++j) {
                u32x2 w; w[0] = cvtpk(v[r][j][0], v[r][j][1]); w[1] = cvtpk(v[r][j][2], v[r][j][3]); o8[64 * j] = w;
                const float a0 = __uint_as_float(w[0] << 16), a1 = __uint_as_float(w[0] & 0xffff0000u), a2 = __uint_as_float(w[1] << 16), a3 = __uint_as_float(w[1] & 0xffff0000u);
                s += (a0 * a0 + a1 * a1) + (a2 * a2 + a3 * a3);
            }
            s = wave_sum_f(s);
            if (F.lane_() < 4) F.RS_()[(size_t)(row0 + r) * 4 + F.lane_()] = (F.lane_() == 0) ? s : 0.f;
        }
    }
}

__device__ __forceinline__ void compress_item(Frame& F, const Params& P, int layer, int bitem) {
    const int witem = bitem;
    const int kv = witem & 1, ng = (witem >> 1) & 15, b = witem >> 5;
    int tid_ = F.tid_(); asm volatile("" : "+v"(tid_));
    const int lane = tid_ & 63, c = lane & 15, G = lane >> 4;
    const int n = 16 * ng + c, nc = n > 254 ? 254 : n;
    const bf16_t* zrow = F.Z_() + ((size_t)b * SEQ + 16 * nc) * NZ + (kv ? ZVC : ZKC) + 8 * G;
    const float* pe = P.pe_cmp + (size_t)layer * 32 * 64 + 8 * G;
    const bf16_t* wt = F.WCT_() + (size_t)(layer * 2 + kv) * 64 * 2048 + (size_t)c * 2048 + 8 * G;
    f32x4 acc[4];
#pragma unroll
    for (int nt = 0; nt < 4; ++nt) acc[nt] = (f32x4){0.f, 0.f, 0.f, 0.f};
#pragma unroll
    for (int kk = 0; kk < 8; ++kk) {
        const int ks = 8 * F.wave + kk;
        const int i = ks >> 1, d0 = 32 * (ks & 1);
        const bf16x8 zr = *(const bf16x8*)(zrow + (size_t)i * NZ + d0);
        const f32x4 p0 = *(const f32x4*)(pe + i * 64 + d0), p1 = *(const f32x4*)(pe + i * 64 + d0 + 4);
        float f[8]; unpack8(zr, f);
        u32x4 aw; aw[0] = cvtpk(f[0] + p0[0], f[1] + p0[1]); aw[1] = cvtpk(f[2] + p0[2], f[3] + p0[3]); aw[2] = cvtpk(f[4] + p1[0], f[5] + p1[1]); aw[3] = cvtpk(f[6] + p1[2], f[7] + p1[3]);
        const bf16x8 af = __builtin_bit_cast(bf16x8, aw);
#pragma unroll
        for (int nt = 0; nt < 4; ++nt) {
            const bf16x8 bf = *(const bf16x8*)(wt + (size_t)nt * 16 * 2048 + ks * 32);
            acc[nt] = __builtin_amdgcn_mfma_f32_16x16x32_bf16(af, bf, acc[nt], 0, 0, 0);
        }
    }
    {
        LAS float* red = (LAS float*)((LAS unsigned char*)F.lds) + F.wave * 1024 + lane;
#pragma unroll
        for (int nt = 0; nt < 4; ++nt)
#pragma unroll
            for (int e = 0; e < 4; ++e) red[(nt * 4 + e) * 64] = acc[nt][e];
    }
    __syncthreads();
    if (__builtin_amdgcn_readfirstlane(F.wave) == 0) {
    {
        const LAS float* red = (const LAS float*)((LAS unsigned char*)F.lds) + lane;
#pragma unroll
        for (int nt = 0; nt < 4; ++nt)
#pragma unroll
            for (int e = 0; e < 4; ++e) {
                float sacc = red[(nt * 4 + e) * 64];
#pragma unroll
                for (int w = 1; w < 8; ++w) sacc += red[w * 1024 + (nt * 4 + e) * 64];
                acc[nt][e] = sacc;
            }
    }
    bf16_t* dst = (kv ? F.VCMP_() : F.KCMP_()) + (size_t)b * 256 * 64;
#pragma unroll
    for (int nt = 0; nt < 4; ++nt)
#pragma unroll
        for (int e = 0; e < 4; ++e) {
            const int nn = 16 * ng + 4 * G + e;
            float v = acc[nt][e];
            int dcol = 16 * nt + c;
            if (kv == 0) {
                if (nt == 0) {
                    const float partner = dpp_f<0x128>(v);
                    const int tpos = 16 * nn + 31;
                    const f32x2 cs = F.CS_()[(tpos & (SEQ - 1)) * 8 + (c & 7)];
                    v = (c < 8) ? (v * cs[0] - partner * cs[1]) : (v * cs[0] + partner * cs[1]);
                }
                dcol = perm64(dcol);
            }
            if (nn > 254) v = 0.f;
            dst[(size_t)nn * 64 + dcol] = (bf16_t)(cvtpk(v, 0.f) & 0xffffu);
        }
    }
}

__device__ __forceinline__ void select_item(Frame& F, int b, int qg) {
    int tid_ = F.tid_(); asm volatile("" : "+v"(tid_));
    const int lane = tid_ & 63, half = lane >> 5, idx = lane & 31, c = lane & 15, G = lane >> 4;
    const int tA = qg * 16 + F.wave * 2, tq = tA + half;
    const size_t rowbase = (size_t)b * SEQ;
#if defined(ABL_SC2)
    const bf16x8 afrag = (bf16x8){(short)0x3f80, (short)0xbf80, (short)0x3f00, (short)0x3f80, (short)0x4000, (short)0xbf00, (short)0x3f80, (short)0x3e80};
#else
    const bf16x8 afrag = *(const bf16x8*)(F.Z_() + (rowbase + tA + (c >> 3)) * NZ + ZQI + (c & 7) * 32 + G * 8);
#endif
#if !(defined(ABL_SC1))
    s16x4 wX, wY;
    {
        const int wrow = c, kg = G;
        const f32x4 wv = *(const f32x4*)(F.WIF_() + (rowbase + tA + (kg >> 1)) * 8 + 4 * (kg & 1));
        const unsigned p01 = cvtpk(wv[0], wv[1]), p23 = cvtpk(wv[2], wv[3]);
        const bool onX = (wrow == 8 * (kg >> 1)), onY = (wrow == 8 * (kg >> 1) + 4);
        const unsigned x01 = onX ? p01 : 0u, x23 = onX ? p23 : 0u, y01 = onY ? p01 : 0u, y23 = onY ? p23 : 0u;
        wX = __builtin_bit_cast(s16x4, (u32x2){x01, x23}); wY = __builtin_bit_cast(s16x4, (u32x2){y01, y23});
    }
    const bf16x8 wXY = (bf16x8){wX[0], wX[1], wX[2], wX[3], wY[0], wY[1], wY[2], wY[3]};
#endif
#if defined(ABL_SC1)
    const f32x4 w4 = (f32x4){1.f, 0.5f, -0.25f, 2.f};
#endif
    const int nchunks = ((qg * 16) >> 8) + 1;
    constexpr int SEL_NBUF = 6, SEL_D = 4;
    LAS unsigned char* kl = (LAS unsigned char*)F.lds;
    const unsigned char* zb = (const unsigned char*)F.Z_();
    const int pk0 = 32 * F.wave + (lane >> 2);
#define SEL_G(k_) ((0x78u >> (2 * (k_))) & 3u)
    const int pG = (lane & 3) ^ (int)SEL_G((lane >> 4) & 3);
    unsigned soff = (unsigned)(((rowbase + pk0) * NZ + ZKI + pG * 8) * 2);
    const unsigned rbase = c * 64 + ((G ^ SEL_G((c >> 2) & 3)) << 4);
#undef SEL_G
    const int nch1 = nchunks - 1;
#define SEL_DMA(chunk_) do { const int cc_ = (chunk_) < nch1 ? (chunk_) : nch1; const unsigned so_ = soff + (unsigned)cc_ * (256u * NZ * 2u); \
        LAS unsigned char* dst_ = kl + ((chunk_) % SEL_NBUF) * 16384 + F.wave * 2048; \
        __builtin_amdgcn_global_load_lds((const unsigned*)(zb + so_), (LAS unsigned*)dst_, 16, 0, 0); \
        __builtin_amdgcn_global_load_lds((const unsigned*)(zb + so_ + 16u * NZ * 2u), (LAS unsigned*)(dst_ + 1024), 16, 0, 0); } while (0)
#pragma unroll
    for (int i = 0; i < SEL_D; ++i) SEL_DMA(i);
    unsigned u[128];
#pragma unroll
    for (int ch = 0; ch < 16; ++ch) {
        if (ch < nchunks) {
            SEL_DMA(ch + SEL_D);
            asm volatile("s_waitcnt vmcnt(%0)" :: "n"(2 * SEL_D) : "memory");
            __builtin_amdgcn_s_barrier();
            asm volatile("" ::: "memory");
            const LAS unsigned char* kb = kl + (ch % SEL_NBUF) * 16384 + rbase;
            typedef short s16x2_ __attribute__((ext_vector_type(2)));
            const s16x2_ z2 = (s16x2_){0, 0};
            bf16x8 kfr[3][2]; f32x4 xq[2], yq[2], scq[2];
            kfr[0][0] = *(const LAS bf16x8*)(kb); kfr[0][1] = *(const LAS bf16x8*)(kb + 1024);
            kfr[1][0] = *(const LAS bf16x8*)(kb + 2048); kfr[1][1] = *(const LAS bf16x8*)(kb + 3072);
#pragma unroll
            for (int t = 0; t < 10; ++t) {
                if (t + 2 < 8) { kfr[(t + 2) % 3][0] = *(const LAS bf16x8*)(kb + (2 * t + 4) * 1024); kfr[(t + 2) % 3][1] = *(const LAS bf16x8*)(kb + (2 * t + 5) * 1024); }
                if (t < 8) {
                    xq[t & 1] = __builtin_amdgcn_mfma_f32_16x16x32_bf16(afrag, kfr[t % 3][0], (f32x4){0.f, 0.f, 0.f, 0.f}, 0, 0, 0);
                    yq[t & 1] = __builtin_amdgcn_mfma_f32_16x16x32_bf16(afrag, kfr[t % 3][1], (f32x4){0.f, 0.f, 0.f, 0.f}, 0, 0, 0);
                }
                __builtin_amdgcn_sched_barrier(0);
                if (t >= 1 && t <= 8) {
                    const f32x4 x = xq[(t - 1) & 1], y = yq[(t - 1) & 1];
                    const unsigned bx0 = __builtin_bit_cast(unsigned, __builtin_elementwise_max(__builtin_bit_cast(s16x2_, cvtpk(x[0], x[1])), z2));
                    const unsigned bx1 = __builtin_bit_cast(unsigned, __builtin_elementwise_max(__builtin_bit_cast(s16x2_, cvtpk(x[2], x[3])), z2));
                    const unsigned by0 = __builtin_bit_cast(unsigned, __builtin_elementwise_max(__builtin_bit_cast(s16x2_, cvtpk(y[0], y[1])), z2));
                    const unsigned by1 = __builtin_bit_cast(unsigned, __builtin_elementwise_max(__builtin_bit_cast(s16x2_, cvtpk(y[2], y[3])), z2));
                    scq[(t - 1) & 1] = __builtin_amdgcn_mfma_f32_16x16x32_bf16(wXY, __builtin_bit_cast(bf16x8, (u32x4){bx0, bx1, by0, by1}), (f32x4){0.f, 0.f, 0.f, 0.f}, 0, 0, 0);
                }
                if (t >= 2) {
                    const int j = ch * 8 + t - 2;
                    const unsigned bits = __float_as_uint(scq[(t - 2) & 1][0]);
                    const unsigned ku = bits ^ ((unsigned)((int)bits >> 31) | 0x80000000u);
                    u[j] = ((32 * j + idx) <= tq) ? ku : 0u;
                }
                __builtin_amdgcn_sched_barrier(0);
            }
        } else {
#pragma unroll
            for (int jj = 0; jj < 8; ++jj) u[ch * 8 + jj] = 0u;
        }
    }
#undef SEL_DMA
    asm volatile("s_waitcnt vmcnt(0)" ::: "memory");
    unsigned myw[4] = {0u, 0u, 0u, 0u};
    if (qg < 16) {
#pragma unroll
        for (int jj = 0; jj < 8; ++jj) {
            const unsigned long long bal = __ballot(u[jj] != 0u);
            asm volatile("s_nop 1\n\tv_writelane_b32 %0, %1, %2" : "+v"(myw[0]) : "s"((unsigned)bal), "n"(jj));
            asm volatile("s_nop 1\n\tv_writelane_b32 %0, %1, %2" : "+v"(myw[0]) : "s"((unsigned)(bal >> 32)), "n"(32 + jj));
        }
    } else {
        const int nw = (nchunks + 3) >> 2;
#pragma unroll
        for (int w = 0; w < 4; ++w) {
            if (w < nw) {
#define TR_STAGE(J, M) _Pragma("unroll") for (int k = 0; k < 32; ++k) { if ((k & (J)) == 0) { \
                    const unsigned t_ = ((u[32 * w + k] >> (J)) ^ u[32 * w + k + (J)]) & (M); u[32 * w + k + (J)] ^= t_; u[32 * w + k] ^= (t_ << (J)); } }
#define TR_PERM(J, SA, SB) _Pragma("unroll") for (int k = 0; k < 32; ++k) { if ((k & (J)) == 0) { \
                    const unsigned a_ = u[32 * w + k], b_ = u[32 * w + k + (J)]; u[32 * w + k] = __builtin_amdgcn_perm(b_, a_, (SA)); u[32 * w + k + (J)] = __builtin_amdgcn_perm(b_, a_, (SB)); } }
                TR_PERM(16, 0x05040100u, 0x07060302u) TR_PERM(8, 0x06020400u, 0x07030501u) TR_STAGE(4, 0x0f0f0f0fu) TR_STAGE(2, 0x33333333u) TR_STAGE(1, 0x55555555u)
#undef TR_PERM
#undef TR_STAGE
            }
        }
        unsigned gt[4] = {0u, 0u, 0u, 0u}, eq[4];
#pragma unroll
        for (int w = 0; w < 4; ++w) eq[w] = (w < nw) ? 0xffffffffu : 0u;
        bool done = false, exact = false;
#pragma unroll
        for (int bit = 31; bit >= 0; --bit) {
            if (!__all(done)) {
                int cnt = 0;
#pragma unroll
                for (int w = 0; w < 4; ++w) { if (w < nw) cnt += __popc(gt[w] | (eq[w] & u[32 * w + bit])); }
                cnt = sum32_i(cnt);
                if (!done) {
                    const bool acc = cnt >= 256;
#pragma unroll
                    for (int w = 0; w < 4; ++w) {
                        if (w < nw) { const unsigned t_ = eq[w] & u[32 * w + bit]; gt[w] = acc ? gt[w] : (gt[w] | t_); eq[w] = acc ? t_ : (eq[w] ^ t_); }
                    }
                    if (cnt == 256) { done = true; exact = true; }
                }
            }
        }
        unsigned selw[4];
#pragma unroll
        for (int w = 0; w < 4; ++w) selw[w] = exact ? (gt[w] | eq[w]) : gt[w];
        if (!__all(exact)) {
            int ngt = 0;
#pragma unroll
            for (int w = 0; w < 4; ++w) ngt += __popc(gt[w]);
            ngt = sum32_i(ngt);
            const int need = 256 - ngt;
            int run = 0;
#pragma unroll
            for (int w = 0; w < 4; ++w) {
                if (w < nw) {
#pragma unroll
                    for (int i = 0; i < 32; ++i) {
                        const bool e = (!exact) && ((eq[w] >> i) & 1u);
                        const unsigned long long bq = __ballot(e);
                        const unsigned hm = half ? (unsigned)(bq >> 32) : (unsigned)bq;
                        const int below = __popc(hm & ((1u << idx) - 1u));
                        if (e && (run + below < need)) selw[w] |= (1u << i);
                        run += __popc(hm);
                    }
                }
            }
        }
#pragma unroll
        for (int w = 0; w < 4; ++w) {
            if (w < nw) {
#pragma unroll
                for (int i = 0; i < 32; ++i) {
                    const unsigned long long bal = __ballot((selw[w] >> i) & 1u);
                    asm volatile("s_nop 1\n\tv_writelane_b32 %0, %1, %2" : "+v"(myw[w]) : "s"((unsigned)bal), "n"(i));
                    asm volatile("s_nop 1\n\tv_writelane_b32 %0, %1, %2" : "+v"(myw[w]) : "s"((unsigned)(bal >> 32)), "n"(32 + i));
                }
            }
        }
    }
    unsigned* mrow = F.MASK_() + (rowbase + tq) * 128;
#pragma unroll
    for (int k = 0; k < 4; ++k) mrow[32 * k + idx] = myw[k];
}

template <int VAR>
__device__ __forceinline__ void convpool_item(Frame& F, const Params& P, int layer, int item) {
    int tid_ = F.tid_(); asm volatile("" : "+v"(tid_));
    const int lane = tid_ & 63;
    const int tok0 = item * 128 + F.wave * 16;
    LAS unsigned char* dub = (LAS unsigned char*)F.lds;
#pragma unroll
    for (int i = 0; i < 9; ++i) {
        const int r = 18 * F.wave + 2 * i + (lane >> 5), p = lane & 31;
        int grow = item * 128 - 16 + r; grow = grow < 0 ? 0 : grow;
        __builtin_amdgcn_global_load_lds((const unsigned*)(F.Z_() + (size_t)grow * NZ + ZDU + 8 * (p ^ (r & 15))), (LAS unsigned*)(dub + (18 * F.wave + 2 * i) * 512), 16, 0, 0);
    }
    if (VAR != 2) {
        const int h = lane >> 5, ch = lane & 31;
        const int t0h = tok0 + 8 * h, tp0 = t0h & (SEQ - 1);
        const bf16_t* zb = F.Z_() + (size_t)t0h * NZ + 8 * ch;
        const float* cw = P.conv_w + (size_t)layer * 3 * 256 + 8 * ch;
        bf16x8 rc[10], rx[10], ra[8], rg[8];
#pragma unroll
        for (int i = 0; i < 10; ++i) { const int d = i - 2; const int dd = (tp0 + d >= 0) ? d : 0;
            rc[i] = *(const bf16x8*)(zb + (ptrdiff_t)dd * NZ + ZCC); rx[i] = *(const bf16x8*)(zb + (ptrdiff_t)dd * NZ + ZCX); }
#pragma unroll
        for (int i = 0; i < 8; ++i) { ra[i] = *(const bf16x8*)(zb + (size_t)i * NZ + ZCB); rg[i] = *(const bf16x8*)(zb + (size_t)i * NZ + ZGC); }
        float w0[8], w1[8], w2[8];
        { const f32x4 a0 = *(const f32x4*)(cw), a1 = *(const f32x4*)(cw + 4), b0 = *(const f32x4*)(cw + 256), b1 = *(const f32x4*)(cw + 260), c0 = *(const f32x4*)(cw + 512), c1 = *(const f32x4*)(cw + 516);
#pragma unroll
          for (int e = 0; e < 4; ++e) { w0[e] = a0[e]; w0[4 + e] = a1[e]; w1[e] = b0[e]; w1[4 + e] = b1[e]; w2[e] = c0[e]; w2[4 + e] = c1[e]; } }
        float um2[8], um1[8];
        { float cc[8], cx[8]; unpack8(rc[0], cc); unpack8(rx[0], cx); const float z = (tp0 >= 2) ? 1.f : 0.f;
#pragma unroll
          for (int e = 0; e < 8; ++e) um2[e] = cc[e] * cx[e] * z; }
        { float cc[8], cx[8]; unpack8(rc[1], cc); unpack8(rx[1], cx); const float z = (tp0 >= 1) ? 1.f : 0.f;
#pragma unroll
          for (int e = 0; e < 8; ++e) um1[e] = cc[e] * cx[e] * z; }
#pragma unroll
        for (int i = 0; i < 8; ++i) {
            float cc[8], cx[8], a[8], bq[8], u[8], o[8];
            unpack8(rc[i + 2], cc); unpack8(rx[i + 2], cx); unpack8(ra[i], a); unpack8(rg[i], bq);
#pragma unroll
            for (int e = 0; e < 8; ++e) { u[e] = cc[e] * cx[e]; o[e] = bq[e] * (a[e] * (um2[e] * w0[e] + um1[e] * w1[e] + u[e] * w2[e])); }
            u32x4 w; w[0] = cvtpk(o[0], o[1]); w[1] = cvtpk(o[2], o[3]); w[2] = cvtpk(o[4], o[5]); w[3] = cvtpk(o[6], o[7]);
            *(u32x4*)(F.MIXED_() + (size_t)(t0h + i) * DM + 512 + 8 * ch) = w;
#pragma unroll
            for (int e = 0; e < 8; ++e) { um2[e] = um1[e]; um1[e] = u[e]; }
        }
    }
    const int tk = lane & 15, G = lane >> 4, row = tok0 + tk, tpos = row & (SEQ - 1);
    const bf16_t* zr = F.Z_() + (size_t)row * NZ;
    {
        const int zk[3] = {ZKA, ZKS, ZKW};
#pragma unroll
        for (int ty = 0; ty < 3; ++ty) {
            float f0[8], f1[8]; unpack8(*(const bf16x8*)(zr + zk[ty] + 16 * G), f0); unpack8(*(const bf16x8*)(zr + zk[ty] + 16 * G + 8), f1);
            float ss = 0.f;
#pragma unroll
            for (int e = 0; e < 8; ++e) ss += f0[e] * f0[e] + f1[e] * f1[e];
            ss = sum32x_f(sum16x_f(ss));
            ss = fmaxf(ss, dpp_f<0xB1>(ss)); ss = fmaxf(ss, dpp_f<0x4E>(ss)); ss = fmaxf(ss, dpp_f<0x141>(ss)); ss = fmaxf(ss, dpp_f<0x140>(ss));
            if (lane == 0) F.KP_()[((layer * 8 + (row >> 12)) * 3 + ty) * 256 + (item & 31) * 8 + F.wave] = ss;
        }
    }
    asm volatile("s_waitcnt vmcnt(0)" ::: "memory");
    __syncthreads();
    const int lr = 16 + 16 * F.wave + tk;
    bf16x8 wfr[2][4]; f32x4 scv[4]; s16x4 gtv[4];
#define POOL_LOAD_W(GG) do { _Pragma("unroll") for (int ks = 0; ks < 2; ++ks) _Pragma("unroll") for (int dt = 0; dt < 4; ++dt) \
            wfr[ks][dt] = *(const bf16x8*)(F.PWT_() + (size_t)(layer * 4 + (GG)) * 4096 + (size_t)(16 * dt + tk) * 64 + 32 * ks + 8 * G); \
        _Pragma("unroll") for (int dt = 0; dt < 4; ++dt) { const int dcol = (GG) * 64 + 16 * dt + 4 * G; scv[dt] = *(const f32x4*)(P.pool_scale + (size_t)layer * 256 + dcol); gtv[dt] = *(const s16x4*)(zr + ZGD + dcol); } } while (0)
    POOL_LOAD_W(0);
#pragma unroll
    for (int g = 0; g < (VAR == 3 ? 0 : 4); ++g) {
        const int win = 2 << g;
        const int cntw = (tpos + 1 < win) ? (tpos + 1) : win;
        const float invc = 1.0f / (float)cntw;
        f32x4 acc[4];
#pragma unroll
        for (int dt = 0; dt < 4; ++dt) acc[dt] = (f32x4){0.f, 0.f, 0.f, 0.f};
        u32x4 pwk[2];
#pragma unroll
        for (int ks = 0; ks < 2; ++ks) {
            const int c = g * 8 + 4 * ks + G;
            float sum[8], self[8];
            unpack8(*(const LAS bf16x8*)(dub + lr * 512 + ((c ^ (lr & 15)) << 4)), self);
#pragma unroll
            for (int e = 0; e < 8; ++e) sum[e] = self[e];
#pragma unroll
            for (int j = 1; j < win; ++j) { const bool in = (j <= tpos); const int rr = lr - (in ? j : 0); float f[8]; unpack8(*(const LAS bf16x8*)(dub + rr * 512 + ((c ^ (rr & 15)) << 4)), f); const float wgt = in ? 1.f : 0.f;
#pragma unroll
                for (int e = 0; e < 8; ++e) sum[e] = fmaf(wgt, f[e], sum[e]); }
#pragma unroll
            for (int e = 0; e < 4; ++e) pwk[ks][e] = cvtpk(sum[2 * e] * invc - self[2 * e], sum[2 * e + 1] * invc - self[2 * e + 1]);
        }
#pragma unroll
        for (int ks = 0; ks < 2; ++ks) {
            const bf16x8 pf = __builtin_bit_cast(bf16x8, pwk[ks]);
#pragma unroll
            for (int dt = 0; dt < 4; ++dt) acc[dt] = __builtin_amdgcn_mfma_f32_16x16x32_bf16(wfr[ks][dt], pf, acc[dt], 0, 0, 0);
        }
        u32x2 wo[4];
#pragma unroll
        for (int dt = 0; dt < 4; ++dt) {
            const f32x4 sc = scv[dt]; const s16x4 gt = gtv[dt];
            wo[dt][0] = cvtpk(acc[dt][0] * sc[0] * bf2f((unsigned short)gt[0]), acc[dt][1] * sc[1] * bf2f((unsigned short)gt[1]));
            wo[dt][1] = cvtpk(acc[dt][2] * sc[2] * bf2f((unsigned short)gt[2]), acc[dt][3] * sc[3] * bf2f((unsigned short)gt[3]));
        }
        if (g < 3) POOL_LOAD_W(g + 1);
#pragma unroll
        for (int dt = 0; dt < 4; ++dt) *(u32x2*)(F.MIXED_() + (size_t)row * DM + 768 + g * 64 + 16 * dt + 4 * G) = wo[dt];
    }
#undef POOL_LOAD_W
    __syncthreads();
}

__device__ __forceinline__ int crow(int r, int hi) { return (r & 3) + 8 * (r >> 2) + 4 * hi; }
__device__ __forceinline__ s16x4 vtr(const LAS unsigned char* p) { return __builtin_bit_cast(s16x4, __builtin_amdgcn_ds_read_tr16_b64_v4i16((LAS s16x4*)p)); }

struct AttnCtx {
    int tid, lane, r32, hi, wave, qs, h;
    int b, qb, t;
    unsigned char* lds;
    int st_key, st_chunk;
    unsigned kwoff, vwoff;
    unsigned kroff[2];
    unsigned vbase;
    int vq;
};

__device__ __forceinline__ void attn_ctx_init(AttnCtx& A, Frame& F, int b, int qb) {
    int tid_ = F.tid_(); asm volatile("" : "+v"(tid_));
    A.tid = tid_; A.lane = tid_ & 63; A.r32 = A.lane & 31; A.hi = A.lane >> 5; A.wave = F.wave; A.qs = F.wave >> 2; A.h = F.wave & 3;
    A.b = b; A.qb = qb; A.t = qb * 64 + A.qs * 32 + A.r32; A.lds = F.lds;
    A.st_key = tid_ >> 3; A.st_chunk = tid_ & 7;
    A.kwoff = A.st_key * 128 + ((A.st_chunk ^ ((A.st_key >> 1) & 7)) << 4);
    A.vwoff = A.st_key * 128 + ((A.st_chunk ^ (((A.st_key >> 1) & 1) << 2)) << 4);
    const int i = A.lane & 15, q = i >> 2, p = i & 3, g1 = (A.lane >> 4) & 1;
    A.vq = (q >> 1) & 1;
    A.vbase = (4 * A.hi + q) * 128 + (2 * g1 + (p >> 1)) * 16 + (p & 1) * 8;
}

__device__ __forceinline__ void k_frags(const AttnCtx& A, const LAS unsigned char* kb, bf16x8 (&kf)[8]) {
    const int k0 = A.r32, k1 = 32 + A.r32;
#pragma unroll
    for (int ks = 0; ks < 4; ++ks) {
        kf[2 * ks + 0] = *(const LAS bf16x8*)(kb + k0 * 128 + (((2 * ks + A.hi) ^ ((k0 >> 1) & 7)) << 4));
        kf[2 * ks + 1] = *(const LAS bf16x8*)(kb + k1 * 128 + (((2 * ks + A.hi) ^ ((k1 >> 1) & 7)) << 4));
    }
}
__device__ __forceinline__ void qk_mma(const bf16x8 (&kf)[8], const bf16x8 (&qf)[4], f32x16& p0, f32x16& p1) {
    p0 = (f32x16){0.f}; p1 = (f32x16){0.f};
#pragma unroll
    for (int ks = 0; ks < 4; ++ks) {
        p0 = __builtin_amdgcn_mfma_f32_32x32x16_bf16(kf[2 * ks + 0], qf[ks], p0, 0, 0, 0);
        p1 = __builtin_amdgcn_mfma_f32_32x32x16_bf16(kf[2 * ks + 1], qf[ks], p1, 0, 0, 0);
    }
}
__device__ __forceinline__ void qk_tile(const AttnCtx& A, const LAS unsigned char* kb, const bf16x8 (&qf)[4], f32x16& p0, f32x16& p1) {
    bf16x8 kf[8]; k_frags(A, kb, kf); qk_mma(kf, qf, p0, p1);
}
__device__ __forceinline__ void v_frags(const AttnCtx& A, const LAS unsigned char* vb, bf16x8 (&vf)[8]) {
#pragma unroll
    for (int s = 0; s < 4; ++s)
#pragma unroll
        for (int dt = 0; dt < 2; ++dt) {
            const LAS unsigned char* base = vb + A.vbase + (16 * s) * 128 + ((dt ^ A.vq) * 64);
            const s16x4 lo = vtr(base), hi4 = vtr(base + 8 * 128);
            vf[2 * s + dt] = (bf16x8){lo[0], lo[1], lo[2], lo[3], hi4[0], hi4[1], hi4[2], hi4[3]};
        }
}
__device__ __forceinline__ void p_pack(const f32x16& p0, const f32x16& p1, bf16x8 (&pf)[4]) {
#pragma unroll
    for (int s = 0; s < 4; ++s) {
        const f32x16& pp = (s >> 1) ? p1 : p0; const int rb = 8 * (s & 1);
        u32x4 pw; pw[0] = cvtpk(pp[rb + 0], pp[rb + 1]); pw[1] = cvtpk(pp[rb + 2], pp[rb + 3]); pw[2] = cvtpk(pp[rb + 4], pp[rb + 5]); pw[3] = cvtpk(pp[rb + 6], pp[rb + 7]);
        pf[s] = __builtin_bit_cast(bf16x8, pw);
    }
}
__device__ __forceinline__ void pv_mma(const bf16x8 (&vf)[8], const bf16x8 (&pf)[4], f32x16& o0, f32x16& o1) {
#pragma unroll
    for (int s = 0; s < 4; ++s) {
        o0 = __builtin_amdgcn_mfma_f32_32x32x16_bf16(vf[2 * s + 0], pf[s], o0, 0, 0, 0);
        o1 = __builtin_amdgcn_mfma_f32_32x32x16_bf16(vf[2 * s + 1], pf[s], o1, 0, 0, 0);
    }
}
__device__ __forceinline__ void pv_tile(const AttnCtx& A, const LAS unsigned char* vb, const f32x16& p0, const f32x16& p1, f32x16& o0, f32x16& o1) {
    bf16x8 vf[8], pf[4]; v_frags(A, vb, vf); p_pack(p0, p1, pf); pv_mma(vf, pf, o0, o1);
}
__device__ __forceinline__ float max16(const f32x16& p) {
    float a = fmaxf(fmaxf(p[0], p[1]), fmaxf(p[2], p[3])), b = fmaxf(fmaxf(p[4], p[5]), fmaxf(p[6], p[7]));
    float c = fmaxf(fmaxf(p[8], p[9]), fmaxf(p[10], p[11])), d = fmaxf(fmaxf(p[12], p[13]), fmaxf(p[14], p[15]));
    return fmaxf(fmaxf(a, b), fmaxf(c, d));
}
__device__ __forceinline__ float sum16(const f32x16& p) {
    return (((p[0] + p[1]) + (p[2] + p[3])) + ((p[4] + p[5]) + (p[6] + p[7]))) + (((p[8] + p[9]) + (p[10] + p[11])) + ((p[12] + p[13]) + (p[14] + p[15])));
}

__device__ __forceinline__ float mask_bit(float p, unsigned w, int pos) {
    const unsigned mk = (unsigned)__builtin_amdgcn_sbfe((int)w, pos, 1);
    return __uint_as_float((__float_as_uint(p) & mk) | (0xff800000u & ~mk));
}
template <int MODE>
__device__ __forceinline__ void tile_mask(const AttnCtx& A, f32x16& p0, f32x16& p1, bool active, unsigned w0, unsigned w1, bool blk, int kt, int iq) {
    if (active) {
        if (MODE == 0) {
#pragma unroll
            for (int r = 0; r < 16; ++r) { const int cpos = (r & 3) + 8 * (r >> 2); p0[r] = mask_bit(p0[r], w0, cpos); p1[r] = mask_bit(p1[r], w1, cpos); }
        } else if (MODE == 1) {
            const bool diag = (kt == A.qb);
#pragma unroll
            for (int r = 0; r < 16; ++r) { const int kp = crow(r, A.hi);
                p0[r] = (blk && (!diag || kp <= iq)) ? p0[r] : -INFINITY; p1[r] = (blk && (!diag || (kp + 32) <= iq)) ? p1[r] : -INFINITY; }
        } else {
            const bool diag = (kt == A.qb), tail = (kt == A.qb - 8);
            if (diag || tail) {
#pragma unroll
                for (int r = 0; r < 16; ++r) { const int kp = crow(r, A.hi);
                    const bool v0 = diag ? (kp <= iq) : (kp > iq), v1 = diag ? ((kp + 32) <= iq) : ((kp + 32) > iq);
                    p0[r] = v0 ? p0[r] : -INFINITY; p1[r] = v1 ? p1[r] : -INFINITY; }
            }
        }
    } else {
#pragma unroll
        for (int r = 0; r < 16; ++r) { p0[r] = -INFINITY; p1[r] = -INFINITY; }
    }
}

__device__ __forceinline__ void qk_mma_c(const bf16x8 (&kf)[8], const bf16x8 (&qf)[4], const f32x16& c0, const f32x16& c1, f32x16& p0, f32x16& p1) {
    p0 = __builtin_amdgcn_mfma_f32_32x32x16_bf16(kf[0], qf[0], c0, 0, 0, 0);
    p1 = __builtin_amdgcn_mfma_f32_32x32x16_bf16(kf[1], qf[0], c1, 0, 0, 0);
#pragma unroll
    for (int ks = 1; ks < 4; ++ks) {
        p0 = __builtin_amdgcn_mfma_f32_32x32x16_bf16(kf[2 * ks + 0], qf[ks], p0, 0, 0, 0);
        p1 = __builtin_amdgcn_mfma_f32_32x32x16_bf16(kf[2 * ks + 1], qf[ks], p1, 0, 0, 0);
    }
}
__device__ __forceinline__ float init_bit(float negref, unsigned w, int pos) {
    const unsigned mk = (unsigned)__builtin_amdgcn_sbfe((int)w, pos, 1);
    return __uint_as_float((__float_as_uint(negref) & mk) | (0xff800000u & ~mk));
}
__device__ __forceinline__ float q_norm2(const AttnCtx& A, const bf16x8 (&qf)[4]) {
    float ss = 0.f;
#pragma unroll
    for (int ks = 0; ks < 4; ++ks) { float f[8]; unpack8(qf[ks], f);
#pragma unroll
        for (int e = 0; e < 8; ++e) ss = fmaf(f[e], f[e], ss); }
    return sum32x_f(ss);
}

template <int MODE>
__device__ __forceinline__ void attn_stream(const AttnCtx& A, const bf16_t* Kg, const bf16_t* Vg, int kt0, int kt1, const bf16x8 (&qf)[4], float negref,
                                            f32x16& o0, f32x16& o1, float& lsum, const unsigned* mrow, unsigned long long bm) {
    LAS unsigned char* kbuf = (LAS unsigned char*)A.lds + L_K; LAS unsigned char* vbuf = (LAS unsigned char*)A.lds + L_V;
    LAS unsigned char* mbuf = (LAS unsigned char*)A.lds + L_IMP;
    const int iq = A.qs * 32 + A.r32;
    const int nsteps = (kt1 - kt0 + 2) >> 1;
    const int dkey = 8 * A.wave + (A.lane >> 3), dpc = A.lane & 7;
    const bf16_t* kgl = Kg + (size_t)dkey * NZ + 8 * (dpc ^ ((dkey >> 1) & 7));
    const bf16_t* vgl = Vg + (size_t)dkey * NZ + 8 * (dpc ^ (((dkey >> 1) & 1) << 2));
    const int wofs = A.wave * 1024;
    if (__builtin_amdgcn_readfirstlane(A.wave) >= 4) __builtin_amdgcn_s_setprio(1);
#define ATTN_DMA(STEP) do { const int ka_ = kt0 + 2 * (STEP), kb2_ = ka_ + 1; const int bo_ = ((STEP) & 1) * 16384 + wofs; \
        __builtin_amdgcn_global_load_lds((const unsigned*)(kgl + (size_t)ka_ * 64 * NZ), (LAS unsigned*)(kbuf + bo_), 16, 0, 0); \
        __builtin_amdgcn_global_load_lds((const unsigned*)(vgl + (size_t)ka_ * 64 * NZ), (LAS unsigned*)(vbuf + bo_), 16, 0, 0); \
        { const int kb3_ = kb2_ <= kt1 ? kb2_ : ka_;        \
            __builtin_amdgcn_global_load_lds((const unsigned*)(kgl + (size_t)kb3_ * 64 * NZ), (LAS unsigned*)(kbuf + bo_ + 8192), 16, 0, 0); \
            __builtin_amdgcn_global_load_lds((const unsigned*)(vgl + (size_t)kb3_ * 64 * NZ), (LAS unsigned*)(vbuf + bo_ + 8192), 16, 0, 0); } \
        if (MODE == 0) __builtin_amdgcn_global_load_lds((const unsigned*)(mrow + 2 * ka_), (LAS unsigned*)(mbuf + ((STEP) & 1) * 8192 + wofs), 16, 0, 0); \
    } while (0)
    ATTN_DMA(0);
    for (int s = 0; s < nsteps; ++s) {
        __syncthreads();
        if (s + 1 < nsteps) ATTN_DMA(s + 1);
        const int ktA = kt0 + 2 * s, ktB = ktA + 1; const bool haveB = ktB <= kt1;
        u32x2 cwA = (u32x2){0u, 0u}, cwB = (u32x2){0u, 0u};
        if (MODE == 0) { const u32x4 mw = *(const LAS u32x4*)(mbuf + (s & 1) * 8192 + wofs + 16 * A.lane); cwA[0] = mw[0]; cwA[1] = mw[1]; cwB[0] = haveB ? mw[2] : 0u; cwB[1] = haveB ? mw[3] : 0u; }
        const LAS unsigned char* kb = kbuf + (s & 1) * 16384; const LAS unsigned char* vb = vbuf + (s & 1) * 16384;
        bool blkA = true, blkB = haveB;
        if (MODE == 1) { blkA = (bm >> ktA) & 1ull; blkB = haveB && ((bm >> ktB) & 1ull); }
#define ATTN_CINIT(C0, C1, W0, W1, BLK) do { \
            if (MODE == 0) { _Pragma("unroll") for (int r = 0; r < 16; ++r) { const int cpos = (r & 3) + 8 * (r >> 2); C0[r] = init_bit(negref, (W0), cpos); C1[r] = init_bit(negref, (W1), cpos); } } \
            else { const float base = (BLK) ? negref : -INFINITY; _Pragma("unroll") for (int r = 0; r < 16; ++r) { C0[r] = base; C1[r] = base; } } } while (0)
#define ATTN_SOFT(P0, P1, PF, KT) do { \
            if (MODE == 1) { if ((KT) == A.qb) { _Pragma("unroll") for (int r = 0; r < 16; ++r) { const int kp = crow(r, A.hi); P0[r] = (kp <= iq) ? P0[r] : -INFINITY; P1[r] = ((kp + 32) <= iq) ? P1[r] : -INFINITY; } } } \
            if (MODE == 2) { const bool diag = ((KT) == A.qb), tail = ((KT) == A.qb - 8); if (diag || tail) { _Pragma("unroll") for (int r = 0; r < 16; ++r) { const int kp = crow(r, A.hi); \
                const bool v0 = diag ? (kp <= iq) : (kp > iq), v1 = diag ? ((kp + 32) <= iq) : ((kp + 32) > iq); P0[r] = v0 ? P0[r] : -INFINITY; P1[r] = v1 ? P1[r] : -INFINITY; } } } \
            _Pragma("unroll") for (int r = 0; r < 16; ++r) { P0[r] = fast_exp2(P0[r]); P1[r] = fast_exp2(P1[r]); } \
            lsum += sum16(P0) + sum16(P1); \
            p_pack(P0, P1, PF); } while (0)
        bf16x8 kf[8]; k_frags(A, kb, kf);
        f32x16 pA0, pA1; ATTN_CINIT(pA0, pA1, cwA[0] >> (4 * A.hi), cwA[1] >> (4 * A.hi), blkA);
        __builtin_amdgcn_sched_barrier(0);
        qk_mma_c(kf, qf, pA0, pA1, pA0, pA1);
        f32x16 pB0, pB1; ATTN_CINIT(pB0, pB1, cwB[0] >> (4 * A.hi), cwB[1] >> (4 * A.hi), blkB);
        __builtin_amdgcn_sched_barrier(0);
        k_frags(A, kb + 8192, kf);
        qk_mma_c(kf, qf, pB0, pB1, pB0, pB1);
        bf16x8 pfA[4]; ATTN_SOFT(pA0, pA1, pfA, ktA);
        __builtin_amdgcn_sched_barrier(0);
        bf16x8 vf[8]; v_frags(A, vb, vf);
        pv_mma(vf, pfA, o0, o1);
        bf16x8 pfB[4]; ATTN_SOFT(pB0, pB1, pfB, ktB);
        __builtin_amdgcn_sched_barrier(0);
        v_frags(A, vb + 8192, vf);
        pv_mma(vf, pfB, o0, o1);
#undef ATTN_SOFT
#undef ATTN_CINIT
    }
#undef ATTN_DMA
    __builtin_amdgcn_s_setprio(0);
    __syncthreads();
}

__device__ __forceinline__ void load_q(const AttnCtx& A, const bf16_t* Zq  , bf16x8 (&qf)[4]) {
    const bf16_t* qp = Zq + ((size_t)A.b * SEQ + A.t) * NZ + 64 * A.h + 8 * A.hi;
#pragma unroll
    for (int ks = 0; ks < 4; ++ks) qf[ks] = *(const bf16x8*)(qp + 16 * ks);
}
__device__ __forceinline__ void store_out(const AttnCtx& A, Frame& F, const f32x16& o0, const f32x16& o1, int zgate, int colbase) {
    const size_t row = (size_t)A.b * SEQ + A.t;
#pragma unroll
    for (int dt = 0; dt < 2; ++dt)
#pragma unroll
        for (int k = 0; k < 4; ++k) {
            const int d = 32 * dt + 8 * k + 4 * A.hi;
            const s16x4 gt = *(const s16x4*)(F.Z_() + row * NZ + zgate + 64 * A.h + d);
            const f32x16& o = dt ? o1 : o0;
            u32x2 w; w[0] = cvtpk(o[4 * k + 0] * bf2f((unsigned short)gt[0]), o[4 * k + 1] * bf2f((unsigned short)gt[1]));
            w[1] = cvtpk(o[4 * k + 2] * bf2f((unsigned short)gt[2]), o[4 * k + 3] * bf2f((unsigned short)gt[3]));
            *(u32x2*)(F.MIXED_() + row * DM + colbase + 64 * A.h + d) = w;
        }
}

__device__ __forceinline__ float kmax_load(Frame& F, int layer, int b, int ty, int lane) {
    const f32x4 v = *(const f32x4*)(F.KP_() + ((layer * 8 + b) * 3 + ty) * 256 + 4 * lane);
    float m = fmaxf(fmaxf(v[0], v[1]), fmaxf(v[2], v[3]));
    m = fmaxf(m, dpp_f<0xB1>(m)); m = fmaxf(m, dpp_f<0x4E>(m)); m = fmaxf(m, dpp_f<0x141>(m)); m = fmaxf(m, dpp_f<0x140>(m));
    return max32x_f(max16x_f(m));
}
__device__ __forceinline__ void dsa_attn_item(Frame& F, int layer, int b, int qb) {
    AttnCtx A; attn_ctx_init(A, F, b, qb);
    bf16x8 qf[4]; load_q(A, F.Z_() + ZQA, qf);
    const float kmx = kmax_load(F, layer, b, 0, A.lane);
    const float negref = -sqrtf(q_norm2(A, qf) * kmx);
    f32x16 o0 = (f32x16){0.f}, o1 = (f32x16){0.f}; float ol = 0.f;
    const unsigned* mrow = F.MASK_() + ((size_t)b * SEQ + A.t) * 128;
    attn_stream<0>(A, F.Z_() + (size_t)b * SEQ * NZ + ZKA, F.Z_() + (size_t)b * SEQ * NZ + ZVA, 0, qb, qf, negref, o0, o1, ol, mrow, 0ull);
    const float l = sum32x_f(ol);
    const float il = l > 0.f ? 1.0f / l : 0.f;
#pragma unroll
    for (int r = 0; r < 16; ++r) { o0[r] *= il; o1[r] *= il; }
    store_out(A, F, o0, o1, ZGA, 0);
}

__device__ __forceinline__ void nsa_item(Frame& F, int layer, int b, int qb) {
    AttnCtx A; attn_ctx_init(A, F, b, qb);
    bf16x8 qf[4]; load_q(A, F.Z_() + ZQB, qf);
    const size_t row = (size_t)b * SEQ + A.t;
    const float g_c = F.BGF_()[row * 16 + 3 * A.h + 0], g_s = F.BGF_()[row * 16 + 3 * A.h + 1], g_w = F.BGF_()[row * 16 + 3 * A.h + 2];
    f32x16 out0 = (f32x16){0.f}, out1 = (f32x16){0.f};
    LAS unsigned char* kbuf = (LAS unsigned char*)F.lds + L_K; LAS unsigned char* vbuf = (LAS unsigned char*)F.lds + L_V;
    float* impw = (float*)(F.lds + L_IMP);
    {
        const bf16_t* kc = F.KCMP_() + (size_t)b * 256 * 64; const bf16_t* vc = F.VCMP_() + (size_t)b * 256 * 64;
#pragma unroll
        for (int i = 0; i < 4; ++i) {
            const int key = 64 * i + A.st_key;
            const u32x4 kr = *(const u32x4*)(kc + (size_t)key * 64 + 8 * A.st_chunk), vr = *(const u32x4*)(vc + (size_t)key * 64 + 8 * A.st_chunk);
            *(LAS u32x4*)(kbuf + i * 8192 + A.kwoff) = kr; *(LAS u32x4*)(vbuf + i * 8192 + A.vwoff) = vr;
        }
        __syncthreads();
        const int nmax = (qb * 64 + 63 - 31) >> 4;
        const int ntile = (nmax >> 6) + 1;
        float mx = -1e30f, lsum = 0.f;
        for (int i = 0; i < ntile; ++i) {
            f32x16 p0, p1;
            qk_tile(A, kbuf + i * 8192, qf, p0, p1);
#pragma unroll
            for (int r = 0; r < 16; ++r) { const int n0 = 64 * i + crow(r, A.hi), n1 = n0 + 32;
                p0[r] = (16 * n0 + 31 <= A.t) ? p0[r] : -INFINITY; p1[r] = (16 * n1 + 31 <= A.t) ? p1[r] : -INFINITY; }
            float tm = fmaxf(max16(p0), max16(p1)); tm = fmaxf(tm, xhalf(tm));
            const float mn = fmaxf(mx, tm), alpha = fast_exp2(mx - mn);
#pragma unroll
            for (int r = 0; r < 16; ++r) { p0[r] = fast_exp2(p0[r] - mn); p1[r] = fast_exp2(p1[r] - mn); }
            float rs = sum16(p0) + sum16(p1); rs += xhalf(rs);
            lsum = lsum * alpha + rs; mx = mn;
        }
        const float il = lsum > 0.f ? 1.0f / lsum : 0.f;
        float* ip = impw + ((size_t)A.h * 64 + (A.qs * 32 + A.r32)) * 64;
        float prev_other = 0.f;
        for (int i = 0; i < 4; ++i) {
            if (i < ntile) {
                f32x16 p0, p1;
                qk_tile(A, kbuf + i * 8192, qf, p0, p1);
#pragma unroll
                for (int r = 0; r < 16; ++r) { const int n0 = 64 * i + crow(r, A.hi), n1 = n0 + 32;
                    p0[r] = (16 * n0 + 31 <= A.t) ? fast_exp2(p0[r] - mx) * il : 0.f; p1[r] = (16 * n1 + 31 <= A.t) ? fast_exp2(p1[r] - mx) * il : 0.f; }
#pragma unroll
                for (int rt = 0; rt < 2; ++rt)
#pragma unroll
                    for (int k = 0; k < 4; ++k) {
                        const f32x16& pp = rt ? p1 : p0;
                        const float gs = (pp[4 * k] + pp[4 * k + 1]) + (pp[4 * k + 2] + pp[4 * k + 3]);
                        const float other = xhalf(pp[4 * k + 3]);
                        ip[16 * i + 8 * rt + 2 * k + A.hi] = gs + (A.hi ? other : prev_other);
                        prev_other = other;
                    }
                pv_tile(A, vbuf + i * 8192, p0, p1, out0, out1);
            } else {
#pragma unroll
                for (int j = 0; j < 8; ++j) ip[16 * i + 2 * j + A.hi] = 0.f;
            }
        }
#pragma unroll
        for (int r = 0; r < 16; ++r) { out0[r] *= g_c; out1[r] *= g_c; }
    }
    __syncthreads();
    {
        unsigned long long* bmp = (unsigned long long*)(F.lds + L_BM);
        for (int qg4 = 0; qg4 < 2; ++qg4) {
            const int j = A.lane;
            unsigned key[4], T[4];
#pragma unroll
            for (int k = 0; k < 4; ++k) {
                const int q = F.wave * 8 + qg4 * 4 + k;
                float v = ((impw[(0 * 64 + q) * 64 + j] + impw[(1 * 64 + q) * 64 + j]) + impw[(2 * 64 + q) * 64 + j]) + impw[(3 * 64 + q) * 64 + j];
                if (j == 0 || j == qb) v = INFINITY; else if (j > qb) v = -INFINITY;
                const unsigned bits = __float_as_uint(v);
                key[k] = (bits & 0x80000000u) ? ~bits : (bits | 0x80000000u);
                T[k] = 0u;
            }
#pragma unroll 4
            for (int bit = 31; bit >= 0; --bit) {
#pragma unroll
                for (int k = 0; k < 4; ++k) {
                    const unsigned cand = T[k] | (1u << bit);
                    const int cnt = __popcll(__ballot(key[k] >= cand));
                    T[k] = (cnt >= 16) ? cand : T[k];
                }
            }
#pragma unroll
            for (int k = 0; k < 4; ++k) {
                const int q = F.wave * 8 + qg4 * 4 + k;
                const unsigned long long gtm = __ballot(key[k] > T[k]), eqm = __ballot(key[k] == T[k]);
                const int need = 16 - __popcll(gtm);
                const int below = __popcll(eqm & ((1ull << j) - 1ull));
                const unsigned long long sel = __ballot((j <= qb) && ((key[k] > T[k]) || ((key[k] == T[k]) && below < need)));
                if (A.lane == 0) bmp[q] = sel;
            }
        }
    }
    __syncthreads();
    const unsigned long long bm = ((const unsigned long long*)(F.lds + L_BM))[A.qs * 32 + A.r32];
    LAS float* ow = (LAS float*)((LAS unsigned char*)F.lds + L_IMP) + F.wave * 2048 + A.lane;
#pragma unroll
    for (int r = 0; r < 16; ++r) { ow[r * 64] = out0[r]; ow[(16 + r) * 64] = out1[r]; }
    const float qn2 = q_norm2(A, qf);
    const float kmx_s = kmax_load(F, layer, b, 1, A.lane), kmx_w = kmax_load(F, layer, b, 2, A.lane);
    {
        f32x16 o0 = (f32x16){0.f}, o1 = (f32x16){0.f}; float ol = 0.f;
        const float negref = -sqrtf(qn2 * kmx_s);
        attn_stream<1>(A, F.Z_() + (size_t)b * SEQ * NZ + ZKS, F.Z_() + (size_t)b * SEQ * NZ + ZVS, 0, qb, qf, negref, o0, o1, ol, nullptr, bm);
        const float l = sum32x_f(ol);
        const float sc = (l > 0.f ? 1.0f / l : 0.f) * g_s;
#pragma unroll
        for (int r = 0; r < 16; ++r) { ow[r * 64] += o0[r] * sc; ow[(16 + r) * 64] += o1[r] * sc; }
    }
    {
        f32x16 o0 = (f32x16){0.f}, o1 = (f32x16){0.f}; float ol = 0.f;
        const float negref = -sqrtf(qn2 * kmx_w);
        const int k0 = qb - 8 < 0 ? 0 : qb - 8;
        attn_stream<2>(A, F.Z_() + (size_t)b * SEQ * NZ + ZKW, F.Z_() + (size_t)b * SEQ * NZ + ZVW, k0, qb, qf, negref, o0, o1, ol, nullptr, 0ull);
        const float l = sum32x_f(ol);
        const float sc = (l > 0.f ? 1.0f / l : 0.f) * g_w;
#pragma unroll
        for (int r = 0; r < 16; ++r) { o0[r] = ow[r * 64] + o0[r] * sc; o1[r] = ow[(16 + r) * 64] + o1[r] * sc; }
        store_out(A, F, o0, o1, ZGB, 256);
    }
}

__device__ __forceinline__ void zero_item(Frame& F, int b, int qb, int colbase) {
    const int tid = F.tid_();
    for (int i = tid; i < 64 * 32; i += 512) { const int r = i >> 5, c = i & 31;
        *(u32x4*)(F.MIXED_() + ((size_t)b * SEQ + qb * 64 + r) * DM + colbase + 8 * c) = (u32x4){0u, 0u, 0u, 0u}; }
}

__device__ __forceinline__ void phase_final(Frame& F, const Params& P) {
    const int gw = blockIdx.x * 8 + F.wave, NGW = F.G * 8;
#ifdef ABL_DUMP
    for (int row = gw; row < MROWS; row += NGW) {
        for (int c = F.lane_(); c < DM; c += 64) P.out[(size_t)row * DM + c] = bf2f(F.Z_()[(size_t)row * NZ + ABL_DUMP + (c & 255)]);
    }
    return;
#endif
    for (int row = gw; row < MROWS; row += NGW) {
        const f32x4 a = *(const f32x4*)(F.RS_() + (size_t)row * 4);
        const float ss = (a[0] + a[1]) + (a[2] + a[3]);
        const float rr = 1.0f / sqrtf(ss * (1.0f / 1024.0f) + 1e-6f);
        const u32x2* xb = (const u32x2*)(F.XB_() + (size_t)row * DM) + F.lane_();
        f32x4* xo = (f32x4*)(P.out + (size_t)row * DM) + F.lane_();
        const f32x4* gw4 = (const f32x4*)P.final_norm_w + F.lane_();
#pragma unroll
        for (int j = 0; j < 4; ++j) { const u32x2 w = xb[64 * j]; const f32x4 g = gw4[64 * j];
            xo[64 * j] = (f32x4){__uint_as_float(w[0] << 16) * rr * g[0], __uint_as_float(w[0] & 0xffff0000u) * rr * g[1], __uint_as_float(w[1] << 16) * rr * g[2], __uint_as_float(w[1] & 0xffff0000u) * rr * g[3]}; }
    }
}

#define XB_TMO      128
#define XB_XCNT(j)  (256  + 64 * (j))
#define XB_XSUB(j)  (1280 + 64 * (j))
#define XB_XGEN(j)  (2304 + 64 * (j))
#define XB_TOP      3328
#define XB_TOPGEN   3392
#define XCD_BAR_WORDS 3456
#define XB_SPIN_CAP (1u << 18)

__device__ __forceinline__ unsigned xb_ld(unsigned* p)              { return __hip_atomic_load(p, __ATOMIC_RELAXED, __HIP_MEMORY_SCOPE_AGENT); }
__device__ __forceinline__ unsigned xb_add(unsigned* p, unsigned v) { return __hip_atomic_fetch_add(p, v, __ATOMIC_RELAXED, __HIP_MEMORY_SCOPE_AGENT); }
__device__ __forceinline__ unsigned xb_xcc_id() { return (unsigned)__builtin_amdgcn_s_getreg((3 << 11) | 20) & 0xFu; }
#define XB_SPIN(cond, bar) do { unsigned _sp = 0; while (cond) { __builtin_amdgcn_s_sleep(1); \
    if ((++_sp & 255u) == 0u) { if (xb_ld(&(bar)[XB_TMO])) break; if (_sp > XB_SPIN_CAP) { atomicAdd(&(bar)[XB_TMO], 1u); break; } } } } while (0)

struct XcdBarrier {
    unsigned* bar; unsigned x;
    volatile LAS unsigned* st;
};

__device__ __forceinline__ XcdBarrier xcd_barrier_post(unsigned* bar, volatile LAS unsigned* st) {
    XcdBarrier b; b.bar = bar; b.x = xb_xcc_id(); b.st = st;
    if (threadIdx.x == 0) (void)xb_add(&bar[XB_XCNT(b.x)], 1u);
    return b;
}
__device__ __forceinline__ void xcd_barrier_complete(unsigned* bar, unsigned x, unsigned& nloc, unsigned& nx) {
    const unsigned G = gridDim.x * gridDim.y * gridDim.z;
    unsigned sum, cnt, mine, sp = 0u;
    for (;;) {
        sum = 0u; cnt = 0u; mine = 0u;
#pragma unroll
        for (unsigned j = 0; j < 16; ++j) { const unsigned c = xb_ld(&bar[XB_XCNT(j)]); sum += c; cnt += (c > 0u) ? 1u : 0u; mine = (j == x) ? c : mine; }
        if (sum == G) break;
        __builtin_amdgcn_s_sleep(1);
        if ((++sp & 255u) == 0u) { if (xb_ld(&bar[XB_TMO])) break; if (sp > XB_SPIN_CAP) { atomicAdd(&bar[XB_TMO], 1u); break; } }
    }
    nloc = mine > 0u ? mine : 1u; nx = cnt > 0u ? cnt : 1u;
}

__device__ __forceinline__ void xcd_barrier(const XcdBarrier& b) {
    asm volatile("s_waitcnt vmcnt(0)" ::: "memory");
    __syncthreads();
    if (threadIdx.x == 0) {
        unsigned* bar = b.bar;
        __builtin_amdgcn_s_waitcnt(0);
        unsigned nloc = b.st[0], nx = b.st[1];
        if (nloc == 0u) { xcd_barrier_complete(bar, b.x, nloc, nx); b.st[0] = nloc; b.st[1] = nx; }
        const unsigned old = xb_add(&bar[XB_XSUB(b.x)], 1u);
        const unsigned gen = old / nloc;
        if (old + 1u == (gen + 1u) * nloc) {
            __builtin_amdgcn_fence(__ATOMIC_RELEASE, "agent");
            asm volatile("s_waitcnt vmcnt(0)" ::: "memory");
            const unsigned og = xb_add(&bar[XB_TOP], 1u);
            const unsigned tg = og / nx;
            if (og + 1u == (tg + 1u) * nx) xb_add(&bar[XB_TOPGEN], 1u);
            else XB_SPIN(xb_ld(&bar[XB_TOPGEN]) == tg, bar);
            __builtin_amdgcn_fence(__ATOMIC_ACQUIRE, "agent");
            xb_add(&bar[XB_XGEN(b.x)], 1u);
            asm volatile("s_waitcnt vmcnt(0)" ::: "memory");
        } else {
            XB_SPIN(xb_ld(&bar[XB_XGEN(b.x)]) == gen, bar);
            __builtin_amdgcn_fence(__ATOMIC_ACQUIRE, "agent");
            asm volatile("s_waitcnt vmcnt(0)" ::: "memory");
        }
    }
    __syncthreads();
}

template <int SUB>
__device__ __forceinline__ void run_phase(Frame& F, const Params& Q, int layer, unsigned char* lds) {
        constexpr int sub = SUB;
        if (sub == 0) {
            pg8::Gemm g{F.XB_(), F.WIT_() + (size_t)layer * NZ * DM, MROWS, NZ, DM};
            pg8::StaticOrder S; S.init(MROWS, NZ, F.G, (int)blockIdx.x);
            EpiIn E{F.Z_(), F.RS_(), F.CS_(), F.WIF_(), F.BGF_(), lds};
            pg8::gemm_phase<EpiIn, pg8::StaticOrder, true, true>((PG8_LAS unsigned char*)lds, g, S, E, F.wave);
#if defined(PROBE_DUP) && PROBE_DUP == 1
            __syncthreads();
            pg8::gemm_phase<EpiIn, pg8::StaticOrder, true, true>((PG8_LAS unsigned char*)lds, g, S, E, F.wave);
#endif
        } else if (sub == 1) {
            const int qbase = 32 * layer;
            for (int it = (int)blockIdx.x; it < 256; it += F.G) { compress_item(F, Q, layer, it); __syncthreads(); }
            for (int it = (int)blockIdx.x; it < 256; it += F.G) convpool_item<0>(F, Q, layer, it);
#ifndef ABL_NO_A
            { int b, it; while (next_item_batch(F, qbase + 8, 128, b, it)) {
_Pragma("nounroll")
                for (int k = 0; k < 2; ++k) { select_item(F, b, 255 - 2 * it - k); __syncthreads(); } } }
#endif
#if defined(PROBE_DUP) && PROBE_DUP == 7
            __syncthreads();
            for (;;) { const int it = next_item(F, qbase + 2); if (it >= 256) break; compress_item(F, Q, layer, it); }
            { int b, it; while (next_item_batch(F, qbase + 24, 256, b, it)) select_item(F, b, 255 - it); }
            for (;;) { const int it = next_item(F, qbase + 3); if (it >= 256) break; convpool_item<0>(F, Q, layer, it); }
#endif
#if defined(PROBE_DUP) && PROBE_DUP == 12
            { int b, it; while (next_item_batch(F, qbase + 24, 256, b, it)) select_item(F, b, 255 - it); }
#endif
#if defined(PROBE_DUP) && PROBE_DUP == 2
            { int b, it; while (next_item_batch(F, qbase + 24, 256, b, it)) select_item(F, b, 255 - it); }
#endif
#if defined(PROBE_DUP) && PROBE_DUP == 3
            for (;;) { const int it = next_item(F, qbase + 2); if (it >= 256) break; compress_item(F, Q, layer, it); }
#endif
#if defined(PROBE_DUP) && PROBE_DUP == 13
            { int acc_ = 0; for (int k = 0; k < 16; ++k) acc_ += next_item(F, qbase + 24 + (k & 7)); if (acc_ == 0x7fffffff) F.KMAX_()[127] = 1u; }
#endif
#if defined(PROBE_DUP) && PROBE_DUP == 11
            for (;;) { const int it = next_item(F, qbase + 3); if (it >= 256) break; convpool_item<PROBE_VAR>(F, Q, layer, it); }
#endif
        } else if (sub == 2) {
            const int qbase = 32 * layer;
            { int b, it;
              while (next_item_batch(F, qbase + 16, 128, b, it)) {
                const int qb = 63 - (it >> 1);
                if ((it & 1) == 0) nsa_item(F, layer, b, qb); else dsa_attn_item(F, layer, b, qb);
              } }
#if defined(PROBE_DUP) && (PROBE_DUP == 4 || PROBE_DUP == 5)
            __syncthreads();
            { int b, it;
              while (next_item_batch(F, qbase + 24, 64, b, it)) {
                const int qb = 63 - it;
                if (PROBE_DUP == 5) nsa_item(F, layer, b, qb); else dsa_attn_item(F, layer, b, qb);
              } }
#endif
#if defined(PROBE_DUP) && PROBE_DUP == 6
            __syncthreads();
            { int b, it;
              while (next_item_batch(F, qbase + 24, 128, b, it)) {
                const int qb = 63 - (it >> 1);
                if ((it & 1) == 0) nsa_item(F, layer, b, qb); else dsa_attn_item(F, layer, b, qb);
              } }
#endif
        } else {
            pg8::Gemm g{F.MIXED_(), F.WOT_() + (size_t)layer * DM * DM, MROWS, DM, DM};
            pg8::StaticOrder S; S.init(MROWS, DM, F.G, (int)blockIdx.x);
            EpiOut E{F.XB_(), F.RS_(), lds};
            pg8::gemm_phase<EpiOut, pg8::StaticOrder, true, true>((PG8_LAS unsigned char*)lds, g, S, E, F.wave);
#if defined(PROBE_DUP) && PROBE_DUP == 8
            __syncthreads();
            EpiOut E2{F.Z_() + (size_t)64 * 1024 * 1024, F.BGF_(), lds};
            pg8::gemm_phase<EpiOut, pg8::StaticOrder, true, true>((PG8_LAS unsigned char*)lds, g, S, E2, F.wave);
#endif
        }
}

template <bool COOP>
__global__ void __launch_bounds__(512, 2) fwd_kernel(Params P) {
    extern __shared__ __attribute__((aligned(16))) unsigned char lds[];
    Frame F;
    F.lds = lds; F.wave = __builtin_amdgcn_readfirstlane((int)(threadIdx.x >> 6)); F.G = gridDim.x;
    F.ws = P.ws;
    XcdBarrier bar; bar.bar = nullptr; bar.x = 0; bar.st = nullptr;
    if (COOP) {
        volatile LAS unsigned* misc = (volatile LAS unsigned*)((LAS unsigned char*)lds + MISC_OFF);
        if (threadIdx.x < 64) misc[threadIdx.x] = 0u;
        { unsigned* c = F.ctl_(); for (int i = (int)blockIdx.x * 512 + (int)threadIdx.x; i < (int)(CTL_BYTES / 4); i += (int)gridDim.x * 512) c[i] = 0u; }
        __syncthreads();
    }
#define GRID_SYNC() do { if (COOP) { xcd_barrier(bar); } } while (0)
#if defined(PROBE_DUP) && PROBE_DUP == 14
#define PROBE_XSYNC GRID_SYNC()
#else
#define PROBE_XSYNC (void)0
#endif

    if (COOP) {
        phase_prologue(F, P);
#if defined(PROBE_DUP) && PROBE_DUP == 9
        __syncthreads(); phase_prologue(F, P);
#endif
        cg::this_grid().sync();
        bar = xcd_barrier_post(F.ctl_() + 12288, (volatile LAS unsigned*)((LAS unsigned char*)lds + MISC_OFF) + 8);
#define RUN_PHASE(LAYER, SUB) do { Params Q = P; \
            asm volatile("" : "+s"(Q.x), "+s"(Q.norm_w), "+s"(Q.conv_w), "+s"(Q.pe_cmp), "+s"(Q.pool_scale), "+s"(Q.out), "+s"(Q.ws)); F.ws = Q.ws; \
            run_phase<SUB>(F, Q, LAYER, lds); GRID_SYNC(); PROBE_XSYNC; } while (0)
#define RUN_LAYER(LAYER) do { RUN_PHASE(LAYER, 0); RUN_PHASE(LAYER, 1); RUN_PHASE(LAYER, 2); RUN_PHASE(LAYER, 3); } while (0)
        RUN_LAYER(0); RUN_LAYER(1); RUN_LAYER(2); RUN_LAYER(3);
#undef RUN_LAYER
#undef RUN_PHASE
        phase_final(F, P);
    } else {
        int ph = P.ph_lo;
        if (ph == 0) { phase_prologue(F, P); ++ph; }
        for (; ph < P.ph_hi && ph < NPHASE - 1; ++ph) {
            int ph_ = ph; asm volatile("" : "+s"(ph_));
            Params Q = P;
            asm volatile("" : "+s"(Q.x), "+s"(Q.norm_w), "+s"(Q.conv_w), "+s"(Q.pe_cmp), "+s"(Q.pool_scale), "+s"(Q.out), "+s"(Q.ws));
            F.ws = Q.ws;
            const int layer = (ph_ - 1) >> 2, sub = (ph_ - 1) & 3;
            if (sub == 0) run_phase<0>(F, Q, layer, lds); else if (sub == 1) run_phase<1>(F, Q, layer, lds); else if (sub == 2) run_phase<2>(F, Q, layer, lds); else run_phase<3>(F, Q, layer, lds);
        }
        if (ph == NPHASE - 1 && ph < P.ph_hi) phase_final(F, P);
    }
}

#ifndef N_LAUNCH_MODE
#define N_LAUNCH_MODE 0
#endif
#if N_LAUNCH_MODE == 0
template __global__ void fwd_kernel<true>(Params);
#else
template __global__ void fwd_kernel<false>(Params);
#endif
extern "C" void kernel_launch(void* const* d_in, const int* in_sizes, int n_in, void* d_out, int out_size, void* d_ws, size_t ws_size, hipStream_t stream) {
    static int grid = 0;
    if (grid == 0) {
        if (n_in != 11 || out_size != MROWS * DM || ws_size < WS_END) { fprintf(stderr, "kernel_launch: unexpected shapes (n_in %d out %d ws %zu)\n", n_in, out_size, ws_size); grid = -1; return; }
        int dev = 0, cus = 0, per_cu = 0;
        hipGetDevice(&dev); hipDeviceGetAttribute(&cus, hipDeviceAttributeMultiprocessorCount, dev);
#if N_LAUNCH_MODE == 0
#define FWD_K fwd_kernel<true>
#else
#define FWD_K fwd_kernel<false>
#endif
        hipFuncSetAttribute((const void*)FWD_K, hipFuncAttributeMaxDynamicSharedMemorySize, LDS_BYTES);
        hipOccupancyMaxActiveBlocksPerMultiprocessor(&per_cu, (const void*)FWD_K, 512, LDS_BYTES);
        (void)hipGetLastError();
        if (per_cu < 1) { fprintf(stderr, "kernel_launch: occupancy query says %d blocks/CU\n", per_cu); per_cu = 1; }
        grid = cus;
    }
    if (grid < 0) return;
#if N_LAUNCH_MODE != 0
    hipMemsetAsync((char*)d_ws + WS_CTL, 0, CTL_BYTES, stream);
#endif
    Params p{};
    p.x = (const float*)d_in[0]; p.norm_w = (const float*)d_in[1]; p.w_in = (const float*)d_in[2]; p.w_out = (const float*)d_in[3]; p.conv_w = (const float*)d_in[4];
    p.pe_cmp = (const float*)d_in[5]; p.w_cmp_k = (const float*)d_in[6]; p.w_cmp_v = (const float*)d_in[7]; p.pool_w = (const float*)d_in[8]; p.pool_scale = (const float*)d_in[9];
    p.final_norm_w = (const float*)d_in[10]; p.out = (float*)d_out; p.ws = (unsigned char*)d_ws;
#if N_LAUNCH_MODE == 0
    p.ph_lo = 0; p.ph_hi = NPHASE;
    void* args[] = {&p};
    hipError_t e = hipLaunchCooperativeKernel((const void*)fwd_kernel<true>, dim3(grid), dim3(512), args, LDS_BYTES, stream);
    if (e != hipSuccess) fprintf(stderr, "cooperative launch failed: %s (grid %d)\n", hipGetErrorString(e), grid);
#else
    for (int ph = 0; ph < NPHASE; ++ph) {
#ifdef ABL_DUMP
        if (ph >= 2 && ph < NPHASE - 1) continue;
#endif
        p.ph_lo = ph; p.ph_hi = ph + 1;
        hipLaunchKernelGGL(fwd_kernel<false>, dim3(grid), dim3(512), LDS_BYTES, stream, p);
    }
#endif
}
```

```cpp
#include <hip/hip_runtime.h>
#include <hip/hip_cooperative_groups.h>
#include <cstdio>
#include <cstdint>
namespace cg = cooperative_groups;

constexpr int BATCH = 8, SEQ = 4096, DM = 1024, DEPTH = 4, MROWS = BATCH * SEQ;
constexpr int D_IN = 3380, NZ = 3584;
constexpr int ZQA = 0, ZQI = 256, ZQB = 512, ZKA = 768, ZVA = 832, ZKS = 896, ZVS = 960, ZKW = 1024, ZVW = 1088, ZKC = 1152, ZVC = 1216,
              ZKI = 1280, ZWI = 1312, ZBG = 1320, ZGA = 1536, ZGB = 1792, ZCB = 2048, ZCC = 2304, ZCX = 2560, ZGC = 2816, ZDU = 3072, ZGD = 3328;
constexpr float C2 = 0.18033688011112042f;
constexpr int NPHASE = 2 + 4 * DEPTH;

constexpr size_t MiB = 1u << 20;
constexpr size_t WS_CTL = 0, CTL_BYTES = 64 * 1024;
constexpr size_t WS_WIT = 2 * MiB;
constexpr size_t WS_WOT = 30 * MiB;
constexpr size_t WS_WCT = 38 * MiB;
constexpr size_t WS_PWT = 40 * MiB;
constexpr size_t WS_CS = 40 * MiB + 256 * 1024;
constexpr size_t WS_KP = 41 * MiB;
constexpr size_t WS_RS = 42 * MiB;
constexpr size_t WS_WIF = 44 * MiB;
constexpr size_t WS_BGF = 45 * MiB;
constexpr size_t WS_KCMP = 47 * MiB;
constexpr size_t WS_VCMP = 47 * MiB + 512 * 1024;
constexpr size_t WS_XB = 48 * MiB;
constexpr size_t WS_Z = 112 * MiB;
constexpr size_t WS_MIXED = 336 * MiB;
constexpr size_t WS_MASK = 400 * MiB;
constexpr size_t WS_END = 416 * MiB;

constexpr int RING_BYTES = 131072;
constexpr int MISC_OFF = RING_BYTES;
constexpr int LDS_BYTES = 147456;
constexpr int L_K = 0, L_V = 32768, L_IMP = 65536, L_BM = MISC_OFF + 256;

typedef unsigned short bf16_t;
typedef short bf16x8 __attribute__((ext_vector_type(8)));
typedef short s16x4 __attribute__((ext_vector_type(4)));
typedef float f32x4 __attribute__((ext_vector_type(4)));
typedef float f32x2 __attribute__((ext_vector_type(2)));
typedef float f32x16 __attribute__((ext_vector_type(16)));
typedef unsigned u32x4 __attribute__((ext_vector_type(4)));
typedef unsigned u32x2 __attribute__((ext_vector_type(2)));
#define LAS __attribute__((address_space(3)))

__host__ __device__ __forceinline__ int perm64(int j) { return j < 16 ? ((j & ~12) | ((j & 4) << 1) | ((j & 8) >> 1)) : j; }
__host__ __device__ __forceinline__ int src_col(int p) {
    if (p < 256) return 0 + (p >> 6) * 64 + perm64(p & 63);
    if (p < 512) return 384 + (p - 256);
    if (p < 768) { const int q = p - 512; return 936 + (q >> 6) * 64 + perm64(q & 63); }
    if (p < 832) return 256 + perm64(p - 768);
    if (p < 896) return 320 + (p - 832);
    if (p < 960) return 1320 + perm64(p - 896);
    if (p < 1024) return 1384 + (p - 960);
    if (p < 1088) return 1448 + perm64(p - 1024);
    if (p < 1152) return 1512 + (p - 1088);
    if (p < 1216) return 1192 + (p - 1152);
    if (p < 1280) return 1256 + (p - 1216);
    if (p < 1312) return 640 + (p - 1280);
    if (p < 1320) return 672 + (p - 1312);
    if (p < 1332) return 1576 + (p - 1320);
    if (p < 1536) return -1;
    if (p < 1792) return 680 + (p - 1536);
    if (p < 2048) return 1588 + (p - 1792);
    if (p < 2304) return 1844 + (p - 2048);
    if (p < 2560) return 2100 + (p - 2304);
    if (p < 2816) return 2356 + (p - 2560);
    if (p < 3072) return 2612 + (p - 2816);
    if (p < 3328) return 2868 + (p - 3072);
    return 3124 + (p - 3328);
}
#define N_LAUNCH_MODE 0
namespace pg8 {
#define PG8_LAS __attribute__((address_space(3)))
typedef unsigned short bf16_t;
typedef short bf16x8 __attribute__((ext_vector_type(8)));
typedef float f32x4 __attribute__((ext_vector_type(4)));
typedef unsigned u32x4 __attribute__((ext_vector_type(4)));
constexpr int BM = 256, BK = 64, HALF = 128, HTB = HALF * BK * 2  , STAGE_BYTES = 8 * HTB, NXCD = 8, WGM = 8;

__host__ __device__ __forceinline__ int lds_byte(int r, int c) { const int st = (r >> 4) * 2 + (c >> 5), rr = r & 15, cc = c & 31, ob = rr * 64 + cc * 2; return st * 1024 + (ob ^ (((ob >> 9) & 1) << 5)); }
__host__ __device__ __forceinline__ void stage_rc(int b, int& R, int& C) { const int st = b / 1024, sb = b % 1024, swz = sb ^ (((sb >> 9) & 1) << 5); R = (st >> 1) * 16 + swz / 64; C = (st & 1) * 32 + (swz % 64) / 2; }
__host__ __device__ __forceinline__ int perm32(int rho) { const int n = rho >> 4, i = rho & 15; return 8 * (i >> 2) + 4 * n + (i & 3); }

struct Unit { int pm, pn; };
struct Gemm { const bf16_t* A; const bf16_t* Bt; int M, N, K; };

struct StaticOrder {
    int nM, nN, nwg, G, c;
    __host__ __device__ void init(int M, int N, int G_, int c_) { nM = M / BM; nN = N / BM; nwg = nM * nN; G = G_; c = c_; }
    __host__ __device__ bool next(int i, Unit& u) const {
        const long L = (long)i * G + c; if (L >= nwg) return false;
        int wgid = (int)L; { const int q = nwg / NXCD, r = nwg % NXCD, xcd = wgid % NXCD, off = wgid / NXCD; wgid = (xcd < r ? xcd * (q + 1) : r * (q + 1) + (xcd - r) * q) + off; }
        const int nig = WGM * nN, gid = wgid / nig, fm = gid * WGM, gsz = (nM - fm) < WGM ? (nM - fm) : WGM;
        u.pm = fm + ((wgid % nig) % gsz); u.pn = (wgid % nig) / gsz; return true;
    }
    __device__ __forceinline__ void a_ready(const Unit&) const {}
    __device__ __forceinline__ void done(const Unit&) const {}
};
}
namespace pg8 {
template <class Epi, class Sched, bool ALIGN_EPI = false, bool SP2 = false>
__device__ __forceinline__ void gemm_phase(PG8_LAS unsigned char* lds, const Gemm g, const Sched& S, const Epi& E, const int wave_s) {
    int lane_; asm volatile("v_mbcnt_lo_u32_b32 %0, -1, 0\n\tv_mbcnt_hi_u32_b32 %0, -1, %0" : "=v"(lane_));
    const int tid = wave_s * 64 + lane_, wid = wave_s, lane = lane_, wr = wid >> 2, wc = wid & 3, fr = lane & 15, fq = lane >> 4;
    const int K = g.K, nt = K / BK;
    unsigned voffA[2], voffB[2];
#pragma unroll
    for (int i = 0; i < 2; ++i) { int R, C; stage_rc(tid * 16 + i * 8192, R, C); const int Rb = Epi::PERM ? ((R & ~31) + perm32(R & 31)) : R;
        voffA[i] = (unsigned)(R * K + C) * 2u; voffB[i] = (unsigned)(Rb * K + C) * 2u; }
    const size_t kstep = (size_t)(BK * 2);
    const size_t hstep = (size_t)HALF * K * 2;
    const size_t tstep = 2 * hstep;
    const unsigned ldsw = (unsigned)wid * 1024u;
    const int aoff = lds_byte(wr * 64 + fr, fq * 8), boff = lds_byte(wc * 32 + fr, fq * 8);
#define PG8_SA(b, h) (((b) * 2 + (h)) * HTB)
#define PG8_SB(b, h) ((4 + (b) * 2 + (h)) * HTB)
#define PG8_STAGE(bufoff, gbase, voff) do { _Pragma("unroll") for (int _i = 0; _i < 2; ++_i) \
        __builtin_amdgcn_global_load_lds((const unsigned*)((const char*)(gbase) + (voff)[_i]), (PG8_LAS unsigned*)(lds + (bufoff) + ldsw + _i * 8192), 16, 0, 0); } while (0)
#define PG8_LDA(dst, b, h) do { _Pragma("unroll") for (int m = 0; m < 4; ++m) _Pragma("unroll") for (int k = 0; k < 2; ++k) dst[m][k] = *(const PG8_LAS bf16x8*)(lds + PG8_SA(b, h) + aoff + m * 2048 + k * 1024); } while (0)
#define PG8_LDB(dst, b, h) do { _Pragma("unroll") for (int n = 0; n < 2; ++n) _Pragma("unroll") for (int k = 0; k < 2; ++k) dst[n][k] = *(const PG8_LAS bf16x8*)(lds + PG8_SB(b, h) + boff + n * 2048 + k * 1024); } while (0)
#define PG8_MMA(ai, bj, At, Bt) do { __builtin_amdgcn_s_setprio(1); _Pragma("unroll") for (int m = 0; m < 4; ++m) _Pragma("unroll") for (int n = 0; n < 2; ++n) _Pragma("unroll") for (int k = 0; k < 2; ++k) \
        acc[ai][bj][m][n] = __builtin_amdgcn_mfma_f32_16x16x32_bf16(Bt[n][k], At[m][k], acc[ai][bj][m][n], 0, 0, 0); __builtin_amdgcn_s_setprio(0); } while (0)
#define PG8_WAIT_V(n) asm volatile("s_waitcnt vmcnt(" #n ")" ::: "memory")
#define PG8_WAIT_L(n) asm volatile("s_waitcnt lgkmcnt(" #n ")" ::: "memory")
#define PG8_BAR __builtin_amdgcn_s_barrier()
#define PG8_SCHED __builtin_amdgcn_sched_barrier(0)
    Unit cur, nxt; int ui = 0; int par_ = 0;
    if (!S.next(0, cur)) return;
    f32x4 acc[2][2][4][2];
    if constexpr (Epi::HAS_INIT) E.init(acc, cur, wr, wc, fr, fq);
    else {
#pragma unroll
    for (int a = 0; a < 2; ++a)
#pragma unroll
        for (int b = 0; b < 2; ++b)
#pragma unroll
            for (int m = 0; m < 4; ++m)
#pragma unroll
                for (int n = 0; n < 2; ++n) acc[a][b][m][n] = (f32x4){0.f, 0.f, 0.f, 0.f};
    }
    bf16x8 At[4][2], B0[2][2], B1[2][2];
    const char* cA = (const char*)g.A + (size_t)cur.pm * tstep; const char* cB = (const char*)g.Bt + (size_t)cur.pn * tstep;
    S.a_ready(cur);
    if constexpr (SP2) {
        PG8_STAGE(PG8_SB(0, 0), cB, voffB); PG8_STAGE(PG8_SB(0, 1), cB + hstep, voffB); PG8_STAGE(PG8_SA(0, 0), cA, voffA); PG8_STAGE(PG8_SA(0, 1), cA + hstep, voffA);
        if constexpr (Epi::HAS_ROWS) { typename Epi::Rows r0_ = E.rows_issue(cur, tid); E.rows_commit(r0_, tid, 0, true); }
        if (wr == 1) PG8_BAR;
        PG8_WAIT_V(2); PG8_BAR;
        PG8_STAGE(PG8_SB(1, 0), cB + kstep, voffB); PG8_STAGE(PG8_SA(1, 0), cA + kstep, voffA); PG8_STAGE(PG8_SB(1, 1), cB + hstep + kstep, voffB);
        PG8_WAIT_V(6); PG8_BAR;
    } else {
        PG8_STAGE(PG8_SB(0, 0), cB, voffB); PG8_STAGE(PG8_SA(0, 0), cA, voffA); PG8_STAGE(PG8_SB(0, 1), cB + hstep, voffB); PG8_STAGE(PG8_SA(0, 1), cA + hstep, voffA);
        if (wr == 1) PG8_BAR;
        PG8_WAIT_V(4); PG8_BAR;
        PG8_STAGE(PG8_SB(1, 0), cB + kstep, voffB); PG8_STAGE(PG8_SA(1, 0), cA + kstep, voffA); PG8_STAGE(PG8_SB(1, 1), cB + hstep + kstep, voffB);
        PG8_WAIT_V(6); PG8_BAR;
    }
    for (;;) {
        const bool has_next = S.next(ui + 1, nxt);
        const char* nA = has_next ? (const char*)g.A + (size_t)nxt.pm * tstep : cA; const char* nB = has_next ? (const char*)g.Bt + (size_t)nxt.pn * tstep : cB;
        for (int t = 0; t < nt; t += 2) {
            const bool last = (t == nt - 2);
            const char* a1 = cA + (size_t)(t + 1) * kstep;
            const char* a2 = last ? nA : cA + (size_t)(t + 2) * kstep; const char* b2 = last ? nB : cB + (size_t)(t + 2) * kstep;
            const char* a3 = a2 + kstep; const char* b3 = b2 + kstep;
            if (last && has_next) S.a_ready(nxt);
            if constexpr (SP2) {
            PG8_LDB(B0, 0, 0); PG8_LDB(B1, 0, 1); PG8_SCHED; PG8_LDA(At, 0, 0); PG8_STAGE(PG8_SA(1, 1), a1 + hstep, voffA);
            PG8_WAIT_V(8); PG8_WAIT_L(0); PG8_BAR; PG8_MMA(0, 0, At, B0); PG8_MMA(0, 1, At, B1); PG8_BAR; PG8_SCHED;
            PG8_LDA(At, 0, 1); PG8_STAGE(PG8_SB(0, 0), b2, voffB); PG8_STAGE(PG8_SB(0, 1), b2 + hstep, voffB); PG8_STAGE(PG8_SA(0, 0), a2, voffA);
            PG8_WAIT_V(8); PG8_WAIT_L(0); PG8_BAR; PG8_MMA(1, 0, At, B0); PG8_MMA(1, 1, At, B1); PG8_BAR; PG8_SCHED;
            PG8_LDB(B0, 1, 0); PG8_LDB(B1, 1, 1); PG8_SCHED; PG8_LDA(At, 1, 0); PG8_STAGE(PG8_SA(0, 1), a2 + hstep, voffA);
            PG8_WAIT_V(8); PG8_WAIT_L(0); PG8_BAR; PG8_MMA(0, 0, At, B0); PG8_MMA(0, 1, At, B1); PG8_BAR; PG8_SCHED;
            PG8_LDA(At, 1, 1); PG8_STAGE(PG8_SB(1, 0), b3, voffB); PG8_STAGE(PG8_SB(1, 1), b3 + hstep, voffB); PG8_STAGE(PG8_SA(1, 0), a3, voffA);
            PG8_WAIT_V(8); PG8_WAIT_L(0); PG8_BAR; PG8_MMA(1, 0, At, B0); PG8_MMA(1, 1, At, B1); PG8_BAR; PG8_SCHED;
            } else {
            PG8_LDB(B0, 0, 0); PG8_SCHED; PG8_LDA(At, 0, 0); PG8_STAGE(PG8_SA(1, 1), a1 + hstep, voffA);
            PG8_WAIT_L(8); PG8_BAR; PG8_WAIT_L(0); PG8_MMA(0, 0, At, B0); PG8_BAR; PG8_SCHED;
            PG8_LDB(B1, 0, 1); PG8_STAGE(PG8_SB(0, 0), b2, voffB);
            PG8_BAR; PG8_WAIT_L(0); PG8_MMA(0, 1, At, B1); PG8_BAR;
            PG8_LDA(At, 0, 1); PG8_STAGE(PG8_SA(0, 0), a2, voffA);
            PG8_BAR; PG8_WAIT_L(0); PG8_MMA(1, 0, At, B0); PG8_BAR; PG8_SCHED;
            PG8_STAGE(PG8_SB(0, 1), b2 + hstep, voffB);
            PG8_WAIT_V(6); PG8_BAR; PG8_MMA(1, 1, At, B1); PG8_BAR;
            PG8_LDB(B0, 1, 0); PG8_SCHED; PG8_LDA(At, 1, 0); PG8_STAGE(PG8_SA(0, 1), a2 + hstep, voffA);
            PG8_WAIT_L(8); PG8_BAR; PG8_WAIT_L(0); PG8_MMA(0, 0, At, B0); PG8_BAR; PG8_SCHED;
            PG8_LDB(B1, 1, 1); PG8_STAGE(PG8_SB(1, 0), b3, voffB);
            PG8_BAR; PG8_WAIT_L(0); PG8_MMA(0, 1, At, B1); PG8_BAR;
            PG8_LDA(At, 1, 1); PG8_STAGE(PG8_SA(1, 0), a3, voffA);
            PG8_BAR; PG8_WAIT_L(0); PG8_MMA(1, 0, At, B0); PG8_BAR; PG8_SCHED;
            PG8_STAGE(PG8_SB(1, 1), b3 + hstep, voffB);
            PG8_WAIT_V(6); PG8_BAR; PG8_MMA(1, 1, At, B1); PG8_BAR;
            }
        }
        if constexpr (ALIGN_EPI) { if (wr == 0) PG8_BAR; }
        if constexpr (Epi::HAS_ROWS) {
            typename Epi::Rows rn_ = E.rows_issue(has_next ? nxt : cur, tid);
            E.run(acc, cur, wr, wc, fr, fq, par_); S.done(cur);
            E.rows_commit(rn_, tid, par_ ^ 1, false); par_ ^= 1;
        } else
        if constexpr (!Epi::AFTER_DRAIN) { E(acc, cur, wr, wc, fr, fq); S.done(cur); }
        if (!has_next) break;
        if constexpr (Epi::HAS_INIT) E.init(acc, nxt, wr, wc, fr, fq);
        else {
#pragma unroll
        for (int a = 0; a < 2; ++a)
#pragma unroll
            for (int b = 0; b < 2; ++b)
#pragma unroll
                for (int m = 0; m < 4; ++m)
#pragma unroll
                    for (int n = 0; n < 2; ++n) acc[a][b][m][n] = (f32x4){0.f, 0.f, 0.f, 0.f};
        }
        cur = nxt; cA = nA; cB = nB; ++ui;
        if constexpr (ALIGN_EPI) { if (wr == 1) PG8_BAR; }
    }
    PG8_WAIT_V(0);
    if constexpr (!ALIGN_EPI) { if (wr == 0) PG8_BAR; }
    PG8_BAR;
    if constexpr (Epi::AFTER_DRAIN) { E.fused(acc, cur, wr, wc, fr, fq, lds, wid, lane); S.done(cur); }
#undef PG8_SA
#undef PG8_SB
#undef PG8_STAGE
#undef PG8_LDA
#undef PG8_LDB
#undef PG8_MMA
#undef PG8_WAIT_V
#undef PG8_WAIT_L
#undef PG8_BAR
#undef PG8_SCHED
}
}

__device__ __forceinline__ float bf2f(unsigned short h) { return __uint_as_float((unsigned)h << 16); }
typedef __bf16 bf16x2_t __attribute__((ext_vector_type(2)));
__device__ __forceinline__ unsigned cvtpk(float lo, float hi) { f32x2 v = {lo, hi}; bf16x2_t b = __builtin_convertvector(v, bf16x2_t); return __builtin_bit_cast(unsigned, b); }
__device__ __forceinline__ float fast_exp2(float x) { return __builtin_amdgcn_exp2f(x); }
__device__ __forceinline__ float fast_rcp(float x) { return __builtin_amdgcn_rcpf(x); }
__device__ __forceinline__ float sigmoidf_(float x) { return fast_rcp(1.f + fast_exp2(-1.4426950408889634f * x)); }
__device__ __forceinline__ float siluf_(float x) { return x * sigmoidf_(x); }
__device__ __forceinline__ int lane_id() { int l; asm volatile("v_mbcnt_lo_u32_b32 %0, -1, 0\n\tv_mbcnt_hi_u32_b32 %0, -1, %0" : "=v"(l)); return l; }
__device__ __forceinline__ float xhalf_(float v, int hi) {
    auto rr = __builtin_amdgcn_permlane32_swap(__float_as_uint(v), __float_as_uint(v), false, false);
    return hi ? __uint_as_float(rr[0]) : __uint_as_float(rr[1]);
}
#define xhalf(v) xhalf_((v), A.hi)
template <int CTRL> __device__ __forceinline__ int dpp_i(int v) { return __builtin_amdgcn_update_dpp(0, v, CTRL, 0xf, 0xf, true); }
template <int CTRL> __device__ __forceinline__ float dpp_f(float v) { return __int_as_float(__builtin_amdgcn_update_dpp(0, __float_as_int(v), CTRL, 0xf, 0xf, true)); }
__device__ __forceinline__ int sum32_i(int v) {
    v += dpp_i<0xB1>(v); v += dpp_i<0x4E>(v); v += dpp_i<0x141>(v); v += dpp_i<0x140>(v);
    const auto r = __builtin_amdgcn_permlane16_swap((unsigned)v, (unsigned)v, false, false);
    return (int)(r[0] + r[1]);
}
__device__ __forceinline__ float sum16x_f(float v) {
    const auto r = __builtin_amdgcn_permlane16_swap(__float_as_uint(v), __float_as_uint(v), false, false);
    return __uint_as_float(r[0]) + __uint_as_float(r[1]);
}
__device__ __forceinline__ float sum32x_f(float v) {
    const auto r = __builtin_amdgcn_permlane32_swap(__float_as_uint(v), __float_as_uint(v), false, false);
    return __uint_as_float(r[0]) + __uint_as_float(r[1]);
}
__device__ __forceinline__ float max16x_f(float v) {
    const auto r = __builtin_amdgcn_permlane16_swap(__float_as_uint(v), __float_as_uint(v), false, false);
    return fmaxf(__uint_as_float(r[0]), __uint_as_float(r[1]));
}
__device__ __forceinline__ float max32x_f(float v) {
    const auto r = __builtin_amdgcn_permlane32_swap(__float_as_uint(v), __float_as_uint(v), false, false);
    return fmaxf(__uint_as_float(r[0]), __uint_as_float(r[1]));
}
__device__ __forceinline__ float wave_sum_f(float v) {
    v += dpp_f<0xB1>(v); v += dpp_f<0x4E>(v); v += dpp_f<0x141>(v); v += dpp_f<0x140>(v);
    return sum32x_f(sum16x_f(v));
}
__device__ __forceinline__ void unpack8(bf16x8 v, float (&f)[8]) {
#pragma unroll
    for (int j = 0; j < 8; ++j) f[j] = bf2f((unsigned short)v[j]);
}

struct Params {
    const float* x; const float* norm_w; const float* w_in; const float* w_out; const float* conv_w; const float* pe_cmp;
    const float* w_cmp_k; const float* w_cmp_v; const float* pool_w; const float* pool_scale; const float* final_norm_w;
    float* out; unsigned char* ws; int ph_lo, ph_hi;
};

struct EpiIn {
    static constexpr bool PERM = true, AFTER_DRAIN = false, HAS_INIT = false, HAS_ROWS = true;
    bf16_t* Z; const float* RS; const f32x2* CS; float* WIF; float* BGF; unsigned char* lds;
    struct Rows { f32x4 rs; f32x2 cs; };
    __device__ __forceinline__ Rows rows_issue(const pg8::Unit& u, int tid) const {
        Rows r; r.rs = (f32x4){1.f, 1.f, 1.f, 1.f}; r.cs = (f32x2){1.f, 0.f};
        if (tid < 256) {
            r.rs = *(const f32x4*)(RS + (size_t)(u.pm * 256 + tid) * 4);
            const int rr = tid >> 3, t0 = (u.pm * 256 + (rr >> 4) * 64 + (rr & 15)) & (SEQ - 1);
            r.cs = CS[t0 * 8 + (tid & 7)];
        }
        return r;
    }
    __device__ __forceinline__ void rows_commit(const Rows& r, int tid, int par, bool first) const {
        LAS float* lrs = (LAS float*)((LAS unsigned char*)lds + MISC_OFF + 1024) + par * 256;
        LAS f32x2* lcs = (LAS f32x2*)((LAS unsigned char*)lds + MISC_OFF + 4096) + par * 256;
        if (tid < 256) {
            lrs[tid] = 1.0f / sqrtf(((r.rs[0] + r.rs[1]) + (r.rs[2] + r.rs[3])) * (1.0f / 1024.0f) + 1e-6f);
            lcs[tid] = r.cs;
        }
        if (first && tid < 8) ((LAS f32x2*)((LAS unsigned char*)lds + MISC_OFF + 3072))[tid] = CS[16 * 8 + tid];
    }
    __device__ __forceinline__ void run(const f32x4 (&acc)[2][2][4][2], const pg8::Unit& u, int wr, int wc, int fr, int fq, int par) const {
        const int pn = u.pn;
        float rrv[2][4];
        {
            const LAS float* lrs = (const LAS float*)((LAS unsigned char*)lds + MISC_OFF + 1024) + par * 256;
#pragma unroll
            for (int ai = 0; ai < 2; ++ai)
#pragma unroll
                for (int m = 0; m < 4; ++m) rrv[ai][m] = lrs[ai * 128 + wr * 64 + m * 16 + fr];
        }
        const int cl0 = wc * 32 + fq * 8, hp0 = cl0 & 63;
        bool rope0 = false, rope1 = false; int fb = 0, fs = 1;
        if (pn == 0 || pn == 2) { if (hp0 < 16) { rope0 = rope1 = true; fb = hp0 >> 1; } }
        else if (pn == 1) { if ((cl0 & 31) == 0) { rope0 = rope1 = true; fs = 2; } }
        else if (pn == 3) { if (((cl0 >> 6) & 1) == 0 && hp0 < 16) { rope0 = rope1 = true; fb = hp0 >> 1; } }
        else if (pn == 4) { if ((cl0 >> 6) == 0 && hp0 < 16) { rope0 = true; fb = hp0 >> 1; } }
        else if (pn == 5) { if (cl0 == 0) { rope0 = true; fs = 2; } }
        f32x2 csc[4], cst[4];
        if (rope0) {
            const LAS f32x2* lcs = (const LAS f32x2*)((LAS unsigned char*)lds + MISC_OFF + 4096) + par * 256 + (wr * 16 + fr) * 8;
            const LAS f32x2* lst = (const LAS f32x2*)((LAS unsigned char*)lds + MISC_OFF + 3072);
#pragma unroll
            for (int e = 0; e < 4; ++e) { csc[e] = lcs[fb + e * fs]; cst[e] = lst[fb + e * fs]; }
        }
#pragma unroll
        for (int aim = 0; aim < 4; ++aim) {
            const int ai = aim >> 1;
#pragma unroll
            for (int m2 = 0; m2 < 2; ++m2) {
                const int m = 2 * (aim & 1) + m2;
                const int row = u.pm * 256 + ai * 128 + wr * 64 + m * 16 + fr;
                const float rr = rrv[ai][m];
#pragma unroll
                for (int bj = 0; bj < 2; ++bj) {
                    float v[8];
#pragma unroll
                    for (int e = 0; e < 4; ++e) { v[e] = acc[ai][bj][m][0][e] * rr; v[4 + e] = acc[ai][bj][m][1][e] * rr; }
                    const int cl = bj * 128 + wc * 32 + fq * 8;
                    if (bj == 0 ? rope0 : rope1) {
#pragma unroll
                        for (int e = 0; e < 4; ++e) {
                            const f32x2 cs = csc[e];
                            const float x1 = v[e], x2 = v[4 + e];
                            v[e] = x1 * cs[0] - x2 * cs[1]; v[4 + e] = x2 * cs[0] + x1 * cs[1];
                        }
                    }
                    if (pn == 0 || pn == 2) {
#pragma unroll
                        for (int e = 0; e < 8; ++e) v[e] *= C2;
                    } else if (pn == 6 || pn == 7 || pn == 11 || pn == 13) {
#pragma unroll
                        for (int e = 0; e < 8; ++e) v[e] = siluf_(v[e]);
                    } else if (pn == 5) {
                        if (cl == 32) { *(f32x4*)(WIF + (size_t)row * 8) = (f32x4){v[0], v[1], v[2], v[3]}; *(f32x4*)(WIF + (size_t)row * 8 + 4) = (f32x4){v[4], v[5], v[6], v[7]}; }
                        else if (cl == 40) { *(f32x4*)(BGF + (size_t)row * 16) = (f32x4){sigmoidf_(v[0]), sigmoidf_(v[1]), sigmoidf_(v[2]), sigmoidf_(v[3])};
                                             *(f32x4*)(BGF + (size_t)row * 16 + 4) = (f32x4){sigmoidf_(v[4]), sigmoidf_(v[5]), sigmoidf_(v[6]), sigmoidf_(v[7])}; }
                        else if (cl == 48) { *(f32x4*)(BGF + (size_t)row * 16 + 8) = (f32x4){sigmoidf_(v[0]), sigmoidf_(v[1]), sigmoidf_(v[2]), sigmoidf_(v[3])}; }
                    }
                    u32x4 w; w[0] = cvtpk(v[0], v[1]); w[1] = cvtpk(v[2], v[3]); w[2] = cvtpk(v[4], v[5]); w[3] = cvtpk(v[6], v[7]);
                    *(u32x4*)(Z + (size_t)row * NZ + pn * 256 + cl) = w;
                }
                if (rope0 && !(ai == 1 && m == 3)) {
#pragma unroll
                    for (int st = 0; st < (m == 3 ? 5 : 1); ++st)
#pragma unroll
                        for (int e = 0; e < 4; ++e) { const float c = csc[e][0], sn = csc[e][1]; csc[e][0] = c * cst[e][0] - sn * cst[e][1]; csc[e][1] = sn * cst[e][0] + c * cst[e][1]; }
                }
            }
        }
    }
};

struct EpiOut {
    static constexpr bool PERM = true, AFTER_DRAIN = false, HAS_INIT = true, HAS_ROWS = false;
    bf16_t* XB; float* RS; unsigned char* lds;
    __device__ __forceinline__ void init(f32x4 (&acc)[2][2][4][2], const pg8::Unit& u, int wr, int wc, int fr, int fq) const {
        bf16x8 xold[2][4][2];
#pragma unroll
        for (int ai = 0; ai < 2; ++ai)
#pragma unroll
            for (int m = 0; m < 4; ++m)
#pragma unroll
                for (int bj = 0; bj < 2; ++bj) xold[ai][m][bj] = *(const bf16x8*)(XB + (size_t)(u.pm * 256 + ai * 128 + wr * 64 + m * 16 + fr) * DM + u.pn * 256 + bj * 128 + wc * 32 + fq * 8);
#pragma unroll
        for (int ai = 0; ai < 2; ++ai)
#pragma unroll
            for (int m = 0; m < 4; ++m)
#pragma unroll
                for (int bj = 0; bj < 2; ++bj) {
                    float xo[8]; unpack8(xold[ai][m][bj], xo);
                    acc[ai][bj][m][0] = (f32x4){xo[0], xo[1], xo[2], xo[3]}; acc[ai][bj][m][1] = (f32x4){xo[4], xo[5], xo[6], xo[7]};
                }
    }
    __device__ __forceinline__ void operator()(const f32x4 (&acc)[2][2][4][2], const pg8::Unit& u, int wr, int wc, int fr, int fq) const {
        LAS float* part = (LAS float*)((LAS unsigned char*)lds + MISC_OFF + 1024);
#pragma unroll
        for (int aim = 0; aim < 4; ++aim) {
            const int ai = aim >> 1;
#pragma unroll
            for (int m2 = 0; m2 < 2; ++m2) {
                const int m = 2 * (aim & 1) + m2;
                const int rt = ai * 128 + wr * 64 + m * 16 + fr, row = u.pm * 256 + rt;
                float ssq = 0.f;
#pragma unroll
                for (int bj = 0; bj < 2; ++bj) {
                    const int col = u.pn * 256 + bj * 128 + wc * 32 + fq * 8;
                    const size_t off = (size_t)row * DM + col;
                    u32x4 w;
                    w[0] = cvtpk(acc[ai][bj][m][0][0], acc[ai][bj][m][0][1]); w[1] = cvtpk(acc[ai][bj][m][0][2], acc[ai][bj][m][0][3]);
                    w[2] = cvtpk(acc[ai][bj][m][1][0], acc[ai][bj][m][1][1]); w[3] = cvtpk(acc[ai][bj][m][1][2], acc[ai][bj][m][1][3]);
                    *(u32x4*)(XB + off) = w;
                    float xr[8]; unpack8(__builtin_bit_cast(bf16x8, w), xr);
#pragma unroll
                    for (int e = 0; e < 8; ++e) ssq = fmaf(xr[e], xr[e], ssq);
                }
                ssq = sum32x_f(sum16x_f(ssq));
                if (fq == 0) part[rt * 4 + wc] = ssq;
            }
            asm volatile("" ::: "memory");
        }
        __syncthreads();
        const int tid = (wr * 4 + wc) * 64 + fq * 16 + fr;
        if (tid < 256) { const f32x4 p4 = *(const LAS f32x4*)(part + tid * 4); RS[(size_t)(u.pm * 256 + tid) * 4 + u.pn] = (p4[0] + p4[1]) + (p4[2] + p4[3]); }
    }
};

struct Frame {
    unsigned char* lds; int wave, G;
    unsigned char* ws;
    __device__ __forceinline__ int lane_() const { return lane_id(); }
    __device__ __forceinline__ int tid_() const { return wave * 64 + lane_id(); }
    __device__ __forceinline__ unsigned* ctl_() const { return (unsigned*)(ws + WS_CTL); }
    __device__ __forceinline__ bf16_t* WIT_() const { return (bf16_t*)(ws + WS_WIT); }
    __device__ __forceinline__ bf16_t* WOT_() const { return (bf16_t*)(ws + WS_WOT); }
    __device__ __forceinline__ bf16_t* WCT_() const { return (bf16_t*)(ws + WS_WCT); }
    __device__ __forceinline__ bf16_t* PWT_() const { return (bf16_t*)(ws + WS_PWT); }
    __device__ __forceinline__ bf16_t* KCMP_() const { return (bf16_t*)(ws + WS_KCMP); }
    __device__ __forceinline__ bf16_t* VCMP_() const { return (bf16_t*)(ws + WS_VCMP); }
    __device__ __forceinline__ bf16_t* XB_() const { return (bf16_t*)(ws + WS_XB); }
    __device__ __forceinline__ bf16_t* Z_() const { return (bf16_t*)(ws + WS_Z); }
    __device__ __forceinline__ bf16_t* MIXED_() const { return (bf16_t*)(ws + WS_MIXED); }
    __device__ __forceinline__ f32x2* CS_() const { return (f32x2*)(ws + WS_CS); }
    __device__ __forceinline__ float* RS_() const { return (float*)(ws + WS_RS); }
    __device__ __forceinline__ float* WIF_() const { return (float*)(ws + WS_WIF); }
    __device__ __forceinline__ float* BGF_() const { return (float*)(ws + WS_BGF); }
    __device__ __forceinline__ unsigned* MASK_() const { return (unsigned*)(ws + WS_MASK); }
    __device__ __forceinline__ float* KP_() const { return (float*)(ws + WS_KP); }
    __device__ __forceinline__ unsigned* KMAX_() const { return (unsigned*)(ws + WS_CTL) + 8192; }
};

__device__ __forceinline__ int next_item(Frame& F, int q) {
    volatile unsigned* slot = (volatile unsigned*)(F.lds + MISC_OFF);
    __syncthreads();
    if (F.tid_() == 0) slot[0] = atomicAdd(F.ctl_() + 64 * q, 1u);
    __syncthreads();
    return __builtin_amdgcn_readfirstlane((int)slot[0]);
}
__device__ __forceinline__ unsigned xcc_id() { return (unsigned)__builtin_amdgcn_s_getreg((3 << 11) | 20) & 0xFu; }
__device__ __forceinline__ bool next_item_batch(Frame& F, int qfirst, int nitems, int& b, int& it) {
    const int home = (int)(xcc_id() & 7u);
    { const int v = next_item(F, qfirst + home); if (v < nitems) { b = home; it = v; return true; } }
    volatile unsigned* slot = (volatile unsigned*)(F.lds + MISC_OFF);
    for (;;) {
        __syncthreads();
        if (F.wave == 0) {
            const int l = F.lane_();
            unsigned c = 0xffffffffu;
            if (l < 8) c = __hip_atomic_load(F.ctl_() + 64 * (qfirst + l), __ATOMIC_RELAXED, __HIP_MEMORY_SCOPE_AGENT);
            const unsigned long long m = __ballot(c < (unsigned)nitems);
            if (l == 0) slot[1] = (unsigned)m;
        }
        __syncthreads();
        const unsigned mask = (unsigned)__builtin_amdgcn_readfirstlane((int)slot[1]) & 0xffu;
        if (mask == 0u) return false;
        const unsigned rot = ((mask >> home) | (mask << (8 - home))) & 0xffu;
        const int bq = (home + __builtin_ctz(rot)) & 7;
        const int v = next_item(F, qfirst + bq);
        if (v < nitems) { b = bq; it = v; return true; }
    }
}

template <int MAP>
__device__ __forceinline__ void transpose_item(const float* W, int K, int Nsrc, bf16_t* WT, int nblk, const float* kscale, float* scr, int item, int lane) {
    const int kb = item / nblk, nb = item % nblk, k0 = 64 * kb, n0 = 32 * nb;
    int sc = n0 + (lane & 31);
    if (MAP == 1) sc = src_col(sc);
    float vv[32], ks_[32];
    const int scc = sc >= 0 ? sc : 0;
#pragma unroll
    for (int i = 0; i < 32; ++i) { const int kk = 2 * i + (lane >> 5); vv[i] = W[(size_t)(k0 + kk) * Nsrc + scc]; ks_[i] = kscale ? kscale[k0 + kk] : 1.f; }
#pragma unroll
    for (int i = 0; i < 32; ++i) { const int kk = 2 * i + (lane >> 5); scr[kk * 33 + (lane & 31)] = (sc >= 0) ? vv[i] * ks_[i] : 0.f; }
    asm volatile("s_waitcnt lgkmcnt(0)" ::: "memory");
    const int c = lane & 7;
#pragma unroll
    for (int j = 0; j < 4; ++j) {
        const int n = (lane >> 3) + 8 * j; const float* s = scr + (8 * c) * 33 + n;
        u32x4 o; o[0] = cvtpk(s[0 * 33], s[1 * 33]); o[1] = cvtpk(s[2 * 33], s[3 * 33]); o[2] = cvtpk(s[4 * 33], s[5 * 33]); o[3] = cvtpk(s[6 * 33], s[7 * 33]);
        *(u32x4*)(WT + (size_t)(n0 + n) * K + k0 + 8 * c) = o;
    }
    asm volatile("s_waitcnt lgkmcnt(0)" ::: "memory");
}

__device__ __forceinline__ void sincos_d(double x, float& c, float& s) {
    const double TWO_OVER_PI = 0.63661977236758134308, PIO2_HI = 1.57079632679489655800e+00, PIO2_LO = 6.12323399573676603587e-17;
    const double kd = __builtin_rint(x * TWO_OVER_PI);
    const double r = (x - kd * PIO2_HI) - kd * PIO2_LO;
    const double r2 = r * r;
    double sp = -1.0 / 1307674368000.0;
    sp = sp * r2 + 1.0 / 6227020800.0;
    sp = sp * r2 - 1.0 / 39916800.0;
    sp = sp * r2 + 1.0 / 362880.0;
    sp = sp * r2 - 1.0 / 5040.0;
    sp = sp * r2 + 1.0 / 120.0;
    sp = sp * r2 - 1.0 / 6.0;
    const double sn = r + r * r2 * sp;
    double cp = 1.0 / 20922789888000.0;
    cp = cp * r2 - 1.0 / 87178291200.0;
    cp = cp * r2 + 1.0 / 479001600.0;
    cp = cp * r2 - 1.0 / 3628800.0;
    cp = cp * r2 + 1.0 / 40320.0;
    cp = cp * r2 - 1.0 / 720.0;
    cp = cp * r2 + 1.0 / 24.0;
    cp = cp * r2 - 0.5;
    const double cn = 1.0 + r2 * cp;
    const int q = ((int)kd) & 3;
    const double cc = (q == 0) ? cn : (q == 1) ? -sn : (q == 2) ? -cn : sn;
    const double ss = (q == 0) ? sn : (q == 1) ? cn : (q == 2) ? -sn : -cn;
    c = (float)cc; s = (float)ss;
}

__device__ __forceinline__ void phase_prologue(Frame& F, const Params& P) {
    float* scr = (float*)(F.lds + F.wave * 16384);
    const int gw = blockIdx.x * 8 + F.wave, NGW = F.G * 8;
    constexpr int I_IN = 16 * 112, I_OUT = 16 * 32, I_CMP = 32 * 2, I_POOL = 1 * 2;
    constexpr int N_IN = DEPTH * I_IN, N_OUT = DEPTH * I_OUT, N_CMP = DEPTH * 2 * I_CMP, N_POOL = DEPTH * 4 * I_POOL;
    for (int it = gw; it < N_IN + N_OUT + N_CMP + N_POOL; it += NGW) {
        int r = it;
        if (r < N_IN) { const int l = r / I_IN; transpose_item<1>(P.w_in + (size_t)l * DM * D_IN, DM, D_IN, F.WIT_() + (size_t)l * NZ * DM, 112, P.norm_w + l * DM, scr, r % I_IN, F.lane_()); continue; }
        r -= N_IN;
        if (r < N_OUT) { const int l = r / I_OUT; transpose_item<0>(P.w_out + (size_t)l * DM * DM, DM, DM, F.WOT_() + (size_t)l * DM * DM, 32, nullptr, scr, r % I_OUT, F.lane_()); continue; }
        r -= N_OUT;
        if (r < N_CMP) { const int lk = r / I_CMP, l = lk >> 1, kv = lk & 1; const float* W = (kv ? P.w_cmp_v : P.w_cmp_k) + (size_t)l * 2048 * 64;
            transpose_item<0>(W, 2048, 64, F.WCT_() + (size_t)lk * 64 * 2048, 2, nullptr, scr, r % I_CMP, F.lane_()); continue; }
        r -= N_CMP;
        { const int lg = r / I_POOL; transpose_item<0>(P.pool_w + (size_t)lg * 64 * 64, 64, 64, F.PWT_() + (size_t)lg * 64 * 64, 2, nullptr, scr, r % I_POOL, F.lane_()); }
    }
    {
        const float inv[8] = {1.000000000e+00f, 1.939227432e-01f, 3.760603070e-02f, 7.292664610e-03f, 1.414213562e-03f, 2.742481884e-04f, 5.318296098e-05f, 1.031338616e-05f};
        for (int i = blockIdx.x * 512 + F.tid_(); i < SEQ * 8; i += F.G * 512) {
            const int t = i >> 3, f = i & 7;
            float iv = inv[0];
#pragma unroll
            for (int k = 1; k < 8; ++k) iv = (f == k) ? inv[k] : iv;
            const float ang = (float)t * iv;
            float c, s; sincos_d((double)ang, c, s);
            F.CS_()[i] = (f32x2){c, s};
        }
    }
    for (int row0 = gw * 4; row0 < MROWS; row0 += NGW * 4) {
        f32x4 v[4][4];
#pragma unroll
        for (int r = 0; r < 4; ++r) { const f32x4* xr = (const f32x4*)(P.x + (size_t)(row0 + r) * DM) + F.lane_();
#pragma unroll
            for (int j = 0; j < 4; ++j) v[r][j] = xr[64 * j]; }
#pragma unroll
        for (int r = 0; r < 4; ++r) {
            u32x2* o8 = (u32x2*)(F.XB_() + (size_t)(row0 + r) * DM) + F.lane_();
            float s = 0.f;
#pragma unroll
            for (int j = 0; j < 4; ++j) {
                u32x2 w; w[0] = cvtpk(v[r][j][0], v[r][j][1]); w[1] = cvtpk(v[r][j][2], v[r][j][3]); o8[64 * j] = w;
                const float a0 = __uint_as_float(w[0] << 16), a1 = __uint_as_float(w[0] & 0xffff0000u), a2 = __uint_as_float(w[1] << 16), a3 = __uint_as_float(w[1] & 0xffff0000u);
                s += (a0 * a0 + a1 * a1) + (a2 * a2 + a3 * a3);
            }
            s = wave_sum_f(s);
            if (F.lane_() < 4) F.RS_()[(size_t)(row0 + r) * 4 + F.lane_()] = (F.lane_() == 0) ? s : 0.f;
        }
    }
}

__device__ __forceinline__ void compress_item(Frame& F, const Params& P, int layer, int bitem) {
    const int witem = bitem;
    const int kv = witem & 1, ng = (witem >> 1) & 15, b = witem >> 5;
    int tid_ = F.tid_(); asm volatile("" : "+v"(tid_));
    const int lane = tid_ & 63, c = lane & 15, G = lane >> 4;
    const int n = 16 * ng + c, nc = n > 254 ? 254 : n;
    const bf16_t* zrow = F.Z_() + ((size_t)b * SEQ + 16 * nc) * NZ + (kv ? ZVC : ZKC) + 8 * G;
    const float* pe = P.pe_cmp + (size_t)layer * 32 * 64 + 8 * G;
    const bf16_t* wt = F.WCT_() + (size_t)(layer * 2 + kv) * 64 * 2048 + (size_t)c * 2048 + 8 * G;
    f32x4 acc[4];
#pragma unroll
    for (int nt = 0; nt < 4; ++nt) acc[nt] = (f32x4){0.f, 0.f, 0.f, 0.f};
#pragma unroll
    for (int kk = 0; kk < 8; ++kk) {
        const int ks = 8 * F.wave + kk;
        const int i = ks >> 1, d0 = 32 * (ks & 1);
        const bf16x8 zr = *(const bf16x8*)(zrow + (size_t)i * NZ + d0);
        const f32x4 p0 = *(const f32x4*)(pe + i * 64 + d0), p1 = *(const f32x4*)(pe + i * 64 + d0 + 4);
        float f[8]; unpack8(zr, f);
        u32x4 aw; aw[0] = cvtpk(f[0] + p0[0], f[1] + p0[1]); aw[1] = cvtpk(f[2] + p0[2], f[3] + p0[3]); aw[2] = cvtpk(f[4] + p1[0], f[5] + p1[1]); aw[3] = cvtpk(f[6] + p1[2], f[7] + p1[3]);
        const bf16x8 af = __builtin_bit_cast(bf16x8, aw);
#pragma unroll
        for (int nt = 0; nt < 4; ++nt) {
            const bf16x8 bf = *(const bf16x8*)(wt + (size_t)nt * 16 * 2048 + ks * 32);
            acc[nt] = __builtin_amdgcn_mfma_f32_16x16x32_bf16(af, bf, acc[nt], 0, 0, 0);
        }
    }
    {
        LAS float* red = (LAS float*)((LAS unsigned char*)F.lds) + F.wave * 1024 + lane;
#pragma unroll
        for (int nt = 0; nt < 4; ++nt)
#pragma unroll
            for (int e = 0; e < 4; ++e) red[(nt * 4 + e) * 64] = acc[nt][e];
    }
    __syncthreads();
    if (__builtin_amdgcn_readfirstlane(F.wave) == 0) {
    {
        const LAS float* red = (const LAS float*)((LAS unsigned char*)F.lds) + lane;
#pragma unroll
        for (int nt = 0; nt < 4; ++nt)
#pragma unroll
            for (int e = 0; e < 4; ++e) {
                float sacc = red[(nt * 4 + e) * 64];
#pragma unroll
                for (int w = 1; w < 8; ++w) sacc += red[w * 1024 + (nt * 4 + e) * 64];
                acc[nt][e] = sacc;
            }
    }
    bf16_t* dst = (kv ? F.VCMP_() : F.KCMP_()) + (size_t)b * 256 * 64;
#pragma unroll
    for (int nt = 0; nt < 4; ++nt)
#pragma unroll
        for (int e = 0; e < 4; ++e) {
            const int nn = 16 * ng + 4 * G + e;
            float v = acc[nt][e];
            int dcol = 16 * nt + c;
            if (kv == 0) {
                if (nt == 0) {
                    const float partner = dpp_f<0x128>(v);
                    const int tpos = 16 * nn + 31;
                    const f32x2 cs = F.CS_()[(tpos & (SEQ - 1)) * 8 + (c & 7)];
                    v = (c < 8) ? (v * cs[0] - partner * cs[1]) : (v * cs[0] + partner * cs[1]);
                }
                dcol = perm64(dcol);
            }
            if (nn > 254) v = 0.f;
            dst[(size_t)nn * 64 + dcol] = (bf16_t)(cvtpk(v, 0.f) & 0xffffu);
        }
    }
}

__device__ __forceinline__ void select_item(Frame& F, int b, int qg) {
    int tid_ = F.tid_(); asm volatile("" : "+v"(tid_));
    const int lane = tid_ & 63, half = lane >> 5, idx = lane & 31, c = lane & 15, G = lane >> 4;
    const int tA = qg * 16 + F.wave * 2, tq = tA + half;
    const size_t rowbase = (size_t)b * SEQ;
#if defined(ABL_SC2)
    const bf16x8 afrag = (bf16x8){(short)0x3f80, (short)0xbf80, (short)0x3f00, (short)0x3f80, (short)0x4000, (short)0xbf00, (short)0x3f80, (short)0x3e80};
#else
    const bf16x8 afrag = *(const bf16x8*)(F.Z_() + (rowbase + tA + (c >> 3)) * NZ + ZQI + (c & 7) * 32 + G * 8);
#endif
#if !(defined(ABL_SC1))
    s16x4 wX, wY;
    {
        const int wrow = c, kg = G;
        const f32x4 wv = *(const f32x4*)(F.WIF_() + (rowbase + tA + (kg >> 1)) * 8 + 4 * (kg & 1));
        const unsigned p01 = cvtpk(wv[0], wv[1]), p23 = cvtpk(wv[2], wv[3]);
        const bool onX = (wrow == 8 * (kg >> 1)), onY = (wrow == 8 * (kg >> 1) + 4);
        const unsigned x01 = onX ? p01 : 0u, x23 = onX ? p23 : 0u, y01 = onY ? p01 : 0u, y23 = onY ? p23 : 0u;
        wX = __builtin_bit_cast(s16x4, (u32x2){x01, x23}); wY = __builtin_bit_cast(s16x4, (u32x2){y01, y23});
    }
    const bf16x8 wXY = (bf16x8){wX[0], wX[1], wX[2], wX[3], wY[0], wY[1], wY[2], wY[3]};
#endif
#if defined(ABL_SC1)
    const f32x4 w4 = (f32x4){1.f, 0.5f, -0.25f, 2.f};
#endif
    const int nchunks = ((qg * 16) >> 8) + 1;
    constexpr int SEL_NBUF = 6, SEL_D = 4;
    LAS unsigned char* kl = (LAS unsigned char*)F.lds;
    const unsigned char* zb = (const unsigned char*)F.Z_();
    const int pk0 = 32 * F.wave + (lane >> 2);
#define SEL_G(k_) ((0x78u >> (2 * (k_))) & 3u)
    const int pG = (lane & 3) ^ (int)SEL_G((lane >> 4) & 3);
    unsigned soff = (unsigned)(((rowbase + pk0) * NZ + ZKI + pG * 8) * 2);
    const unsigned rbase = c * 64 + ((G ^ SEL_G((c >> 2) & 3)) << 4);
#undef SEL_G
    const int nch1 = nchunks - 1;
#define SEL_DMA(chunk_) do { const int cc_ = (chunk_) < nch1 ? (chunk_) : nch1; const unsigned so_ = soff + (unsigned)cc_ * (256u * NZ * 2u); \
        LAS unsigned char* dst_ = kl + ((chunk_) % SEL_NBUF) * 16384 + F.wave * 2048; \
        __builtin_amdgcn_global_load_lds((const unsigned*)(zb + so_), (LAS unsigned*)dst_, 16, 0, 0); \
        __builtin_amdgcn_global_load_lds((const unsigned*)(zb + so_ + 16u * NZ * 2u), (LAS unsigned*)(dst_ + 1024), 16, 0, 0); } while (0)
#pragma unroll
    for (int i = 0; i < SEL_D; ++i) SEL_DMA(i);
    unsigned u[128];
#pragma unroll
    for (int ch = 0; ch < 16; ++ch) {
        if (ch < nchunks) {
            SEL_DMA(ch + SEL_D);
            asm volatile("s_waitcnt vmcnt(%0)" :: "n"(2 * SEL_D) : "memory");
            __builtin_amdgcn_s_barrier();
            asm volatile("" ::: "memory");
            const LAS unsigned char* kb = kl + (ch % SEL_NBUF) * 16384 + rbase;
            typedef short s16x2_ __attribute__((ext_vector_type(2)));
            const s16x2_ z2 = (s16x2_){0, 0};
            bf16x8 kfr[3][2]; f32x4 xq[2], yq[2], scq[2];
            kfr[0][0] = *(const LAS bf16x8*)(kb); kfr[0][1] = *(const LAS bf16x8*)(kb + 1024);
            kfr[1][0] = *(const LAS bf16x8*)(kb + 2048); kfr[1][1] = *(const LAS bf16x8*)(kb + 3072);
#pragma unroll
            for (int t = 0; t < 10; ++t) {
                if (t + 2 < 8) { kfr[(t + 2) % 3][0] = *(const LAS bf16x8*)(kb + (2 * t + 4) * 1024); kfr[(t + 2) % 3][1] = *(const LAS bf16x8*)(kb + (2 * t + 5) * 1024); }
                if (t < 8) {
                    xq[t & 1] = __builtin_amdgcn_mfma_f32_16x16x32_bf16(afrag, kfr[t % 3][0], (f32x4){0.f, 0.f, 0.f, 0.f}, 0, 0, 0);
                    yq[t & 1] = __builtin_amdgcn_mfma_f32_16x16x32_bf16(afrag, kfr[t % 3][1], (f32x4){0.f, 0.f, 0.f, 0.f}, 0, 0, 0);
                }
                __builtin_amdgcn_sched_barrier(0);
                if (t >= 1 && t <= 8) {
                    const f32x4 x = xq[(t - 1) & 1], y = yq[(t - 1) & 1];
                    const unsigned bx0 = __builtin_bit_cast(unsigned, __builtin_elementwise_max(__builtin_bit_cast(s16x2_, cvtpk(x[0], x[1])), z2));
                    const unsigned bx1 = __builtin_bit_cast(unsigned, __builtin_elementwise_max(__builtin_bit_cast(s16x2_, cvtpk(x[2], x[3])), z2));
                    const unsigned by0 = __builtin_bit_cast(unsigned, __builtin_elementwise_max(__builtin_bit_cast(s16x2_, cvtpk(y[0], y[1])), z2));
                    const unsigned by1 = __builtin_bit_cast(unsigned, __builtin_elementwise_max(__builtin_bit_cast(s16x2_, cvtpk(y[2], y[3])), z2));
                    scq[(t - 1) & 1] = __builtin_amdgcn_mfma_f32_16x16x32_bf16(wXY, __builtin_bit_cast(bf16x8, (u32x4){bx0, bx1, by0, by1}), (f32x4){0.f, 0.f, 0.f, 0.f}, 0, 0, 0);
                }
                if (t >= 2) {
                    const int j = ch * 8 + t - 2;
                    const unsigned bits = __float_as_uint(scq[(t - 2) & 1][0]);
                    const unsigned ku = bits ^ ((unsigned)((int)bits >> 31) | 0x80000000u);
                    u[j] = ((32 * j + idx) <= tq) ? ku : 0u;
                }
                __builtin_amdgcn_sched_barrier(0);
            }
        } else {
#pragma unroll
            for (int jj = 0; jj < 8; ++jj) u[ch * 8 + jj] = 0u;
        }
    }
#undef SEL_DMA
    asm volatile("s_waitcnt vmcnt(0)" ::: "memory");
    unsigned myw[4] = {0u, 0u, 0u, 0u};
    if (qg < 16) {
#pragma unroll
        for (int jj = 0; jj < 8; ++jj) {
            const unsigned long long bal = __ballot(u[jj] != 0u);
            asm volatile("s_nop 1\n\tv_writelane_b32 %0, %1, %2" : "+v"(myw[0]) : "s"((unsigned)bal), "n"(jj));
            asm volatile("s_nop 1\n\tv_writelane_b32 %0, %1, %2" : "+v"(myw[0]) : "s"((unsigned)(bal >> 32)), "n"(32 + jj));
        }
    } else {
        const int nw = (nchunks + 3) >> 2;
#pragma unroll
        for (int w = 0; w < 4; ++w) {
            if (w < nw) {
#define TR_STAGE(J, M) _Pragma("unroll") for (int k = 0; k < 32; ++k) { if ((k & (J)) == 0) { \
                    const unsigned t_ = ((u[32 * w + k] >> (J)) ^ u[32 * w + k + (J)]) & (M); u[32 * w + k + (J)] ^= t_; u[32 * w + k] ^= (t_ << (J)); } }
#define TR_PERM(J, SA, SB) _Pragma("unroll") for (int k = 0; k < 32; ++k) { if ((k & (J)) == 0) { \
                    const unsigned a_ = u[32 * w + k], b_ = u[32 * w + k + (J)]; u[32 * w + k] = __builtin_amdgcn_perm(b_, a_, (SA)); u[32 * w + k + (J)] = __builtin_amdgcn_perm(b_, a_, (SB)); } }
                TR_PERM(16, 0x05040100u, 0x07060302u) TR_PERM(8, 0x06020400u, 0x07030501u) TR_STAGE(4, 0x0f0f0f0fu) TR_STAGE(2, 0x33333333u) TR_STAGE(1, 0x55555555u)
#undef TR_PERM
#undef TR_STAGE
            }
        }
        unsigned gt[4] = {0u, 0u, 0u, 0u}, eq[4];
#pragma unroll
        for (int w = 0; w < 4; ++w) eq[w] = (w < nw) ? 0xffffffffu : 0u;
        bool done = false, exact = false;
#pragma unroll
        for (int bit = 31; bit >= 0; --bit) {
            if (!__all(done)) {
                int cnt = 0;
#pragma unroll
                for (int w = 0; w < 4; ++w) { if (w < nw) cnt += __popc(gt[w] | (eq[w] & u[32 * w + bit])); }
                cnt = sum32_i(cnt);
                if (!done) {
                    const bool acc = cnt >= 256;
#pragma unroll
                    for (int w = 0; w < 4; ++w) {
                        if (w < nw) { const unsigned t_ = eq[w] & u[32 * w + bit]; gt[w] = acc ? gt[w] : (gt[w] | t_); eq[w] = acc ? t_ : (eq[w] ^ t_); }
                    }
                    if (cnt == 256) { done = true; exact = true; }
                }
            }
        }
        unsigned selw[4];
#pragma unroll
        for (int w = 0; w < 4; ++w) selw[w] = exact ? (gt[w] | eq[w]) : gt[w];
        if (!__all(exact)) {
            int ngt = 0;
#pragma unroll
            for (int w = 0; w < 4; ++w) ngt += __popc(gt[w]);
            ngt = sum32_i(ngt);
            const int need = 256 - ngt;
            int run = 0;
#pragma unroll
            for (int w = 0; w < 4; ++w) {
                if (w < nw) {
#pragma unroll
                    for (int i = 0; i < 32; ++i) {
                        const bool e = (!exact) && ((eq[w] >> i) & 1u);
                        const unsigned long long bq = __ballot(e);
                        const unsigned hm = half ? (unsigned)(bq >> 32) : (unsigned)bq;
                        const int below = __popc(hm & ((1u << idx) - 1u));
                        if (e && (run + below < need)) selw[w] |= (1u << i);
                        run += __popc(hm);
                    }
                }
            }
        }
#pragma unroll
        for (int w = 0; w < 4; ++w) {
            if (w < nw) {
#pragma unroll
                for (int i = 0; i < 32; ++i) {
                    const unsigned long long bal = __ballot((selw[w] >> i) & 1u);
                    asm volatile("s_nop 1\n\tv_writelane_b32 %0, %1, %2" : "+v"(myw[w]) : "s"((unsigned)bal), "n"(i));
                    asm volatile("s_nop 1\n\tv_writelane_b32 %0, %1, %2" : "+v"(myw[w]) : "s"((unsigned)(bal >> 32)), "n"(32 + i));
                }
            }
        }
    }
    unsigned* mrow = F.MASK_() + (rowbase + tq) * 128;
#pragma unroll
    for (int k = 0; k < 4; ++k) mrow[32 * k + idx] = myw[k];
}

template <int VAR>
__device__ __forceinline__ void convpool_item(Frame& F, const Params& P, int layer, int item) {
    int tid_ = F.tid_(); asm volatile("" : "+v"(tid_));
    const int lane = tid_ & 63;
    const int tok0 = item * 128 + F.wave * 16;
    LAS unsigned char* dub = (LAS unsigned char*)F.lds;
#pragma unroll
    for (int i = 0; i < 9; ++i) {
        const int r = 18 * F.wave + 2 * i + (lane >> 5), p = lane & 31;
        int grow = item * 128 - 16 + r; grow = grow < 0 ? 0 : grow;
        __builtin_amdgcn_global_load_lds((const unsigned*)(F.Z_() + (size_t)grow * NZ + ZDU + 8 * (p ^ (r & 15))), (LAS unsigned*)(dub + (18 * F.wave + 2 * i) * 512), 16, 0, 0);
    }
    if (VAR != 2) {
        const int h = lane >> 5, ch = lane & 31;
        const int t0h = tok0 + 8 * h, tp0 = t0h & (SEQ - 1);
        const bf16_t* zb = F.Z_() + (size_t)t0h * NZ + 8 * ch;
        const float* cw = P.conv_w + (size_t)layer * 3 * 256 + 8 * ch;
        bf16x8 rc[10], rx[10], ra[8], rg[8];
#pragma unroll
        for (int i = 0; i < 10; ++i) { const int d = i - 2; const int dd = (tp0 + d >= 0) ? d : 0;
            rc[i] = *(const bf16x8*)(zb + (ptrdiff_t)dd * NZ + ZCC); rx[i] = *(const bf16x8*)(zb + (ptrdiff_t)dd * NZ + ZCX); }
#pragma unroll
        for (int i = 0; i < 8; ++i) { ra[i] = *(const bf16x8*)(zb + (size_t)i * NZ + ZCB); rg[i] = *(const bf16x8*)(zb + (size_t)i * NZ + ZGC); }
        float w0[8], w1[8], w2[8];
        { const f32x4 a0 = *(const f32x4*)(cw), a1 = *(const f32x4*)(cw + 4), b0 = *(const f32x4*)(cw + 256), b1 = *(const f32x4*)(cw + 260), c0 = *(const f32x4*)(cw + 512), c1 = *(const f32x4*)(cw + 516);
#pragma unroll
          for (int e = 0; e < 4; ++e) { w0[e] = a0[e]; w0[4 + e] = a1[e]; w1[e] = b0[e]; w1[4 + e] = b1[e]; w2[e] = c0[e]; w2[4 + e] = c1[e]; } }
        float um2[8], um1[8];
        { float cc[8], cx[8]; unpack8(rc[0], cc); unpack8(rx[0], cx); const float z = (tp0 >= 2) ? 1.f : 0.f;
#pragma unroll
          for (int e = 0; e < 8; ++e) um2[e] = cc[e] * cx[e] * z; }
        { float cc[8], cx[8]; unpack8(rc[1], cc); unpack8(rx[1], cx); const float z = (tp0 >= 1) ? 1.f : 0.f;
#pragma unroll
          for (int e = 0; e < 8; ++e) um1[e] = cc[e] * cx[e] * z; }
#pragma unroll
        for (int i = 0; i < 8; ++i) {
            float cc[8], cx[8], a[8], bq[8], u[8], o[8];
            unpack8(rc[i + 2], cc); unpack8(rx[i + 2], cx); unpack8(ra[i], a); unpack8(rg[i], bq);
#pragma unroll
            for (int e = 0; e < 8; ++e) { u[e] = cc[e] * cx[e]; o[e] = bq[e] * (a[e] * (um2[e] * w0[e] + um1[e] * w1[e] + u[e] * w2[e])); }
            u32x4 w; w[0] = cvtpk(o[0], o[1]); w[1] = cvtpk(o[2], o[3]); w[2] = cvtpk(o[4], o[5]); w[3] = cvtpk(o[6], o[7]);
            *(u32x4*)(F.MIXED_() + (size_t)(t0h + i) * DM + 512 + 8 * ch) = w;
#pragma unroll
            for (int e = 0; e < 8; ++e) { um2[e] = um1[e]; um1[e] = u[e]; }
        }
    }
    const int tk = lane & 15, G = lane >> 4, row = tok0 + tk, tpos = row & (SEQ - 1);
    const bf16_t* zr = F.Z_() + (size_t)row * NZ;
    {
        const int zk[3] = {ZKA, ZKS, ZKW};
#pragma unroll
        for (int ty = 0; ty < 3; ++ty) {
            float f0[8], f1[8]; unpack8(*(const bf16x8*)(zr + zk[ty] + 16 * G), f0); unpack8(*(const bf16x8*)(zr + zk[ty] + 16 * G + 8), f1);
            float ss = 0.f;
#pragma unroll
            for (int e = 0; e < 8; ++e) ss += f0[e] * f0[e] + f1[e] * f1[e];
            ss = sum32x_f(sum16x_f(ss));
            ss = fmaxf(ss, dpp_f<0xB1>(ss)); ss = fmaxf(ss, dpp_f<0x4E>(ss)); ss = fmaxf(ss, dpp_f<0x141>(ss)); ss = fmaxf(ss, dpp_f<0x140>(ss));
            if (lane == 0) F.KP_()[((layer * 8 + (row >> 12)) * 3 + ty) * 256 + (item & 31) * 8 + F.wave] = ss;
        }
    }
    asm volatile("s_waitcnt vmcnt(0)" ::: "memory");
    __syncthreads();
    const int lr = 16 + 16 * F.wave + tk;
    bf16x8 wfr[2][4]; f32x4 scv[4]; s16x4 gtv[4];
#define POOL_LOAD_W(GG) do { _Pragma("unroll") for (int ks = 0; ks < 2; ++ks) _Pragma("unroll") for (int dt = 0; dt < 4; ++dt) \
            wfr[ks][dt] = *(const bf16x8*)(F.PWT_() + (size_t)(layer * 4 + (GG)) * 4096 + (size_t)(16 * dt + tk) * 64 + 32 * ks + 8 * G); \
        _Pragma("unroll") for (int dt = 0; dt < 4; ++dt) { const int dcol = (GG) * 64 + 16 * dt + 4 * G; scv[dt] = *(const f32x4*)(P.pool_scale + (size_t)layer * 256 + dcol); gtv[dt] = *(const s16x4*)(zr + ZGD + dcol); } } while (0)
    POOL_LOAD_W(0);
#pragma unroll
    for (int g = 0; g < (VAR == 3 ? 0 : 4); ++g) {
        const int win = 2 << g;
        const int cntw = (tpos + 1 < win) ? (tpos + 1) : win;
        const float invc = 1.0f / (float)cntw;
        f32x4 acc[4];
#pragma unroll
        for (int dt = 0; dt < 4; ++dt) acc[dt] = (f32x4){0.f, 0.f, 0.f, 0.f};
        u32x4 pwk[2];
#pragma unroll
        for (int ks = 0; ks < 2; ++ks) {
            const int c = g * 8 + 4 * ks + G;
            float sum[8], self[8];
            unpack8(*(const LAS bf16x8*)(dub + lr * 512 + ((c ^ (lr & 15)) << 4)), self);
#pragma unroll
            for (int e = 0; e < 8; ++e) sum[e] = self[e];
#pragma unroll
            for (int j = 1; j < win; ++j) { const bool in = (j <= tpos); const int rr = lr - (in ? j : 0); float f[8]; unpack8(*(const LAS bf16x8*)(dub + rr * 512 + ((c ^ (rr & 15)) << 4)), f); const float wgt = in ? 1.f : 0.f;
#pragma unroll
                for (int e = 0; e < 8; ++e) sum[e] = fmaf(wgt, f[e], sum[e]); }
#pragma unroll
            for (int e = 0; e < 4; ++e) pwk[ks][e] = cvtpk(sum[2 * e] * invc - self[2 * e], sum[2 * e + 1] * invc - self[2 * e + 1]);
        }
#pragma unroll
        for (int ks = 0; ks < 2; ++ks) {
            const bf16x8 pf = __builtin_bit_cast(bf16x8, pwk[ks]);
#pragma unroll
            for (int dt = 0; dt < 4; ++dt) acc[dt] = __builtin_amdgcn_mfma_f32_16x16x32_bf16(wfr[ks][dt], pf, acc[dt], 0, 0, 0);
        }
        u32x2 wo[4];
#pragma unroll
        for (int dt = 0; dt < 4; ++dt) {
            const f32x4 sc = scv[dt]; const s16x4 gt = gtv[dt];
            wo[dt][0] = cvtpk(acc[dt][0] * sc[0] * bf2f((unsigned short)gt[0]), acc[dt][1] * sc[1] * bf2f((unsigned short)gt[1]));
            wo[dt][1] = cvtpk(acc[dt][2] * sc[2] * bf2f((unsigned short)gt[2]), acc[dt][3] * sc[3] * bf2f((unsigned short)gt[3]));
        }
        if (g < 3) POOL_LOAD_W(g + 1);
#pragma unroll
        for (int dt = 0; dt < 4; ++dt) *(u32x2*)(F.MIXED_() + (size_t)row * DM + 768 + g * 64 + 16 * dt + 4 * G) = wo[dt];
    }
#undef POOL_LOAD_W
    __syncthreads();
}

__device__ __forceinline__ int crow(int r, int hi) { return (r & 3) + 8 * (r >> 2) + 4 * hi; }
__device__ __forceinline__ s16x4 vtr(const LAS unsigned char* p) { return __builtin_bit_cast(s16x4, __builtin_amdgcn_ds_read_tr16_b64_v4i16((LAS s16x4*)p)); }

struct AttnCtx {
    int tid, lane, r32, hi, wave, qs, h;
    int b, qb, t;
    unsigned char* lds;
    int st_key, st_chunk;
    unsigned kwoff, vwoff;
    unsigned kroff[2];
    unsigned vbase;
    int vq;
};

__device__ __forceinline__ void attn_ctx_init(AttnCtx& A, Frame& F, int b, int qb) {
    int tid_ = F.tid_(); asm volatile("" : "+v"(tid_));
    A.tid = tid_; A.lane = tid_ & 63; A.r32 = A.lane & 31; A.hi = A.lane >> 5; A.wave = F.wave; A.qs = F.wave >> 2; A.h = F.wave & 3;
    A.b = b; A.qb = qb; A.t = qb * 64 + A.qs * 32 + A.r32; A.lds = F.lds;
    A.st_key = tid_ >> 3; A.st_chunk = tid_ & 7;
    A.kwoff = A.st_key * 128 + ((A.st_chunk ^ ((A.st_key >> 1) & 7)) << 4);
    A.vwoff = A.st_key * 128 + ((A.st_chunk ^ (((A.st_key >> 1) & 1) << 2)) << 4);
    const int i = A.lane & 15, q = i >> 2, p = i & 3, g1 = (A.lane >> 4) & 1;
    A.vq = (q >> 1) & 1;
    A.vbase = (4 * A.hi + q) * 128 + (2 * g1 + (p >> 1)) * 16 + (p & 1) * 8;
}

__device__ __forceinline__ void k_frags(const AttnCtx& A, const LAS unsigned char* kb, bf16x8 (&kf)[8]) {
    const int k0 = A.r32, k1 = 32 + A.r32;
#pragma unroll
    for (int ks = 0; ks < 4; ++ks) {
        kf[2 * ks + 0] = *(const LAS bf16x8*)(kb + k0 * 128 + (((2 * ks + A.hi) ^ ((k0 >> 1) & 7)) << 4));
        kf[2 * ks + 1] = *(const LAS bf16x8*)(kb + k1 * 128 + (((2 * ks + A.hi) ^ ((k1 >> 1) & 7)) << 4));
    }
}
__device__ __forceinline__ void qk_mma(const bf16x8 (&kf)[8], const bf16x8 (&qf)[4], f32x16& p0, f32x16& p1) {
    p0 = (f32x16){0.f}; p1 = (f32x16){0.f};
#pragma unroll
    for (int ks = 0; ks < 4; ++ks) {
        p0 = __builtin_amdgcn_mfma_f32_32x32x16_bf16(kf[2 * ks + 0], qf[ks], p0, 0, 0, 0);
        p1 = __builtin_amdgcn_mfma_f32_32x32x16_bf16(kf[2 * ks + 1], qf[ks], p1, 0, 0, 0);
    }
}
__device__ __forceinline__ void qk_tile(const AttnCtx& A, const LAS unsigned char* kb, const bf16x8 (&qf)[4], f32x16& p0, f32x16& p1) {
    bf16x8 kf[8]; k_frags(A, kb, kf); qk_mma(kf, qf, p0, p1);
}
__device__ __forceinline__ void v_frags(const AttnCtx& A, const LAS unsigned char* vb, bf16x8 (&vf)[8]) {
#pragma unroll
    for (int s = 0; s < 4; ++s)
#pragma unroll
        for (int dt = 0; dt < 2; ++dt) {
            const LAS unsigned char* base = vb + A.vbase + (16 * s) * 128 + ((dt ^ A.vq) * 64);
            const s16x4 lo = vtr(base), hi4 = vtr(base + 8 * 128);
            vf[2 * s + dt] = (bf16x8){lo[0], lo[1], lo[2], lo[3], hi4[0], hi4[1], hi4[2], hi4[3]};
        }
}
__device__ __forceinline__ void p_pack(const f32x16& p0, const f32x16& p1, bf16x8 (&pf)[4]) {
#pragma unroll
    for (int s = 0; s < 4; ++s) {
        const f32x16& pp = (s >> 1) ? p1 : p0; const int rb = 8 * (s & 1);
        u32x4 pw; pw[0] = cvtpk(pp[rb + 0], pp[rb + 1]); pw[1] = cvtpk(pp[rb + 2], pp[rb + 3]); pw[2] = cvtpk(pp[rb + 4], pp[rb + 5]); pw[3] = cvtpk(pp[rb + 6], pp[rb + 7]);
        pf[s] = __builtin_bit_cast(bf16x8, pw);
    }
}
__device__ __forceinline__ void pv_mma(const bf16x8 (&vf)[8], const bf16x8 (&pf)[4], f32x16& o0, f32x16& o1) {
#pragma unroll
    for (int s = 0; s < 4; ++s) {
        o0 = __builtin_amdgcn_mfma_f32_32x32x16_bf16(vf[2 * s + 0], pf[s], o0, 0, 0, 0);
        o1 = __builtin_amdgcn_mfma_f32_32x32x16_bf16(vf[2 * s + 1], pf[s], o1, 0, 0, 0);
    }
}
__device__ __forceinline__ void pv_tile(const AttnCtx& A, const LAS unsigned char* vb, const f32x16& p0, const f32x16& p1, f32x16& o0, f32x16& o1) {
    bf16x8 vf[8], pf[4]; v_frags(A, vb, vf); p_pack(p0, p1, pf); pv_mma(vf, pf, o0, o1);
}
__device__ __forceinline__ float max16(const f32x16& p) {
    float a = fmaxf(fmaxf(p[0], p[1]), fmaxf(p[2], p[3])), b = fmaxf(fmaxf(p[4], p[5]), fmaxf(p[6], p[7]));
    float c = fmaxf(fmaxf(p[8], p[9]), fmaxf(p[10], p[11])), d = fmaxf(fmaxf(p[12], p[13]), fmaxf(p[14], p[15]));
    return fmaxf(fmaxf(a, b), fmaxf(c, d));
}
__device__ __forceinline__ float sum16(const f32x16& p) {
    return (((p[0] + p[1]) + (p[2] + p[3])) + ((p[4] + p[5]) + (p[6] + p[7]))) + (((p[8] + p[9]) + (p[10] + p[11])) + ((p[12] + p[13]) + (p[14] + p[15])));
}

__device__ __forceinline__ float mask_bit(float p, unsigned w, int pos) {
    const unsigned mk = (unsigned)__builtin_amdgcn_sbfe((int)w, pos, 1);
    return __uint_as_float((__float_as_uint(p) & mk) | (0xff800000u & ~mk));
}
template <int MODE>
__device__ __forceinline__ void tile_mask(const AttnCtx& A, f32x16& p0, f32x16& p1, bool active, unsigned w0, unsigned w1, bool blk, int kt, int iq) {
    if (active) {
        if (MODE == 0) {
#pragma unroll
            for (int r = 0; r < 16; ++r) { const int cpos = (r & 3) + 8 * (r >> 2); p0[r] = mask_bit(p0[r], w0, cpos); p1[r] = mask_bit(p1[r], w1, cpos); }
        } else if (MODE == 1) {
            const bool diag = (kt == A.qb);
#pragma unroll
            for (int r = 0; r < 16; ++r) { const int kp = crow(r, A.hi);
                p0[r] = (blk && (!diag || kp <= iq)) ? p0[r] : -INFINITY; p1[r] = (blk && (!diag || (kp + 32) <= iq)) ? p1[r] : -INFINITY; }
        } else {
            const bool diag = (kt == A.qb), tail = (kt == A.qb - 8);
            if (diag || tail) {
#pragma unroll
                for (int r = 0; r < 16; ++r) { const int kp = crow(r, A.hi);
                    const bool v0 = diag ? (kp <= iq) : (kp > iq), v1 = diag ? ((kp + 32) <= iq) : ((kp + 32) > iq);
                    p0[r] = v0 ? p0[r] : -INFINITY; p1[r] = v1 ? p1[r] : -INFINITY; }
            }
        }
    } else {
#pragma unroll
        for (int r = 0; r < 16; ++r) { p0[r] = -INFINITY; p1[r] = -INFINITY; }
    }
}

__device__ __forceinline__ void qk_mma_c(const bf16x8 (&kf)[8], const bf16x8 (&qf)[4], const f32x16& c0, const f32x16& c1, f32x16& p0, f32x16& p1) {
    p0 = __builtin_amdgcn_mfma_f32_32x32x16_bf16(kf[0], qf[0], c0, 0, 0, 0);
    p1 = __builtin_amdgcn_mfma_f32_32x32x16_bf16(kf[1], qf[0], c1, 0, 0, 0);
#pragma unroll
    for (int ks = 1; ks < 4; ++ks) {
        p0 = __builtin_amdgcn_mfma_f32_32x32x16_bf16(kf[2 * ks + 0], qf[ks], p0, 0, 0, 0);
        p1 = __builtin_amdgcn_mfma_f32_32x32x16_bf16(kf[2 * ks + 1], qf[ks], p1, 0, 0, 0);
    }
}
__device__ __forceinline__ float init_bit(float negref, unsigned w, int pos) {
    const unsigned mk = (unsigned)__builtin_amdgcn_sbfe((int)w, pos, 1);
    return __uint_as_float((__float_as_uint(negref) & mk) | (0xff800000u & ~mk));
}
__device__ __forceinline__ float q_norm2(const AttnCtx& A, const bf16x8 (&qf)[4]) {
    float ss = 0.f;
#pragma unroll
    for (int ks = 0; ks < 4; ++ks) { float f[8]; unpack8(qf[ks], f);
#pragma unroll
        for (int e = 0; e < 8; ++e) ss = fmaf(f[e], f[e], ss); }
    return sum32x_f(ss);
}

template <int MODE>
__device__ __forceinline__ void attn_stream(const AttnCtx& A, const bf16_t* Kg, const bf16_t* Vg, int kt0, int kt1, const bf16x8 (&qf)[4], float negref,
                                            f32x16& o0, f32x16& o1, float& lsum, const unsigned* mrow, unsigned long long bm) {
    LAS unsigned char* kbuf = (LAS unsigned char*)A.lds + L_K; LAS unsigned char* vbuf = (LAS unsigned char*)A.lds + L_V;
    LAS unsigned char* mbuf = (LAS unsigned char*)A.lds + L_IMP;
    const int iq = A.qs * 32 + A.r32;
    const int nsteps = (kt1 - kt0 + 2) >> 1;
    const int dkey = 8 * A.wave + (A.lane >> 3), dpc = A.lane & 7;
    const bf16_t* kgl = Kg + (size_t)dkey * NZ + 8 * (dpc ^ ((dkey >> 1) & 7));
    const bf16_t* vgl = Vg + (size_t)dkey * NZ + 8 * (dpc ^ (((dkey >> 1) & 1) << 2));
    const int wofs = A.wave * 1024;
    if (__builtin_amdgcn_readfirstlane(A.wave) >= 4) __builtin_amdgcn_s_setprio(1);
#define ATTN_DMA(STEP) do { const int ka_ = kt0 + 2 * (STEP), kb2_ = ka_ + 1; const int bo_ = ((STEP) & 1) * 16384 + wofs; \
        __builtin_amdgcn_global_load_lds((const unsigned*)(kgl + (size_t)ka_ * 64 * NZ), (LAS unsigned*)(kbuf + bo_), 16, 0, 0); \
        __builtin_amdgcn_global_load_lds((const unsigned*)(vgl + (size_t)ka_ * 64 * NZ), (LAS unsigned*)(vbuf + bo_), 16, 0, 0); \
        { const int kb3_ = kb2_ <= kt1 ? kb2_ : ka_;        \
            __builtin_amdgcn_global_load_lds((const unsigned*)(kgl + (size_t)kb3_ * 64 * NZ), (LAS unsigned*)(kbuf + bo_ + 8192), 16, 0, 0); \
            __builtin_amdgcn_global_load_lds((const unsigned*)(vgl + (size_t)kb3_ * 64 * NZ), (LAS unsigned*)(vbuf + bo_ + 8192), 16, 0, 0); } \
        if (MODE == 0) __builtin_amdgcn_global_load_lds((const unsigned*)(mrow + 2 * ka_), (LAS unsigned*)(mbuf + ((STEP) & 1) * 8192 + wofs), 16, 0, 0); \
    } while (0)
    ATTN_DMA(0);
    for (int s = 0; s < nsteps; ++s) {
        __syncthreads();
        if (s + 1 < nsteps) ATTN_DMA(s + 1);
        const int ktA = kt0 + 2 * s, ktB = ktA + 1; const bool haveB = ktB <= kt1;
        u32x2 cwA = (u32x2){0u, 0u}, cwB = (u32x2){0u, 0u};
        if (MODE == 0) { const u32x4 mw = *(const LAS u32x4*)(mbuf + (s & 1) * 8192 + wofs + 16 * A.lane); cwA[0] = mw[0]; cwA[1] = mw[1]; cwB[0] = haveB ? mw[2] : 0u; cwB[1] = haveB ? mw[3] : 0u; }
        const LAS unsigned char* kb = kbuf + (s & 1) * 16384; const LAS unsigned char* vb = vbuf + (s & 1) * 16384;
        bool blkA = true, blkB = haveB;
        if (MODE == 1) { blkA = (bm >> ktA) & 1ull; blkB = haveB && ((bm >> ktB) & 1ull); }
#define ATTN_CINIT(C0, C1, W0, W1, BLK) do { \
            if (MODE == 0) { _Pragma("unroll") for (int r = 0; r < 16; ++r) { const int cpos = (r & 3) + 8 * (r >> 2); C0[r] = init_bit(negref, (W0), cpos); C1[r] = init_bit(negref, (W1), cpos); } } \
            else { const float base = (BLK) ? negref : -INFINITY; _Pragma("unroll") for (int r = 0; r < 16; ++r) { C0[r] = base; C1[r] = base; } } } while (0)
#define ATTN_SOFT(P0, P1, PF, KT) do { \
            if (MODE == 1) { if ((KT) == A.qb) { _Pragma("unroll") for (int r = 0; r < 16; ++r) { const int kp = crow(r, A.hi); P0[r] = (kp <= iq) ? P0[r] : -INFINITY; P1[r] = ((kp + 32) <= iq) ? P1[r] : -INFINITY; } } } \
            if (MODE == 2) { const bool diag = ((KT) == A.qb), tail = ((KT) == A.qb - 8); if (diag || tail) { _Pragma("unroll") for (int r = 0; r < 16; ++r) { const int kp = crow(r, A.hi); \
                const bool v0 = diag ? (kp <= iq) : (kp > iq), v1 = diag ? ((kp + 32) <= iq) : ((kp + 32) > iq); P0[r] = v0 ? P0[r] : -INFINITY; P1[r] = v1 ? P1[r] : -INFINITY; } } } \
            _Pragma("unroll") for (int r = 0; r < 16; ++r) { P0[r] = fast_exp2(P0[r]); P1[r] = fast_exp2(P1[r]); } \
            lsum += sum16(P0) + sum16(P1); \
            p_pack(P0, P1, PF); } while (0)
        bf16x8 kf[8]; k_frags(A, kb, kf);
        f32x16 pA0, pA1; ATTN_CINIT(pA0, pA1, cwA[0] >> (4 * A.hi), cwA[1] >> (4 * A.hi), blkA);
        __builtin_amdgcn_sched_barrier(0);
        qk_mma_c(kf, qf, pA0, pA1, pA0, pA1);
        f32x16 pB0, pB1; ATTN_CINIT(pB0, pB1, cwB[0] >> (4 * A.hi), cwB[1] >> (4 * A.hi), blkB);
        __builtin_amdgcn_sched_barrier(0);
        k_frags(A, kb + 8192, kf);
        qk_mma_c(kf, qf, pB0, pB1, pB0, pB1);
        bf16x8 pfA[4]; ATTN_SOFT(pA0, pA1, pfA, ktA);
        __builtin_amdgcn_sched_barrier(0);
        bf16x8 vf[8]; v_frags(A, vb, vf);
        pv_mma(vf, pfA, o0, o1);
        bf16x8 pfB[4]; ATTN_SOFT(pB0, pB1, pfB, ktB);
        __builtin_amdgcn_sched_barrier(0);
        v_frags(A, vb + 8192, vf);
        pv_mma(vf, pfB, o0, o1);
#undef ATTN_SOFT
#undef ATTN_CINIT
    }
#undef ATTN_DMA
    __builtin_amdgcn_s_setprio(0);
    __syncthreads();
}

__device__ __forceinline__ void load_q(const AttnCtx& A, const bf16_t* Zq  , bf16x8 (&qf)[4]) {
    const bf16_t* qp = Zq + ((size_t)A.b * SEQ + A.t) * NZ + 64 * A.h + 8 * A.hi;
#pragma unroll
    for (int ks = 0; ks < 4; ++ks) qf[ks] = *(const bf16x8*)(qp + 16 * ks);
}
__device__ __forceinline__ void store_out(const AttnCtx& A, Frame& F, const f32x16& o0, const f32x16& o1, int zgate, int colbase) {
    const size_t row = (size_t)A.b * SEQ + A.t;
#pragma unroll
    for (int dt = 0; dt < 2; ++dt)
#pragma unroll
        for (int k = 0; k < 4; ++k) {
            const int d = 32 * dt + 8 * k + 4 * A.hi;
            const s16x4 gt = *(const s16x4*)(F.Z_() + row * NZ + zgate + 64 * A.h + d);
            const f32x16& o = dt ? o1 : o0;
            u32x2 w; w[0] = cvtpk(o[4 * k + 0] * bf2f((unsigned short)gt[0]), o[4 * k + 1] * bf2f((unsigned short)gt[1]));
            w[1] = cvtpk(o[4 * k + 2] * bf2f((unsigned short)gt[2]), o[4 * k + 3] * bf2f((unsigned short)gt[3]));
            *(u32x2*)(F.MIXED_() + row * DM + colbase + 64 * A.h + d) = w;
        }
}

__device__ __forceinline__ float kmax_load(Frame& F, int layer, int b, int ty, int lane) {
    const f32x4 v = *(const f32x4*)(F.KP_() + ((layer * 8 + b) * 3 + ty) * 256 + 4 * lane);
    float m = fmaxf(fmaxf(v[0], v[1]), fmaxf(v[2], v[3]));
    m = fmaxf(m, dpp_f<0xB1>(m)); m = fmaxf(m, dpp_f<0x4E>(m)); m = fmaxf(m, dpp_f<0x141>(m)); m = fmaxf(m, dpp_f<0x140>(m));
    return max32x_f(max16x_f(m));
}
__device__ __forceinline__ void dsa_attn_item(Frame& F, int layer, int b, int qb) {
    AttnCtx A; attn_ctx_init(A, F, b, qb);
    bf16x8 qf[4]; load_q(A, F.Z_() + ZQA, qf);
    const float kmx = kmax_load(F, layer, b, 0, A.lane);
    const float negref = -sqrtf(q_norm2(A, qf) * kmx);
    f32x16 o0 = (f32x16){0.f}, o1 = (f32x16){0.f}; float ol = 0.f;
    const unsigned* mrow = F.MASK_() + ((size_t)b * SEQ + A.t) * 128;
    attn_stream<0>(A, F.Z_() + (size_t)b * SEQ * NZ + ZKA, F.Z_() + (size_t)b * SEQ * NZ + ZVA, 0, qb, qf, negref, o0, o1, ol, mrow, 0ull);
    const float l = sum32x_f(ol);
    const float il = l > 0.f ? 1.0f / l : 0.f;
#pragma unroll
    for (int r = 0; r < 16; ++r) { o0[r] *= il; o1[r] *= il; }
    store_out(A, F, o0, o1, ZGA, 0);
}

__device__ __forceinline__ void nsa_item(Frame& F, int layer, int b, int qb) {
    AttnCtx A; attn_ctx_init(A, F, b, qb);
    bf16x8 qf[4]; load_q(A, F.Z_() + ZQB, qf);
    const size_t row = (size_t)b * SEQ + A.t;
    const float g_c = F.BGF_()[row * 16 + 3 * A.h + 0], g_s = F.BGF_()[row * 16 + 3 * A.h + 1], g_w = F.BGF_()[row * 16 + 3 * A.h + 2];
    f32x16 out0 = (f32x16){0.f}, out1 = (f32x16){0.f};
    LAS unsigned char* kbuf = (LAS unsigned char*)F.lds + L_K; LAS unsigned char* vbuf = (LAS unsigned char*)F.lds + L_V;
    float* impw = (float*)(F.lds + L_IMP);
    {
        const bf16_t* kc = F.KCMP_() + (size_t)b * 256 * 64; const bf16_t* vc = F.VCMP_() + (size_t)b * 256 * 64;
#pragma unroll
        for (int i = 0; i < 4; ++i) {
            const int key = 64 * i + A.st_key;
            const u32x4 kr = *(const u32x4*)(kc + (size_t)key * 64 + 8 * A.st_chunk), vr = *(const u32x4*)(vc + (size_t)key * 64 + 8 * A.st_chunk);
            *(LAS u32x4*)(kbuf + i * 8192 + A.kwoff) = kr; *(LAS u32x4*)(vbuf + i * 8192 + A.vwoff) = vr;
        }
        __syncthreads();
        const int nmax = (qb * 64 + 63 - 31) >> 4;
        const int ntile = (nmax >> 6) + 1;
        float mx = -1e30f, lsum = 0.f;
        for (int i = 0; i < ntile; ++i) {
            f32x16 p0, p1;
            qk_tile(A, kbuf + i * 8192, qf, p0, p1);
#pragma unroll
            for (int r = 0; r < 16; ++r) { const int n0 = 64 * i + crow(r, A.hi), n1 = n0 + 32;
                p0[r] = (16 * n0 + 31 <= A.t) ? p0[r] : -INFINITY; p1[r] = (16 * n1 + 31 <= A.t) ? p1[r] : -INFINITY; }
            float tm = fmaxf(max16(p0), max16(p1)); tm = fmaxf(tm, xhalf(tm));
            const float mn = fmaxf(mx, tm), alpha = fast_exp2(mx - mn);
#pragma unroll
            for (int r = 0; r < 16; ++r) { p0[r] = fast_exp2(p0[r] - mn); p1[r] = fast_exp2(p1[r] - mn); }
            float rs = sum16(p0) + sum16(p1); rs += xhalf(rs);
            lsum = lsum * alpha + rs; mx = mn;
        }
        const float il = lsum > 0.f ? 1.0f / lsum : 0.f;
        float* ip = impw + ((size_t)A.h * 64 + (A.qs * 32 + A.r32)) * 64;
        float prev_other = 0.f;
        for (int i = 0; i < 4; ++i) {
            if (i < ntile) {
                f32x16 p0, p1;
                qk_tile(A, kbuf + i * 8192, qf, p0, p1);
#pragma unroll
                for (int r = 0; r < 16; ++r) { const int n0 = 64 * i + crow(r, A.hi), n1 = n0 + 32;
                    p0[r] = (16 * n0 + 31 <= A.t) ? fast_exp2(p0[r] - mx) * il : 0.f; p1[r] = (16 * n1 + 31 <= A.t) ? fast_exp2(p1[r] - mx) * il : 0.f; }
#pragma unroll
                for (int rt = 0; rt < 2; ++rt)
#pragma unroll
                    for (int k = 0; k < 4; ++k) {
                        const f32x16& pp = rt ? p1 : p0;
                        const float gs = (pp[4 * k] + pp[4 * k + 1]) + (pp[4 * k + 2] + pp[4 * k + 3]);
                        const float other = xhalf(pp[4 * k + 3]);
                        ip[16 * i + 8 * rt + 2 * k + A.hi] = gs + (A.hi ? other : prev_other);
                        prev_other = other;
                    }
                pv_tile(A, vbuf + i * 8192, p0, p1, out0, out1);
            } else {
#pragma unroll
                for (int j = 0; j < 8; ++j) ip[16 * i + 2 * j + A.hi] = 0.f;
            }
        }
#pragma unroll
        for (int r = 0; r < 16; ++r) { out0[r] *= g_c; out1[r] *= g_c; }
    }
    __syncthreads();
    {
        unsigned long long* bmp = (unsigned long long*)(F.lds + L_BM);
        for (int qg4 = 0; qg4 < 1; ++qg4) {
            const int j = A.lane;
            unsigned key[8], T[8];
#pragma unroll
            for (int k = 0; k < 8; ++k) {
                const int q = F.wave * 8 + k;
                float v = ((impw[(0 * 64 + q) * 64 + j] + impw[(1 * 64 + q) * 64 + j]) + impw[(2 * 64 + q) * 64 + j]) + impw[(3 * 64 + q) * 64 + j];
                if (j == 0 || j == qb) v = INFINITY; else if (j > qb) v = -INFINITY;
                const unsigned bits = __float_as_uint(v);
                key[k] = (bits & 0x80000000u) ? ~bits : (bits | 0x80000000u);
                T[k] = 0u;
            }
#pragma unroll 4
            for (int bit = 31; bit >= 0; --bit) {
#pragma unroll
                for (int k = 0; k < 8; ++k) {
                    const unsigned cand = T[k] | (1u << bit);
                    const int cnt = __popcll(__ballot(key[k] >= cand));
                    T[k] = (cnt >= 16) ? cand : T[k];
                }
            }
#pragma unroll
            for (int k = 0; k < 8; ++k) {
                const int q = F.wave * 8 + k;
                const unsigned long long gtm = __ballot(key[k] > T[k]), eqm = __ballot(key[k] == T[k]);
                const int need = 16 - __popcll(gtm);
                const int below = __popcll(eqm & ((1ull << j) - 1ull));
                const unsigned long long sel = __ballot((j <= qb) && ((key[k] > T[k]) || ((key[k] == T[k]) && below < need)));
                if (A.lane == 0) bmp[q] = sel;
            }
        }
    }
    __syncthreads();
    const unsigned long long bm = ((const unsigned long long*)(F.lds + L_BM))[A.qs * 32 + A.r32];
    LAS float* ow = (LAS float*)((LAS unsigned char*)F.lds + L_IMP) + F.wave * 2048 + A.lane;
#pragma unroll
    for (int r = 0; r < 16; ++r) { ow[r * 64] = out0[r]; ow[(16 + r) * 64] = out1[r]; }
    const float qn2 = q_norm2(A, qf);
    const float kmx_s = kmax_load(F, layer, b, 1, A.lane), kmx_w = kmax_load(F, layer, b, 2, A.lane);
    {
        f32x16 o0 = (f32x16){0.f}, o1 = (f32x16){0.f}; float ol = 0.f;
        const float negref = -sqrtf(qn2 * kmx_s);
        attn_stream<1>(A, F.Z_() + (size_t)b * SEQ * NZ + ZKS, F.Z_() + (size_t)b * SEQ * NZ + ZVS, 0, qb, qf, negref, o0, o1, ol, nullptr, bm);
        const float l = sum32x_f(ol);
        const float sc = (l > 0.f ? 1.0f / l : 0.f) * g_s;
#pragma unroll
        for (int r = 0; r < 16; ++r) { ow[r * 64] += o0[r] * sc; ow[(16 + r) * 64] += o1[r] * sc; }
    }
    {
        f32x16 o0 = (f32x16){0.f}, o1 = (f32x16){0.f}; float ol = 0.f;
        const float negref = -sqrtf(qn2 * kmx_w);
        const int k0 = qb - 8 < 0 ? 0 : qb - 8;
        attn_stream<2>(A, F.Z_() + (size_t)b * SEQ * NZ + ZKW, F.Z_() + (size_t)b * SEQ * NZ + ZVW, k0, qb, qf, negref, o0, o1, ol, nullptr, 0ull);
        const float l = sum32x_f(ol);
        const float sc = (l > 0.f ? 1.0f / l : 0.f) * g_w;
#pragma unroll
        for (int r = 0; r < 16; ++r) { o0[r] = ow[r * 64] + o0[r] * sc; o1[r] = ow[(16 + r) * 64] + o1[r] * sc; }
        store_out(A, F, o0, o1, ZGB, 256);
    }
}

__device__ __forceinline__ void zero_item(Frame& F, int b, int qb, int colbase) {
    const int tid = F.tid_();
    for (int i = tid; i < 64 * 32; i += 512) { const int r = i >> 5, c = i & 31;
        *(u32x4*)(F.MIXED_() + ((size_t)b * SEQ + qb * 64 + r) * DM + colbase + 8 * c) = (u32x4){0u, 0u, 0u, 0u}; }
}

__device__ __forceinline__ void phase_final(Frame& F, const Params& P) {
    const int gw = blockIdx.x * 8 + F.wave, NGW = F.G * 8;
#ifdef ABL_DUMP
    for (int row = gw; row < MROWS; row += NGW) {
        for (int c = F.lane_(); c < DM; c += 64) P.out[(size_t)row * DM + c] = bf2f(F.Z_()[(size_t)row * NZ + ABL_DUMP + (c & 255)]);
    }
    return;
#endif
    for (int row = gw; row < MROWS; row += NGW) {
        const f32x4 a = *(const f32x4*)(F.RS_() + (size_t)row * 4);
        const float ss = (a[0] + a[1]) + (a[2] + a[3]);
        const float rr = 1.0f / sqrtf(ss * (1.0f / 1024.0f) + 1e-6f);
        const u32x2* xb = (const u32x2*)(F.XB_() + (size_t)row * DM) + F.lane_();
        f32x4* xo = (f32x4*)(P.out + (size_t)row * DM) + F.lane_();
        const f32x4* gw4 = (const f32x4*)P.final_norm_w + F.lane_();
#pragma unroll
        for (int j = 0; j < 4; ++j) { const u32x2 w = xb[64 * j]; const f32x4 g = gw4[64 * j];
            xo[64 * j] = (f32x4){__uint_as_float(w[0] << 16) * rr * g[0], __uint_as_float(w[0] & 0xffff0000u) * rr * g[1], __uint_as_float(w[1] << 16) * rr * g[2], __uint_as_float(w[1] & 0xffff0000u) * rr * g[3]}; }
    }
}

#define XB_TMO      128
#define XB_XCNT(j)  (256  + 64 * (j))
#define XB_XSUB(j)  (1280 + 64 * (j))
#define XB_XGEN(j)  (2304 + 64 * (j))
#define XB_TOP      3328
#define XB_TOPGEN   3392
#define XCD_BAR_WORDS 3456
#define XB_SPIN_CAP (1u << 18)

__device__ __forceinline__ unsigned xb_ld(unsigned* p)              { return __hip_atomic_load(p, __ATOMIC_RELAXED, __HIP_MEMORY_SCOPE_AGENT); }
__device__ __forceinline__ unsigned xb_add(unsigned* p, unsigned v) { return __hip_atomic_fetch_add(p, v, __ATOMIC_RELAXED, __HIP_MEMORY_SCOPE_AGENT); }
__device__ __forceinline__ unsigned xb_xcc_id() { return (unsigned)__builtin_amdgcn_s_getreg((3 << 11) | 20) & 0xFu; }
#define XB_SPIN(cond, bar) do { unsigned _sp = 0; while (cond) { __builtin_amdgcn_s_sleep(1); \
    if ((++_sp & 255u) == 0u) { if (xb_ld(&(bar)[XB_TMO])) break; if (_sp > XB_SPIN_CAP) { atomicAdd(&(bar)[XB_TMO], 1u); break; } } } } while (0)

struct XcdBarrier {
    unsigned* bar; unsigned x;
    volatile LAS unsigned* st;
};

__device__ __forceinline__ XcdBarrier xcd_barrier_post(unsigned* bar, volatile LAS unsigned* st) {
    XcdBarrier b; b.bar = bar; b.x = xb_xcc_id(); b.st = st;
    if (threadIdx.x == 0) (void)xb_add(&bar[XB_XCNT(b.x)], 1u);
    return b;
}
__device__ __forceinline__ void xcd_barrier_complete(unsigned* bar, unsigned x, unsigned& nloc, unsigned& nx) {
    const unsigned G = gridDim.x * gridDim.y * gridDim.z;
    unsigned sum, cnt, mine, sp = 0u;
    for (;;) {
        sum = 0u; cnt = 0u; mine = 0u;
#pragma unroll
        for (unsigned j = 0; j < 16; ++j) { const unsigned c = xb_ld(&bar[XB_XCNT(j)]); sum += c; cnt += (c > 0u) ? 1u : 0u; mine = (j == x) ? c : mine; }
        if (sum == G) break;
        __builtin_amdgcn_s_sleep(1);
        if ((++sp & 255u) == 0u) { if (xb_ld(&bar[XB_TMO])) break; if (sp > XB_SPIN_CAP) { atomicAdd(&bar[XB_TMO], 1u); break; } }
    }
    nloc = mine > 0u ? mine : 1u; nx = cnt > 0u ? cnt : 1u;
}

__device__ __forceinline__ void xcd_barrier(const XcdBarrier& b) {
    asm volatile("s_waitcnt vmcnt(0)" ::: "memory");
    __syncthreads();
    if (threadIdx.x == 0) {
        unsigned* bar = b.bar;
        __builtin_amdgcn_s_waitcnt(0);
        unsigned nloc = b.st[0], nx = b.st[1];
        if (nloc == 0u) { xcd_barrier_complete(bar, b.x, nloc, nx); b.st[0] = nloc; b.st[1] = nx; }
        const unsigned old = xb_add(&bar[XB_XSUB(b.x)], 1u);
        const unsigned gen = old / nloc;
        if (old + 1u == (gen + 1u) * nloc) {
            __builtin_amdgcn_fence(__ATOMIC_RELEASE, "agent");
            asm volatile("s_waitcnt vmcnt(0)" ::: "memory");
            const unsigned og = xb_add(&bar[XB_TOP], 1u);
            const unsigned tg = og / nx;
            if (og + 1u == (tg + 1u) * nx) xb_add(&bar[XB_TOPGEN], 1u);
            else XB_SPIN(xb_ld(&bar[XB_TOPGEN]) == tg, bar);
            __builtin_amdgcn_fence(__ATOMIC_ACQUIRE, "agent");
            xb_add(&bar[XB_XGEN(b.x)], 1u);
            asm volatile("s_waitcnt vmcnt(0)" ::: "memory");
        } else {
            XB_SPIN(xb_ld(&bar[XB_XGEN(b.x)]) == gen, bar);
            __builtin_amdgcn_fence(__ATOMIC_ACQUIRE, "agent");
            asm volatile("s_waitcnt vmcnt(0)" ::: "memory");
        }
    }
    __syncthreads();
}

template <int SUB>
__device__ __forceinline__ void run_phase(Frame& F, const Params& Q, int layer, unsigned char* lds) {
        constexpr int sub = SUB;
        if (sub == 0) {
            pg8::Gemm g{F.XB_(), F.WIT_() + (size_t)layer * NZ * DM, MROWS, NZ, DM};
            pg8::StaticOrder S; S.init(MROWS, NZ, F.G, (int)blockIdx.x);
            EpiIn E{F.Z_(), F.RS_(), F.CS_(), F.WIF_(), F.BGF_(), lds};
            pg8::gemm_phase<EpiIn, pg8::StaticOrder, true, true>((PG8_LAS unsigned char*)lds, g, S, E, F.wave);
#if defined(PROBE_DUP) && PROBE_DUP == 1
            __syncthreads();
            pg8::gemm_phase<EpiIn, pg8::StaticOrder, true, true>((PG8_LAS unsigned char*)lds, g, S, E, F.wave);
#endif
        } else if (sub == 1) {
            const int qbase = 32 * layer;
            for (int it = (int)blockIdx.x; it < 256; it += F.G) { compress_item(F, Q, layer, it); __syncthreads(); }
            for (int it = (int)blockIdx.x; it < 256; it += F.G) convpool_item<0>(F, Q, layer, it);
#ifndef ABL_NO_A
            { int b, it; while (next_item_batch(F, qbase + 8, 128, b, it)) {
_Pragma("nounroll")
                for (int k = 0; k < 2; ++k) { select_item(F, b, 255 - 2 * it - k); __syncthreads(); } } }
#endif
#if defined(PROBE_DUP) && PROBE_DUP == 7
            __syncthreads();
            for (;;) { const int it = next_item(F, qbase + 2); if (it >= 256) break; compress_item(F, Q, layer, it); }
            { int b, it; while (next_item_batch(F, qbase + 24, 256, b, it)) select_item(F, b, 255 - it); }
            for (;;) { const int it = next_item(F, qbase + 3); if (it >= 256) break; convpool_item<0>(F, Q, layer, it); }
#endif
#if defined(PROBE_DUP) && PROBE_DUP == 12
            { int b, it; while (next_item_batch(F, qbase + 24, 256, b, it)) select_item(F, b, 255 - it); }
#endif
#if defined(PROBE_DUP) && PROBE_DUP == 2
            { int b, it; while (next_item_batch(F, qbase + 24, 256, b, it)) select_item(F, b, 255 - it); }
#endif
#if defined(PROBE_DUP) && PROBE_DUP == 3
            for (;;) { const int it = next_item(F, qbase + 2); if (it >= 256) break; compress_item(F, Q, layer, it); }
#endif
#if defined(PROBE_DUP) && PROBE_DUP == 13
            { int acc_ = 0; for (int k = 0; k < 16; ++k) acc_ += next_item(F, qbase + 24 + (k & 7)); if (acc_ == 0x7fffffff) F.KMAX_()[127] = 1u; }
#endif
#if defined(PROBE_DUP) && PROBE_DUP == 11
            for (;;) { const int it = next_item(F, qbase + 3); if (it >= 256) break; convpool_item<PROBE_VAR>(F, Q, layer, it); }
#endif
        } else if (sub == 2) {
            const int qbase = 32 * layer;
            { int b, it;
              while (next_item_batch(F, qbase + 16, 128, b, it)) {
                const int qb = 63 - (it >> 1);
                if ((it & 1) == 0) nsa_item(F, layer, b, qb); else dsa_attn_item(F, layer, b, qb);
              } }
#if defined(PROBE_DUP) && (PROBE_DUP == 4 || PROBE_DUP == 5)
            __syncthreads();
            { int b, it;
              while (next_item_batch(F, qbase + 24, 64, b, it)) {
                const int qb = 63 - it;
                if (PROBE_DUP == 5) nsa_item(F, layer, b, qb); else dsa_attn_item(F, layer, b, qb);
              } }
#endif
#if defined(PROBE_DUP) && PROBE_DUP == 6
            __syncthreads();
            { int b, it;
              while (next_item_batch(F, qbase + 24, 128, b, it)) {
                const int qb = 63 - (it >> 1);
                if ((it & 1) == 0) nsa_item(F, layer, b, qb); else dsa_attn_item(F, layer, b, qb);
              } }
#endif
        } else {
            pg8::Gemm g{F.MIXED_(), F.WOT_() + (size_t)layer * DM * DM, MROWS, DM, DM};
            pg8::StaticOrder S; S.init(MROWS, DM, F.G, (int)blockIdx.x);
            EpiOut E{F.XB_(), F.RS_(), lds};
            pg8::gemm_phase<EpiOut, pg8::StaticOrder, true, true>((PG8_LAS unsigned char*)lds, g, S, E, F.wave);
#if defined(PROBE_DUP) && PROBE_DUP == 8
            __syncthreads();
            EpiOut E2{F.Z_() + (size_t)64 * 1024 * 1024, F.BGF_(), lds};
            pg8::gemm_phase<EpiOut, pg8::StaticOrder, true, true>((PG8_LAS unsigned char*)lds, g, S, E2, F.wave);
#endif
        }
}

template <bool COOP>
__global__ void __launch_bounds__(512, 2) fwd_kernel(Params P) {
    extern __shared__ __attribute__((aligned(16))) unsigned char lds[];
    Frame F;
    F.lds = lds; F.wave = __builtin_amdgcn_readfirstlane((int)(threadIdx.x >> 6)); F.G = gridDim.x;
    F.ws = P.ws;
    XcdBarrier bar; bar.bar = nullptr; bar.x = 0; bar.st = nullptr;
    if (COOP) {
        volatile LAS unsigned* misc = (volatile LAS unsigned*)((LAS unsigned char*)lds + MISC_OFF);
        if (threadIdx.x < 64) misc[threadIdx.x] = 0u;
        { unsigned* c = F.ctl_(); for (int i = (int)blockIdx.x * 512 + (int)threadIdx.x; i < (int)(CTL_BYTES / 4); i += (int)gridDim.x * 512) c[i] = 0u; }
        __syncthreads();
    }
#define GRID_SYNC() do { if (COOP) { xcd_barrier(bar); } } while (0)
#if defined(PROBE_DUP) && PROBE_DUP == 14
#define PROBE_XSYNC GRID_SYNC()
#else
#define PROBE_XSYNC (void)0
#endif

    if (COOP) {
        phase_prologue(F, P);
#if defined(PROBE_DUP) && PROBE_DUP == 9
        __syncthreads(); phase_prologue(F, P);
#endif
        cg::this_grid().sync();
        bar = xcd_barrier_post(F.ctl_() + 12288, (volatile LAS unsigned*)((LAS unsigned char*)lds + MISC_OFF) + 8);
#define RUN_PHASE(LAYER, SUB) do { Params Q = P; \
            asm volatile("" : "+s"(Q.x), "+s"(Q.norm_w), "+s"(Q.conv_w), "+s"(Q.pe_cmp), "+s"(Q.pool_scale), "+s"(Q.out), "+s"(Q.ws)); F.ws = Q.ws; \
            run_phase<SUB>(F, Q, LAYER, lds); GRID_SYNC(); PROBE_XSYNC; } while (0)
#define RUN_LAYER(LAYER) do { RUN_PHASE(LAYER, 0); RUN_PHASE(LAYER, 1); RUN_PHASE(LAYER, 2); RUN_PHASE(LAYER, 3); } while (0)
        RUN_LAYER(0); RUN_LAYER(1); RUN_LAYER(2); RUN_LAYER(3);
#undef RUN_LAYER
#undef RUN_PHASE
        phase_final(F, P);
    } else {
        int ph = P.ph_lo;
        if (ph == 0) { phase_prologue(F, P); ++ph; }
        for (; ph < P.ph_hi && ph < NPHASE - 1; ++ph) {
            int ph_ = ph; asm volatile("" : "+s"(ph_));
            Params Q = P;
            asm volatile("" : "+s"(Q.x), "+s"(Q.norm_w), "+s"(Q.conv_w), "+s"(Q.pe_cmp), "+s"(Q.pool_scale), "+s"(Q.out), "+s"(Q.ws));
            F.ws = Q.ws;
            const int layer = (ph_ - 1) >> 2, sub = (ph_ - 1) & 3;
            if (sub == 0) run_phase<0>(F, Q, layer, lds); else if (sub == 1) run_phase<1>(F, Q, layer, lds); else if (sub == 2) run_phase<2>(F, Q, layer, lds); else run_phase<3>(F, Q, layer, lds);
        }
        if (ph == NPHASE - 1 && ph < P.ph_hi) phase_final(F, P);
    }
}

#ifndef N_LAUNCH_MODE
#define N_LAUNCH_MODE 0
#endif
#if N_LAUNCH_MODE == 0
template __global__ void fwd_kernel<true>(Params);
#else
template __global__ void fwd_kernel<false>(Params);
#endif
extern "C" void kernel_launch(void* const* d_in, const int* in_sizes, int n_in, void* d_out, int out_size, void* d_ws, size_t ws_size, hipStream_t stream) {
    static int grid = 0;
    if (grid == 0) {
        if (n_in != 11 || out_size != MROWS * DM || ws_size < WS_END) { fprintf(stderr, "kernel_launch: unexpected shapes (n_in %d out %d ws %zu)\n", n_in, out_size, ws_size); grid = -1; return; }
        int dev = 0, cus = 0, per_cu = 0;
        hipGetDevice(&dev); hipDeviceGetAttribute(&cus, hipDeviceAttributeMultiprocessorCount, dev);
#if N_LAUNCH_MODE == 0
#define FWD_K fwd_kernel<true>
#else
#define FWD_K fwd_kernel<false>
#endif
        hipFuncSetAttribute((const void*)FWD_K, hipFuncAttributeMaxDynamicSharedMemorySize, LDS_BYTES);
        hipOccupancyMaxActiveBlocksPerMultiprocessor(&per_cu, (const void*)FWD_K, 512, LDS_BYTES);
        (void)hipGetLastError();
        if (per_cu < 1) { fprintf(stderr, "kernel_launch: occupancy query says %d blocks/CU\n", per_cu); per_cu = 1; }
        grid = cus;
    }
    if (grid < 0) return;
#if N_LAUNCH_MODE != 0
    hipMemsetAsync((char*)d_ws + WS_CTL, 0, CTL_BYTES, stream);
#endif
    Params p{};
    p.x = (const float*)d_in[0]; p.norm_w = (const float*)d_in[1]; p.w_in = (const float*)d_in[2]; p.w_out = (const float*)d_in[3]; p.conv_w = (const float*)d_in[4];
    p.pe_cmp = (const float*)d_in[5]; p.w_cmp_k = (const float*)d_in[6]; p.w_cmp_v = (const float*)d_in[7]; p.pool_w = (const float*)d_in[8]; p.pool_scale = (const float*)d_in[9];
    p.final_norm_w = (const float*)d_in[10]; p.out = (float*)d_out; p.ws = (unsigned char*)d_ws;
#if N_LAUNCH_MODE == 0
    p.ph_lo = 0; p.ph_hi = NPHASE;
    void* args[] = {&p};
    hipError_t e = hipLaunchCooperativeKernel((const void*)fwd_kernel<true>, dim3(grid), dim3(512), args, LDS_BYTES, stream);
    if (e != hipSuccess) fprintf(stderr, "cooperative launch failed: %s (grid %d)\n", hipGetErrorString(e), grid);
#else
    for (int ph = 0; ph < NPHASE; ++ph) {
#ifdef ABL_DUMP
        if (ph >= 2 && ph < NPHASE - 1) continue;
#endif
        p.ph_lo = ph; p.ph_hi = ph + 1;
        hipLaunchKernelGGL(fwd_kernel<false>, dim3(grid), dim3(512), LDS_BYTES, stream, p);
    }
#endif
}
```

```cpp
#include <hip/hip_runtime.h>
#include <hip/hip_cooperative_groups.h>
#include <cstdio>
#include <cstdint>
namespace cg = cooperative_groups;

constexpr int BATCH = 8, SEQ = 4096, DM = 1024, DEPTH = 4, MROWS = BATCH * SEQ;
constexpr int D_IN = 3380, NZ = 3584;
constexpr int ZQA = 0, ZQI = 256, ZQB = 512, ZKA = 768, ZVA = 832, ZKS = 896, ZVS = 960, ZKW = 1024, ZVW = 1088, ZKC = 1152, ZVC = 1216,
              ZKI = 1280, ZWI = 1312, ZBG = 1320, ZGA = 1536, ZGB = 1792, ZCB = 2048, ZCC = 2304, ZCX = 2560, ZGC = 2816, ZDU = 3072, ZGD = 3328;
constexpr float C2 = 0.18033688011112042f;
constexpr int NPHASE = 2 + 4 * DEPTH;

constexpr size_t MiB = 1u << 20;
constexpr size_t WS_CTL = 0, CTL_BYTES = 64 * 1024;
constexpr size_t WS_WIT = 2 * MiB;
constexpr size_t WS_WOT = 30 * MiB;
constexpr size_t WS_WCT = 38 * MiB;
constexpr size_t WS_PWT = 40 * MiB;
constexpr size_t WS_CS = 40 * MiB + 256 * 1024;
constexpr size_t WS_KP = 41 * MiB;
constexpr size_t WS_RS = 42 * MiB;
constexpr size_t WS_WIF = 44 * MiB;
constexpr size_t WS_BGF = 45 * MiB;
constexpr size_t WS_KCMP = 47 * MiB;
constexpr size_t WS_VCMP = 47 * MiB + 512 * 1024;
constexpr size_t WS_XB = 48 * MiB;
constexpr size_t WS_Z = 112 * MiB;
constexpr size_t WS_MIXED = 336 * MiB;
constexpr size_t WS_MASK = 400 * MiB;
constexpr size_t WS_END = 416 * MiB;

constexpr int RING_BYTES = 131072;
constexpr int MISC_OFF = RING_BYTES;
constexpr int LDS_BYTES = 147456;
constexpr int L_K = 0, L_V = 32768, L_IMP = 65536, L_BM = MISC_OFF + 256;

typedef unsigned short bf16_t;
typedef short bf16x8 __attribute__((ext_vector_type(8)));
typedef short s16x4 __attribute__((ext_vector_type(4)));
typedef float f32x4 __attribute__((ext_vector_type(4)));
typedef float f32x2 __attribute__((ext_vector_type(2)));
typedef float f32x16 __attribute__((ext_vector_type(16)));
typedef unsigned u32x4 __attribute__((ext_vector_type(4)));
typedef unsigned u32x2 __attribute__((ext_vector_type(2)));
#define LAS __attribute__((address_space(3)))
#define GAS __attribute__((address_space(1)))

__host__ __device__ __forceinline__ int perm64(int j) { return j < 16 ? ((j & ~12) | ((j & 4) << 1) | ((j & 8) >> 1)) : j; }
__host__ __device__ __forceinline__ int src_col(int p) {
    if (p < 256) return 0 + (p >> 6) * 64 + perm64(p & 63);
    if (p < 512) return 384 + (p - 256);
    if (p < 768) { const int q = p - 512; return 936 + (q >> 6) * 64 + perm64(q & 63); }
    if (p < 832) return 256 + perm64(p - 768);
    if (p < 896) return 320 + (p - 832);
    if (p < 960) return 1320 + perm64(p - 896);
    if (p < 1024) return 1384 + (p - 960);
    if (p < 1088) return 1448 + perm64(p - 1024);
    if (p < 1152) return 1512 + (p - 1088);
    if (p < 1216) return 1192 + (p - 1152);
    if (p < 1280) return 1256 + (p - 1216);
    if (p < 1312) return 640 + (p - 1280);
    if (p < 1320) return 672 + (p - 1312);
    if (p < 1332) return 1576 + (p - 1320);
    if (p < 1536) return -1;
    if (p < 1792) return 680 + (p - 1536);
    if (p < 2048) return 1588 + (p - 1792);
    if (p < 2304) return 1844 + (p - 2048);
    if (p < 2560) return 2100 + (p - 2304);
    if (p < 2816) return 2356 + (p - 2560);
    if (p < 3072) return 2612 + (p - 2816);
    if (p < 3328) return 2868 + (p - 3072);
    return 3124 + (p - 3328);
}
#define N_LAUNCH_MODE 0
namespace pg8 {
#define PG8_LAS __attribute__((address_space(3)))
typedef unsigned short bf16_t;
typedef short bf16x8 __attribute__((ext_vector_type(8)));
typedef float f32x4 __attribute__((ext_vector_type(4)));
typedef unsigned u32x4 __attribute__((ext_vector_type(4)));
constexpr int BM = 256, BK = 64, HALF = 128, HTB = HALF * BK * 2  , STAGE_BYTES = 8 * HTB, NXCD = 8, WGM = 8;

__host__ __device__ __forceinline__ int lds_byte(int r, int c) { const int st = (r >> 4) * 2 + (c >> 5), rr = r & 15, cc = c & 31, ob = rr * 64 + cc * 2; return st * 1024 + (ob ^ (((ob >> 9) & 1) << 5)); }
__host__ __device__ __forceinline__ void stage_rc(int b, int& R, int& C) { const int st = b / 1024, sb = b % 1024, swz = sb ^ (((sb >> 9) & 1) << 5); R = (st >> 1) * 16 + swz / 64; C = (st & 1) * 32 + (swz % 64) / 2; }
__host__ __device__ __forceinline__ int perm32(int rho) { const int n = rho >> 4, i = rho & 15; return 8 * (i >> 2) + 4 * n + (i & 3); }

struct Unit { int pm, pn; };
struct Gemm { const bf16_t* A; const bf16_t* Bt; int M, N, K; };

struct StaticOrder {
    int nM, nN, nwg, G, c;
    __host__ __device__ void init(int M, int N, int G_, int c_) { nM = M / BM; nN = N / BM; nwg = nM * nN; G = G_; c = c_; }
    __host__ __device__ bool next(int i, Unit& u) const {
        const long L = (long)i * G + c; if (L >= nwg) return false;
        int wgid = (int)L; { const int q = nwg / NXCD, r = nwg % NXCD, xcd = wgid % NXCD, off = wgid / NXCD; wgid = (xcd < r ? xcd * (q + 1) : r * (q + 1) + (xcd - r) * q) + off; }
        const int nig = WGM * nN, gid = wgid / nig, fm = gid * WGM, gsz = (nM - fm) < WGM ? (nM - fm) : WGM;
        u.pm = fm + ((wgid % nig) % gsz); u.pn = (wgid % nig) / gsz; return true;
    }
    __device__ __forceinline__ void a_ready(const Unit&) const {}
    __device__ __forceinline__ void done(const Unit&) const {}
};
}
namespace pg8 {
template <class Epi, class Sched, bool ALIGN_EPI = false, bool SP2 = false>
__device__ __forceinline__ void gemm_phase(PG8_LAS unsigned char* lds, const Gemm g, const Sched& S, const Epi& E, const int wave_s) {
    int lane_; asm volatile("v_mbcnt_lo_u32_b32 %0, -1, 0\n\tv_mbcnt_hi_u32_b32 %0, -1, %0" : "=v"(lane_));
    const int tid = wave_s * 64 + lane_, wid = wave_s, lane = lane_, wr = wid >> 2, wc = wid & 3, fr = lane & 15, fq = lane >> 4;
    const int K = g.K, nt = K / BK;
    unsigned voffA[2], voffB[2];
#pragma unroll
    for (int i = 0; i < 2; ++i) { int R, C; stage_rc(tid * 16 + i * 8192, R, C); const int Rb = Epi::PERM ? ((R & ~31) + perm32(R & 31)) : R;
        voffA[i] = (unsigned)(R * K + C) * 2u; voffB[i] = (unsigned)(Rb * K + C) * 2u; }
    const size_t kstep = (size_t)(BK * 2);
    const size_t hstep = (size_t)HALF * K * 2;
    const size_t tstep = 2 * hstep;
    const unsigned ldsw = (unsigned)wid * 1024u;
    const int aoff = lds_byte(wr * 64 + fr, fq * 8), boff = lds_byte(wc * 32 + fr, fq * 8);
#define PG8_SA(b, h) (((b) * 2 + (h)) * HTB)
#define PG8_SB(b, h) ((4 + (b) * 2 + (h)) * HTB)
#define PG8_STAGE(bufoff, gbase, voff) do { _Pragma("unroll") for (int _i = 0; _i < 2; ++_i) \
        __builtin_amdgcn_global_load_lds((const unsigned*)((const char*)(gbase) + (voff)[_i]), (PG8_LAS unsigned*)(lds + (bufoff) + ldsw + _i * 8192), 16, 0, 0); } while (0)
#define PG8_LDA(dst, b, h) do { _Pragma("unroll") for (int m = 0; m < 4; ++m) _Pragma("unroll") for (int k = 0; k < 2; ++k) dst[m][k] = *(const PG8_LAS bf16x8*)(lds + PG8_SA(b, h) + aoff + m * 2048 + k * 1024); } while (0)
#define PG8_LDB(dst, b, h) do { _Pragma("unroll") for (int n = 0; n < 2; ++n) _Pragma("unroll") for (int k = 0; k < 2; ++k) dst[n][k] = *(const PG8_LAS bf16x8*)(lds + PG8_SB(b, h) + boff + n * 2048 + k * 1024); } while (0)
#define PG8_MMA(ai, bj, At, Bt) do { __builtin_amdgcn_s_setprio(1); _Pragma("unroll") for (int m = 0; m < 4; ++m) _Pragma("unroll") for (int n = 0; n < 2; ++n) _Pragma("unroll") for (int k = 0; k < 2; ++k) \
        acc[ai][bj][m][n] = __builtin_amdgcn_mfma_f32_16x16x32_bf16(Bt[n][k], At[m][k], acc[ai][bj][m][n], 0, 0, 0); __builtin_amdgcn_s_setprio(0); } while (0)
#define PG8_WAIT_V(n) asm volatile("s_waitcnt vmcnt(" #n ")" ::: "memory")
#define PG8_WAIT_L(n) asm volatile("s_waitcnt lgkmcnt(" #n ")" ::: "memory")
#define PG8_BAR __builtin_amdgcn_s_barrier()
#define PG8_SCHED __builtin_amdgcn_sched_barrier(0)
    Unit cur, nxt; int ui = 0; int par_ = 0;
    if (!S.next(0, cur)) return;
    f32x4 acc[2][2][4][2];
    if constexpr (Epi::HAS_INIT) E.init(acc, cur, wr, wc, fr, fq);
    else {
#pragma unroll
    for (int a = 0; a < 2; ++a)
#pragma unroll
        for (int b = 0; b < 2; ++b)
#pragma unroll
            for (int m = 0; m < 4; ++m)
#pragma unroll
                for (int n = 0; n < 2; ++n) acc[a][b][m][n] = (f32x4){0.f, 0.f, 0.f, 0.f};
    }
    bf16x8 At[4][2], B0[2][2], B1[2][2];
    const char* cA = (const char*)g.A + (size_t)cur.pm * tstep; const char* cB = (const char*)g.Bt + (size_t)cur.pn * tstep;
    S.a_ready(cur);
    if constexpr (SP2) {
        PG8_STAGE(PG8_SB(0, 0), cB, voffB); PG8_STAGE(PG8_SB(0, 1), cB + hstep, voffB); PG8_STAGE(PG8_SA(0, 0), cA, voffA); PG8_STAGE(PG8_SA(0, 1), cA + hstep, voffA);
        if constexpr (Epi::HAS_ROWS) { typename Epi::Rows r0_ = E.rows_issue(cur, tid); E.rows_commit(r0_, tid, 0, true); }
        if (wr == 1) PG8_BAR;
        PG8_WAIT_V(2); PG8_BAR;
        PG8_STAGE(PG8_SB(1, 0), cB + kstep, voffB); PG8_STAGE(PG8_SA(1, 0), cA + kstep, voffA); PG8_STAGE(PG8_SB(1, 1), cB + hstep + kstep, voffB);
        PG8_WAIT_V(6); PG8_BAR;
    } else {
        PG8_STAGE(PG8_SB(0, 0), cB, voffB); PG8_STAGE(PG8_SA(0, 0), cA, voffA); PG8_STAGE(PG8_SB(0, 1), cB + hstep, voffB); PG8_STAGE(PG8_SA(0, 1), cA + hstep, voffA);
        if (wr == 1) PG8_BAR;
        PG8_WAIT_V(4); PG8_BAR;
        PG8_STAGE(PG8_SB(1, 0), cB + kstep, voffB); PG8_STAGE(PG8_SA(1, 0), cA + kstep, voffA); PG8_STAGE(PG8_SB(1, 1), cB + hstep + kstep, voffB);
        PG8_WAIT_V(6); PG8_BAR;
    }
    for (;;) {
        const bool has_next = S.next(ui + 1, nxt);
        const char* nA = has_next ? (const char*)g.A + (size_t)nxt.pm * tstep : cA; const char* nB = has_next ? (const char*)g.Bt + (size_t)nxt.pn * tstep : cB;
        for (int t = 0; t < nt; t += 2) {
            const bool last = (t == nt - 2);
            const char* a1 = cA + (size_t)(t + 1) * kstep;
            const char* a2 = last ? nA : cA + (size_t)(t + 2) * kstep; const char* b2 = last ? nB : cB + (size_t)(t + 2) * kstep;
            const char* a3 = a2 + kstep; const char* b3 = b2 + kstep;
            if (last && has_next) S.a_ready(nxt);
            if constexpr (SP2) {
            PG8_LDB(B0, 0, 0); PG8_LDB(B1, 0, 1); PG8_SCHED; PG8_LDA(At, 0, 0); PG8_STAGE(PG8_SA(1, 1), a1 + hstep, voffA);
            PG8_WAIT_V(8); PG8_WAIT_L(0); PG8_BAR; PG8_MMA(0, 0, At, B0); PG8_MMA(0, 1, At, B1); PG8_BAR; PG8_SCHED;
            PG8_LDA(At, 0, 1); PG8_STAGE(PG8_SB(0, 0), b2, voffB); PG8_STAGE(PG8_SB(0, 1), b2 + hstep, voffB); PG8_STAGE(PG8_SA(0, 0), a2, voffA);
            PG8_WAIT_V(8); PG8_WAIT_L(0); PG8_BAR; PG8_MMA(1, 0, At, B0); PG8_MMA(1, 1, At, B1); PG8_BAR; PG8_SCHED;
            PG8_LDB(B0, 1, 0); PG8_LDB(B1, 1, 1); PG8_SCHED; PG8_LDA(At, 1, 0); PG8_STAGE(PG8_SA(0, 1), a2 + hstep, voffA);
            PG8_WAIT_V(8); PG8_WAIT_L(0); PG8_BAR; PG8_MMA(0, 0, At, B0); PG8_MMA(0, 1, At, B1); PG8_BAR; PG8_SCHED;
            PG8_LDA(At, 1, 1); PG8_STAGE(PG8_SB(1, 0), b3, voffB); PG8_STAGE(PG8_SB(1, 1), b3 + hstep, voffB); PG8_STAGE(PG8_SA(1, 0), a3, voffA);
            PG8_WAIT_V(8); PG8_WAIT_L(0); PG8_BAR; PG8_MMA(1, 0, At, B0); PG8_MMA(1, 1, At, B1); PG8_BAR; PG8_SCHED;
            } else {
            PG8_LDB(B0, 0, 0); PG8_SCHED; PG8_LDA(At, 0, 0); PG8_STAGE(PG8_SA(1, 1), a1 + hstep, voffA);
            PG8_WAIT_L(8); PG8_BAR; PG8_WAIT_L(0); PG8_MMA(0, 0, At, B0); PG8_BAR; PG8_SCHED;
            PG8_LDB(B1, 0, 1); PG8_STAGE(PG8_SB(0, 0), b2, voffB);
            PG8_BAR; PG8_WAIT_L(0); PG8_MMA(0, 1, At, B1); PG8_BAR;
            PG8_LDA(At, 0, 1); PG8_STAGE(PG8_SA(0, 0), a2, voffA);
            PG8_BAR; PG8_WAIT_L(0); PG8_MMA(1, 0, At, B0); PG8_BAR; PG8_SCHED;
            PG8_STAGE(PG8_SB(0, 1), b2 + hstep, voffB);
            PG8_WAIT_V(6); PG8_BAR; PG8_MMA(1, 1, At, B1); PG8_BAR;
            PG8_LDB(B0, 1, 0); PG8_SCHED; PG8_LDA(At, 1, 0); PG8_STAGE(PG8_SA(0, 1), a2 + hstep, voffA);
            PG8_WAIT_L(8); PG8_BAR; PG8_WAIT_L(0); PG8_MMA(0, 0, At, B0); PG8_BAR; PG8_SCHED;
            PG8_LDB(B1, 1, 1); PG8_STAGE(PG8_SB(1, 0), b3, voffB);
            PG8_BAR; PG8_WAIT_L(0); PG8_MMA(0, 1, At, B1); PG8_BAR;
            PG8_LDA(At, 1, 1); PG8_STAGE(PG8_SA(1, 0), a3, voffA);
            PG8_BAR; PG8_WAIT_L(0); PG8_MMA(1, 0, At, B0); PG8_BAR; PG8_SCHED;
            PG8_STAGE(PG8_SB(1, 1), b3 + hstep, voffB);
            PG8_WAIT_V(6); PG8_BAR; PG8_MMA(1, 1, At, B1); PG8_BAR;
            }
        }
        if constexpr (ALIGN_EPI) { if (wr == 0) PG8_BAR; }
        if constexpr (Epi::HAS_ROWS) {
            typename Epi::Rows rn_ = E.rows_issue(has_next ? nxt : cur, tid);
            E.run(acc, cur, wr, wc, fr, fq, par_); S.done(cur);
            E.rows_commit(rn_, tid, par_ ^ 1, false); par_ ^= 1;
        } else
        if constexpr (!Epi::AFTER_DRAIN) { E(acc, cur, wr, wc, fr, fq); S.done(cur); }
        if (!has_next) break;
        if constexpr (Epi::HAS_INIT) E.init(acc, nxt, wr, wc, fr, fq);
        else {
#pragma unroll
        for (int a = 0; a < 2; ++a)
#pragma unroll
            for (int b = 0; b < 2; ++b)
#pragma unroll
                for (int m = 0; m < 4; ++m)
#pragma unroll
                    for (int n = 0; n < 2; ++n) acc[a][b][m][n] = (f32x4){0.f, 0.f, 0.f, 0.f};
        }
        cur = nxt; cA = nA; cB = nB; ++ui;
        if constexpr (ALIGN_EPI) { if (wr == 1) PG8_BAR; }
    }
    PG8_WAIT_V(0);
    if constexpr (!ALIGN_EPI) { if (wr == 0) PG8_BAR; }
    PG8_BAR;
    if constexpr (Epi::AFTER_DRAIN) { E.fused(acc, cur, wr, wc, fr, fq, lds, wid, lane); S.done(cur); }
#undef PG8_SA
#undef PG8_SB
#undef PG8_STAGE
#undef PG8_LDA
#undef PG8_LDB
#undef PG8_MMA
#undef PG8_WAIT_V
#undef PG8_WAIT_L
#undef PG8_BAR
#undef PG8_SCHED
}
}

__device__ __forceinline__ float bf2f(unsigned short h) { return __uint_as_float((unsigned)h << 16); }
typedef __bf16 bf16x2_t __attribute__((ext_vector_type(2)));
__device__ __forceinline__ unsigned cvtpk(float lo, float hi) { f32x2 v = {lo, hi}; bf16x2_t b = __builtin_convertvector(v, bf16x2_t); return __builtin_bit_cast(unsigned, b); }
__device__ __forceinline__ float fast_exp2(float x) { return __builtin_amdgcn_exp2f(x); }
__device__ __forceinline__ float fast_rcp(float x) { return __builtin_amdgcn_rcpf(x); }
__device__ __forceinline__ float sigmoidf_(float x) { return fast_rcp(1.f + fast_exp2(-1.4426950408889634f * x)); }
__device__ __forceinline__ float siluf_(float x) { return x * sigmoidf_(x); }
__device__ __forceinline__ int lane_id() { int l; asm volatile("v_mbcnt_lo_u32_b32 %0, -1, 0\n\tv_mbcnt_hi_u32_b32 %0, -1, %0" : "=v"(l)); return l; }
__device__ __forceinline__ float xhalf_(float v, int hi) {
    auto rr = __builtin_amdgcn_permlane32_swap(__float_as_uint(v), __float_as_uint(v), false, false);
    return hi ? __uint_as_float(rr[0]) : __uint_as_float(rr[1]);
}
#define xhalf(v) xhalf_((v), A.hi)
template <int CTRL> __device__ __forceinline__ int dpp_i(int v) { return __builtin_amdgcn_update_dpp(0, v, CTRL, 0xf, 0xf, true); }
template <int CTRL> __device__ __forceinline__ float dpp_f(float v) { return __int_as_float(__builtin_amdgcn_update_dpp(0, __float_as_int(v), CTRL, 0xf, 0xf, true)); }
__device__ __forceinline__ int sum32_i(int v) {
    v += dpp_i<0xB1>(v); v += dpp_i<0x4E>(v); v += dpp_i<0x141>(v); v += dpp_i<0x140>(v);
    const auto r = __builtin_amdgcn_permlane16_swap((unsigned)v, (unsigned)v, false, false);
    return (int)(r[0] + r[1]);
}
__device__ __forceinline__ float sum16x_f(float v) {
    const auto r = __builtin_amdgcn_permlane16_swap(__float_as_uint(v), __float_as_uint(v), false, false);
    return __uint_as_float(r[0]) + __uint_as_float(r[1]);
}
__device__ __forceinline__ float sum32x_f(float v) {
    const auto r = __builtin_amdgcn_permlane32_swap(__float_as_uint(v), __float_as_uint(v), false, false);
    return __uint_as_float(r[0]) + __uint_as_float(r[1]);
}
__device__ __forceinline__ float max16x_f(float v) {
    const auto r = __builtin_amdgcn_permlane16_swap(__float_as_uint(v), __float_as_uint(v), false, false);
    return fmaxf(__uint_as_float(r[0]), __uint_as_float(r[1]));
}
__device__ __forceinline__ float max32x_f(float v) {
    const auto r = __builtin_amdgcn_permlane32_swap(__float_as_uint(v), __float_as_uint(v), false, false);
    return fmaxf(__uint_as_float(r[0]), __uint_as_float(r[1]));
}
__device__ __forceinline__ float wave_sum_f(float v) {
    v += dpp_f<0xB1>(v); v += dpp_f<0x4E>(v); v += dpp_f<0x141>(v); v += dpp_f<0x140>(v);
    return sum32x_f(sum16x_f(v));
}
__device__ __forceinline__ void unpack8(bf16x8 v, float (&f)[8]) {
#pragma unroll
    for (int j = 0; j < 8; ++j) f[j] = bf2f((unsigned short)v[j]);
}

struct Params {
    const float* x; const float* norm_w; const float* w_in; const float* w_out; const float* conv_w; const float* pe_cmp;
    const float* w_cmp_k; const float* w_cmp_v; const float* pool_w; const float* pool_scale; const float* final_norm_w;
    float* out; unsigned char* ws; int ph_lo, ph_hi;
};

struct EpiIn {
    static constexpr bool PERM = true, AFTER_DRAIN = false, HAS_INIT = false, HAS_ROWS = true;
    bf16_t* Z; const float* RS; const f32x2* CS; float* WIF; float* BGF; unsigned char* lds;
    struct Rows { f32x4 rs; f32x2 cs; };
    __device__ __forceinline__ Rows rows_issue(const pg8::Unit& u, int tid) const {
        Rows r; r.rs = (f32x4){1.f, 1.f, 1.f, 1.f}; r.cs = (f32x2){1.f, 0.f};
        if (tid < 256) {
            r.rs = *(const GAS f32x4*)(RS + (size_t)(u.pm * 256 + tid) * 4);
            const int rr = tid >> 3, t0 = (u.pm * 256 + (rr >> 4) * 64 + (rr & 15)) & (SEQ - 1);
            r.cs = CS[t0 * 8 + (tid & 7)];
        }
        return r;
    }
    __device__ __forceinline__ void rows_commit(const Rows& r, int tid, int par, bool first) const {
        LAS float* lrs = (LAS float*)((LAS unsigned char*)lds + MISC_OFF + 1024) + par * 256;
        LAS f32x2* lcs = (LAS f32x2*)((LAS unsigned char*)lds + MISC_OFF + 4096) + par * 256;
        if (tid < 256) {
            lrs[tid] = 1.0f / sqrtf(((r.rs[0] + r.rs[1]) + (r.rs[2] + r.rs[3])) * (1.0f / 1024.0f) + 1e-6f);
            lcs[tid] = r.cs;
        }
        if (first && tid < 8) ((LAS f32x2*)((LAS unsigned char*)lds + MISC_OFF + 3072))[tid] = CS[16 * 8 + tid];
    }
    __device__ __forceinline__ void run(const f32x4 (&acc)[2][2][4][2], const pg8::Unit& u, int wr, int wc, int fr, int fq, int par) const {
        const int pn = u.pn;
        float rrv[2][4];
        {
            const LAS float* lrs = (const LAS float*)((LAS unsigned char*)lds + MISC_OFF + 1024) + par * 256;
#pragma unroll
            for (int ai = 0; ai < 2; ++ai)
#pragma unroll
                for (int m = 0; m < 4; ++m) rrv[ai][m] = lrs[ai * 128 + wr * 64 + m * 16 + fr];
        }
        const int cl0 = wc * 32 + fq * 8, hp0 = cl0 & 63;
        bool rope0 = false, rope1 = false; int fb = 0, fs = 1;
        if (pn == 0 || pn == 2) { if (hp0 < 16) { rope0 = rope1 = true; fb = hp0 >> 1; } }
        else if (pn == 1) { if ((cl0 & 31) == 0) { rope0 = rope1 = true; fs = 2; } }
        else if (pn == 3) { if (((cl0 >> 6) & 1) == 0 && hp0 < 16) { rope0 = rope1 = true; fb = hp0 >> 1; } }
        else if (pn == 4) { if ((cl0 >> 6) == 0 && hp0 < 16) { rope0 = true; fb = hp0 >> 1; } }
        else if (pn == 5) { if (cl0 == 0) { rope0 = true; fs = 2; } }
        f32x2 csc[4], cst[4];
        if (rope0) {
            const LAS f32x2* lcs = (const LAS f32x2*)((LAS unsigned char*)lds + MISC_OFF + 4096) + par * 256 + (wr * 16 + fr) * 8;
            const LAS f32x2* lst = (const LAS f32x2*)((LAS unsigned char*)lds + MISC_OFF + 3072);
#pragma unroll
            for (int e = 0; e < 4; ++e) { csc[e] = lcs[fb + e * fs]; cst[e] = lst[fb + e * fs]; }
        }
#pragma unroll
        for (int aim = 0; aim < 4; ++aim) {
            const int ai = aim >> 1;
#pragma unroll
            for (int m2 = 0; m2 < 2; ++m2) {
                const int m = 2 * (aim & 1) + m2;
                const int row = u.pm * 256 + ai * 128 + wr * 64 + m * 16 + fr;
                const float rr = rrv[ai][m];
#pragma unroll
                for (int bj = 0; bj < 2; ++bj) {
                    float v[8];
#pragma unroll
                    for (int e = 0; e < 4; ++e) { v[e] = acc[ai][bj][m][0][e] * rr; v[4 + e] = acc[ai][bj][m][1][e] * rr; }
                    const int cl = bj * 128 + wc * 32 + fq * 8;
                    if (bj == 0 ? rope0 : rope1) {
#pragma unroll
                        for (int e = 0; e < 4; ++e) {
                            const f32x2 cs = csc[e];
                            const float x1 = v[e], x2 = v[4 + e];
                            v[e] = x1 * cs[0] - x2 * cs[1]; v[4 + e] = x2 * cs[0] + x1 * cs[1];
                        }
                    }
                    if (pn == 0 || pn == 2) {
#pragma unroll
                        for (int e = 0; e < 8; ++e) v[e] *= C2;
                    } else if (pn == 6 || pn == 7 || pn == 11 || pn == 13) {
#pragma unroll
                        for (int e = 0; e < 8; ++e) v[e] = siluf_(v[e]);
                    } else if (pn == 5) {
                        if (cl == 32) { *(GAS f32x4*)(WIF + (size_t)row * 8) = (f32x4){v[0], v[1], v[2], v[3]}; *(GAS f32x4*)(WIF + (size_t)row * 8 + 4) = (f32x4){v[4], v[5], v[6], v[7]}; }
                        else if (cl == 40) { *(GAS f32x4*)(BGF + (size_t)row * 16) = (f32x4){sigmoidf_(v[0]), sigmoidf_(v[1]), sigmoidf_(v[2]), sigmoidf_(v[3])};
                                             *(GAS f32x4*)(BGF + (size_t)row * 16 + 4) = (f32x4){sigmoidf_(v[4]), sigmoidf_(v[5]), sigmoidf_(v[6]), sigmoidf_(v[7])}; }
                        else if (cl == 48) { *(GAS f32x4*)(BGF + (size_t)row * 16 + 8) = (f32x4){sigmoidf_(v[0]), sigmoidf_(v[1]), sigmoidf_(v[2]), sigmoidf_(v[3])}; }
                    }
                    u32x4 w; w[0] = cvtpk(v[0], v[1]); w[1] = cvtpk(v[2], v[3]); w[2] = cvtpk(v[4], v[5]); w[3] = cvtpk(v[6], v[7]);
                    *(GAS u32x4*)(Z + (size_t)row * NZ + pn * 256 + cl) = w;
                }
                if (rope0 && !(ai == 1 && m == 3)) {
#pragma unroll
                    for (int st = 0; st < (m == 3 ? 5 : 1); ++st)
#pragma unroll
                        for (int e = 0; e < 4; ++e) { const float c = csc[e][0], sn = csc[e][1]; csc[e][0] = c * cst[e][0] - sn * cst[e][1]; csc[e][1] = sn * cst[e][0] + c * cst[e][1]; }
                }
            }
        }
    }
};

struct EpiOut {
    static constexpr bool PERM = true, AFTER_DRAIN = false, HAS_INIT = true, HAS_ROWS = false;
    bf16_t* XB; float* RS; unsigned char* lds;
    __device__ __forceinline__ void init(f32x4 (&acc)[2][2][4][2], const pg8::Unit& u, int wr, int wc, int fr, int fq) const {
        bf16x8 xold[2][4][2];
#pragma unroll
        for (int ai = 0; ai < 2; ++ai)
#pragma unroll
            for (int m = 0; m < 4; ++m)
#pragma unroll
                for (int bj = 0; bj < 2; ++bj) xold[ai][m][bj] = *(const GAS bf16x8*)(XB + (size_t)(u.pm * 256 + ai * 128 + wr * 64 + m * 16 + fr) * DM + u.pn * 256 + bj * 128 + wc * 32 + fq * 8);
#pragma unroll
        for (int ai = 0; ai < 2; ++ai)
#pragma unroll
            for (int m = 0; m < 4; ++m)
#pragma unroll
                for (int bj = 0; bj < 2; ++bj) {
                    float xo[8]; unpack8(xold[ai][m][bj], xo);
                    acc[ai][bj][m][0] = (f32x4){xo[0], xo[1], xo[2], xo[3]}; acc[ai][bj][m][1] = (f32x4){xo[4], xo[5], xo[6], xo[7]};
                }
    }
    __device__ __forceinline__ void operator()(const f32x4 (&acc)[2][2][4][2], const pg8::Unit& u, int wr, int wc, int fr, int fq) const {
        LAS float* part = (LAS float*)((LAS unsigned char*)lds + MISC_OFF + 1024);
#pragma unroll
        for (int aim = 0; aim < 4; ++aim) {
            const int ai = aim >> 1;
#pragma unroll
            for (int m2 = 0; m2 < 2; ++m2) {
                const int m = 2 * (aim & 1) + m2;
                const int rt = ai * 128 + wr * 64 + m * 16 + fr, row = u.pm * 256 + rt;
                float ssq = 0.f;
#pragma unroll
                for (int bj = 0; bj < 2; ++bj) {
                    const int col = u.pn * 256 + bj * 128 + wc * 32 + fq * 8;
                    const size_t off = (size_t)row * DM + col;
                    u32x4 w;
                    w[0] = cvtpk(acc[ai][bj][m][0][0], acc[ai][bj][m][0][1]); w[1] = cvtpk(acc[ai][bj][m][0][2], acc[ai][bj][m][0][3]);
                    w[2] = cvtpk(acc[ai][bj][m][1][0], acc[ai][bj][m][1][1]); w[3] = cvtpk(acc[ai][bj][m][1][2], acc[ai][bj][m][1][3]);
                    *(GAS u32x4*)(XB + off) = w;
                    float xr[8]; unpack8(__builtin_bit_cast(bf16x8, w), xr);
#pragma unroll
                    for (int e = 0; e < 8; ++e) ssq = fmaf(xr[e], xr[e], ssq);
                }
                ssq = sum32x_f(sum16x_f(ssq));
                if (fq == 0) part[rt * 4 + wc] = ssq;
            }
            asm volatile("" ::: "memory");
        }
        __syncthreads();
        const int tid = (wr * 4 + wc) * 64 + fq * 16 + fr;
        if (tid < 256) { const f32x4 p4 = *(const LAS f32x4*)(part + tid * 4); RS[(size_t)(u.pm * 256 + tid) * 4 + u.pn] = (p4[0] + p4[1]) + (p4[2] + p4[3]); }
    }
};

struct Frame {
    unsigned char* lds; int wave, G;
    unsigned char* ws;
    __device__ __forceinline__ int lane_() const { return lane_id(); }
    __device__ __forceinline__ int tid_() const { return wave * 64 + lane_id(); }
    __device__ __forceinline__ unsigned* ctl_() const { return (unsigned*)(ws + WS_CTL); }
    __device__ __forceinline__ bf16_t* WIT_() const { return (bf16_t*)(ws + WS_WIT); }
    __device__ __forceinline__ bf16_t* WOT_() const { return (bf16_t*)(ws + WS_WOT); }
    __device__ __forceinline__ bf16_t* WCT_() const { return (bf16_t*)(ws + WS_WCT); }
    __device__ __forceinline__ bf16_t* PWT_() const { return (bf16_t*)(ws + WS_PWT); }
    __device__ __forceinline__ bf16_t* KCMP_() const { return (bf16_t*)(ws + WS_KCMP); }
    __device__ __forceinline__ bf16_t* VCMP_() const { return (bf16_t*)(ws + WS_VCMP); }
    __device__ __forceinline__ bf16_t* XB_() const { return (bf16_t*)(ws + WS_XB); }
    __device__ __forceinline__ bf16_t* Z_() const { return (bf16_t*)(ws + WS_Z); }
    __device__ __forceinline__ bf16_t* MIXED_() const { return (bf16_t*)(ws + WS_MIXED); }
    __device__ __forceinline__ f32x2* CS_() const { return (f32x2*)(ws + WS_CS); }
    __device__ __forceinline__ float* RS_() const { return (float*)(ws + WS_RS); }
    __device__ __forceinline__ float* WIF_() const { return (float*)(ws + WS_WIF); }
    __device__ __forceinline__ float* BGF_() const { return (float*)(ws + WS_BGF); }
    __device__ __forceinline__ unsigned* MASK_() const { return (unsigned*)(ws + WS_MASK); }
    __device__ __forceinline__ float* KP_() const { return (float*)(ws + WS_KP); }
    __device__ __forceinline__ unsigned* KMAX_() const { return (unsigned*)(ws + WS_CTL) + 8192; }
};

__device__ __forceinline__ int next_item(Frame& F, int q) {
    volatile unsigned* slot = (volatile unsigned*)(F.lds + MISC_OFF);
    __syncthreads();
    if (F.tid_() == 0) slot[0] = atomicAdd(F.ctl_() + 64 * q, 1u);
    __syncthreads();
    return __builtin_amdgcn_readfirstlane((int)slot[0]);
}
__device__ __forceinline__ unsigned xcc_id() { return (unsigned)__builtin_amdgcn_s_getreg((3 << 11) | 20) & 0xFu; }
__device__ __forceinline__ bool next_item_batch(Frame& F, int qfirst, int nitems, int& b, int& it) {
    const int home = (int)(xcc_id() & 7u);
    { const int v = next_item(F, qfirst + home); if (v < nitems) { b = home; it = v; return true; } }
    volatile unsigned* slot = (volatile unsigned*)(F.lds + MISC_OFF);
    for (;;) {
        __syncthreads();
        if (F.wave == 0) {
            const int l = F.lane_();
            unsigned c = 0xffffffffu;
            if (l < 8) c = __hip_atomic_load(F.ctl_() + 64 * (qfirst + l), __ATOMIC_RELAXED, __HIP_MEMORY_SCOPE_AGENT);
            const unsigned long long m = __ballot(c < (unsigned)nitems);
            if (l == 0) slot[1] = (unsigned)m;
        }
        __syncthreads();
        const unsigned mask = (unsigned)__builtin_amdgcn_readfirstlane((int)slot[1]) & 0xffu;
        if (mask == 0u) return false;
        const unsigned rot = ((mask >> home) | (mask << (8 - home))) & 0xffu;
        const int bq = (home + __builtin_ctz(rot)) & 7;
        const int v = next_item(F, qfirst + bq);
        if (v < nitems) { b = bq; it = v; return true; }
    }
}

template <int MAP>
__device__ __forceinline__ void transpose_item(const float* W, int K, int Nsrc, bf16_t* WT, int nblk, const float* kscale, float* scr, int item, int lane) {
    const int kb = item / nblk, nb = item % nblk, k0 = 64 * kb, n0 = 32 * nb;
    int sc = n0 + (lane & 31);
    if (MAP == 1) sc = src_col(sc);
    float vv[32], ks_[32];
    const int scc = sc >= 0 ? sc : 0;
#pragma unroll
    for (int i = 0; i < 32; ++i) { const int kk = 2 * i + (lane >> 5); vv[i] = W[(size_t)(k0 + kk) * Nsrc + scc]; ks_[i] = kscale ? kscale[k0 + kk] : 1.f; }
#pragma unroll
    for (int i = 0; i < 32; ++i) { const int kk = 2 * i + (lane >> 5); scr[kk * 33 + (lane & 31)] = (sc >= 0) ? vv[i] * ks_[i] : 0.f; }
    asm volatile("s_waitcnt lgkmcnt(0)" ::: "memory");
    const int c = lane & 7;
#pragma unroll
    for (int j = 0; j < 4; ++j) {
        const int n = (lane >> 3) + 8 * j; const float* s = scr + (8 * c) * 33 + n;
        u32x4 o; o[0] = cvtpk(s[0 * 33], s[1 * 33]); o[1] = cvtpk(s[2 * 33], s[3 * 33]); o[2] = cvtpk(s[4 * 33], s[5 * 33]); o[3] = cvtpk(s[6 * 33], s[7 * 33]);
        *(GAS u32x4*)(WT + (size_t)(n0 + n) * K + k0 + 8 * c) = o;
    }
    asm volatile("s_waitcnt lgkmcnt(0)" ::: "memory");
}

__device__ __forceinline__ void sincos_d(double x, float& c, float& s) {
    const double TWO_OVER_PI = 0.63661977236758134308, PIO2_HI = 1.57079632679489655800e+00, PIO2_LO = 6.12323399573676603587e-17;
    const double kd = __builtin_rint(x * TWO_OVER_PI);
    const double r = (x - kd * PIO2_HI) - kd * PIO2_LO;
    const double r2 = r * r;
    double sp = -1.0 / 1307674368000.0;
    sp = sp * r2 + 1.0 / 6227020800.0;
    sp = sp * r2 - 1.0 / 39916800.0;
    sp = sp * r2 + 1.0 / 362880.0;
    sp = sp * r2 - 1.0 / 5040.0;
    sp = sp * r2 + 1.0 / 120.0;
    sp = sp * r2 - 1.0 / 6.0;
    const double sn = r + r * r2 * sp;
    double cp = 1.0 / 20922789888000.0;
    cp = cp * r2 - 1.0 / 87178291200.0;
    cp = cp * r2 + 1.0 / 479001600.0;
    cp = cp * r2 - 1.0 / 3628800.0;
    cp = cp * r2 + 1.0 / 40320.0;
    cp = cp * r2 - 1.0 / 720.0;
    cp = cp * r2 + 1.0 / 24.0;
    cp = cp * r2 - 0.5;
    const double cn = 1.0 + r2 * cp;
    const int q = ((int)kd) & 3;
    const double cc = (q == 0) ? cn : (q == 1) ? -sn : (q == 2) ? -cn : sn;
    const double ss = (q == 0) ? sn : (q == 1) ? cn : (q == 2) ? -sn : -cn;
    c = (float)cc; s = (float)ss;
}

__device__ __forceinline__ void phase_prologue(Frame& F, const Params& P) {
    float* scr = (float*)(F.lds + F.wave * 16384);
    const int gw = blockIdx.x * 8 + F.wave, NGW = F.G * 8;
    constexpr int I_IN = 16 * 112, I_OUT = 16 * 32, I_CMP = 32 * 2, I_POOL = 1 * 2;
    constexpr int N_IN = DEPTH * I_IN, N_OUT = DEPTH * I_OUT, N_CMP = DEPTH * 2 * I_CMP, N_POOL = DEPTH * 4 * I_POOL;
    for (int it = gw; it < N_IN + N_OUT + N_CMP + N_POOL; it += NGW) {
        int r = it;
        if (r < N_IN) { const int l = r / I_IN; transpose_item<1>(P.w_in + (size_t)l * DM * D_IN, DM, D_IN, F.WIT_() + (size_t)l * NZ * DM, 112, P.norm_w + l * DM, scr, r % I_IN, F.lane_()); continue; }
        r -= N_IN;
        if (r < N_OUT) { const int l = r / I_OUT; transpose_item<0>(P.w_out + (size_t)l * DM * DM, DM, DM, F.WOT_() + (size_t)l * DM * DM, 32, nullptr, scr, r % I_OUT, F.lane_()); continue; }
        r -= N_OUT;
        if (r < N_CMP) { const int lk = r / I_CMP, l = lk >> 1, kv = lk & 1; const float* W = (kv ? P.w_cmp_v : P.w_cmp_k) + (size_t)l * 2048 * 64;
            transpose_item<0>(W, 2048, 64, F.WCT_() + (size_t)lk * 64 * 2048, 2, nullptr, scr, r % I_CMP, F.lane_()); continue; }
        r -= N_CMP;
        { const int lg = r / I_POOL; transpose_item<0>(P.pool_w + (size_t)lg * 64 * 64, 64, 64, F.PWT_() + (size_t)lg * 64 * 64, 2, nullptr, scr, r % I_POOL, F.lane_()); }
    }
    {
        const float inv[8] = {1.000000000e+00f, 1.939227432e-01f, 3.760603070e-02f, 7.292664610e-03f, 1.414213562e-03f, 2.742481884e-04f, 5.318296098e-05f, 1.031338616e-05f};
        for (int i = blockIdx.x * 512 + F.tid_(); i < SEQ * 8; i += F.G * 512) {
            const int t = i >> 3, f = i & 7;
            float iv = inv[0];
#pragma unroll
            for (int k = 1; k < 8; ++k) iv = (f == k) ? inv[k] : iv;
            const float ang = (float)t * iv;
            float c, s; sincos_d((double)ang, c, s);
            F.CS_()[i] = (f32x2){c, s};
        }
    }
    for (int row0 = gw * 4; row0 < MROWS; row0 += NGW * 4) {
        f32x4 v[4][4];
#pragma unroll
        for (int r = 0; r < 4; ++r) { const f32x4* xr = (const f32x4*)(P.x + (size_t)(row0 + r) * DM) + F.lane_();
#pragma unroll
            for (int j = 0; j < 4; ++j) v[r][j] = xr[64 * j]; }
#pragma unroll
        for (int r = 0; r < 4; ++r) {
            u32x2* o8 = (u32x2*)(F.XB_() + (size_t)(row0 + r) * DM) + F.lane_();
            float s = 0.f;
#pragma unroll
            for (int j = 0; j < 4; ++j) {
                u32x2 w; w[0] = cvtpk(v[r][j][0], v[r][j][1]); w[1] = cvtpk(v[r][j][2], v[r][j][3]); o8[64 * j] = w;
                const float a0 = __uint_as_float(w[0] << 16), a1 = __uint_as_float(w[0] & 0xffff0000u), a2 = __uint_as_float(w[1] << 16), a3 = __uint_as_float(w[1] & 0xffff0000u);
                s += (a0 * a0 + a1 * a1) + (a2 * a2 + a3 * a3);
            }
            s = wave_sum_f(s);
            if (F.lane_() < 4) F.RS_()[(size_t)(row0 + r) * 4 + F.lane_()] = (F.lane_() == 0) ? s : 0.f;
        }
    }
}

__device__ __forceinline__ void compress_item(Frame& F, const Params& P, int layer, int bitem) {
    const int witem = bitem;
    const int kv = witem & 1, ng = (witem >> 1) & 15, b = witem >> 5;
    int tid_ = F.tid_(); asm volatile("" : "+v"(tid_));
    const int lane = tid_ & 63, c = lane & 15, G = lane >> 4;
    const int n = 16 * ng + c, nc = n > 254 ? 254 : n;
    const bf16_t* zrow = F.Z_() + ((size_t)b * SEQ + 16 * nc) * NZ + (kv ? ZVC : ZKC) + 8 * G;
    const float* pe = P.pe_cmp + (size_t)layer * 32 * 64 + 8 * G;
    const bf16_t* wt = F.WCT_() + (size_t)(layer * 2 + kv) * 64 * 2048 + (size_t)c * 2048 + 8 * G;
    f32x4 acc[4];
#pragma unroll
    for (int nt = 0; nt < 4; ++nt) acc[nt] = (f32x4){0.f, 0.f, 0.f, 0.f};
#pragma unroll
    for (int kk = 0; kk < 8; ++kk) {
        const int ks = 8 * F.wave + kk;
        const int i = ks >> 1, d0 = 32 * (ks & 1);
        const bf16x8 zr = *(const GAS bf16x8*)(zrow + (size_t)i * NZ + d0);
        const f32x4 p0 = *(const GAS f32x4*)(pe + i * 64 + d0), p1 = *(const GAS f32x4*)(pe + i * 64 + d0 + 4);
        float f[8]; unpack8(zr, f);
        u32x4 aw; aw[0] = cvtpk(f[0] + p0[0], f[1] + p0[1]); aw[1] = cvtpk(f[2] + p0[2], f[3] + p0[3]); aw[2] = cvtpk(f[4] + p1[0], f[5] + p1[1]); aw[3] = cvtpk(f[6] + p1[2], f[7] + p1[3]);
        const bf16x8 af = __builtin_bit_cast(bf16x8, aw);
#pragma unroll
        for (int nt = 0; nt < 4; ++nt) {
            const bf16x8 bf = *(const GAS bf16x8*)(wt + (size_t)nt * 16 * 2048 + ks * 32);
            acc[nt] = __builtin_amdgcn_mfma_f32_16x16x32_bf16(af, bf, acc[nt], 0, 0, 0);
        }
    }
    {
        LAS float* red = (LAS float*)((LAS unsigned char*)F.lds) + F.wave * 1024 + lane;
#pragma unroll
        for (int nt = 0; nt < 4; ++nt)
#pragma unroll
            for (int e = 0; e < 4; ++e) red[(nt * 4 + e) * 64] = acc[nt][e];
    }
    __syncthreads();
    if (__builtin_amdgcn_readfirstlane(F.wave) == 0) {
    {
        const LAS float* red = (const LAS float*)((LAS unsigned char*)F.lds) + lane;
#pragma unroll
        for (int nt = 0; nt < 4; ++nt)
#pragma unroll
            for (int e = 0; e < 4; ++e) {
                float sacc = red[(nt * 4 + e) * 64];
#pragma unroll
                for (int w = 1; w < 8; ++w) sacc += red[w * 1024 + (nt * 4 + e) * 64];
                acc[nt][e] = sacc;
            }
    }
    bf16_t* dst = (kv ? F.VCMP_() : F.KCMP_()) + (size_t)b * 256 * 64;
#pragma unroll
    for (int nt = 0; nt < 4; ++nt)
#pragma unroll
        for (int e = 0; e < 4; ++e) {
            const int nn = 16 * ng + 4 * G + e;
            float v = acc[nt][e];
            int dcol = 16 * nt + c;
            if (kv == 0) {
                if (nt == 0) {
                    const float partner = dpp_f<0x128>(v);
                    const int tpos = 16 * nn + 31;
                    const f32x2 cs = F.CS_()[(tpos & (SEQ - 1)) * 8 + (c & 7)];
                    v = (c < 8) ? (v * cs[0] - partner * cs[1]) : (v * cs[0] + partner * cs[1]);
                }
                dcol = perm64(dcol);
            }
            if (nn > 254) v = 0.f;
            dst[(size_t)nn * 64 + dcol] = (bf16_t)(cvtpk(v, 0.f) & 0xffffu);
        }
    }
}

__device__ __forceinline__ void select_item(Frame& F, int b, int qg) {
    int tid_ = F.tid_(); asm volatile("" : "+v"(tid_));
    const int lane = tid_ & 63, half = lane >> 5, idx = lane & 31, c = lane & 15, G = lane >> 4;
    const int tA = qg * 16 + F.wave * 2, tq = tA + half;
    const size_t rowbase = (size_t)b * SEQ;
#if defined(ABL_SC2)
    const bf16x8 afrag = (bf16x8){(short)0x3f80, (short)0xbf80, (short)0x3f00, (short)0x3f80, (short)0x4000, (short)0xbf00, (short)0x3f80, (short)0x3e80};
#else
    const bf16x8 afrag = *(const GAS bf16x8*)(F.Z_() + (rowbase + tA + (c >> 3)) * NZ + ZQI + (c & 7) * 32 + G * 8);
#endif
#if !(defined(ABL_SC1))
    s16x4 wX, wY;
    {
        const int wrow = c, kg = G;
        const f32x4 wv = *(const GAS f32x4*)(F.WIF_() + (rowbase + tA + (kg >> 1)) * 8 + 4 * (kg & 1));
        const unsigned p01 = cvtpk(wv[0], wv[1]), p23 = cvtpk(wv[2], wv[3]);
        const bool onX = (wrow == 8 * (kg >> 1)), onY = (wrow == 8 * (kg >> 1) + 4);
        const unsigned x01 = onX ? p01 : 0u, x23 = onX ? p23 : 0u, y01 = onY ? p01 : 0u, y23 = onY ? p23 : 0u;
        wX = __builtin_bit_cast(s16x4, (u32x2){x01, x23}); wY = __builtin_bit_cast(s16x4, (u32x2){y01, y23});
    }
    const bf16x8 wXY = (bf16x8){wX[0], wX[1], wX[2], wX[3], wY[0], wY[1], wY[2], wY[3]};
#endif
#if defined(ABL_SC1)
    const f32x4 w4 = (f32x4){1.f, 0.5f, -0.25f, 2.f};
#endif
    const int nchunks = ((qg * 16) >> 8) + 1;
    constexpr int SEL_NBUF = 6, SEL_D = 4;
    LAS unsigned char* kl = (LAS unsigned char*)F.lds;
    const unsigned char* zb = (const unsigned char*)F.Z_();
    const int pk0 = 32 * F.wave + (lane >> 2);
#define SEL_G(k_) ((0x78u >> (2 * (k_))) & 3u)
    const int pG = (lane & 3) ^ (int)SEL_G((lane >> 4) & 3);
    unsigned soff = (unsigned)(((rowbase + pk0) * NZ + ZKI + pG * 8) * 2);
    const unsigned rbase = c * 64 + ((G ^ SEL_G((c >> 2) & 3)) << 4);
#undef SEL_G
    const int nch1 = nchunks - 1;
#define SEL_DMA(chunk_) do { const int cc_ = (chunk_) < nch1 ? (chunk_) : nch1; const unsigned so_ = soff + (unsigned)cc_ * (256u * NZ * 2u); \
        LAS unsigned char* dst_ = kl + ((chunk_) % SEL_NBUF) * 16384 + F.wave * 2048; \
        __builtin_amdgcn_global_load_lds((const unsigned*)(zb + so_), (LAS unsigned*)dst_, 16, 0, 0); \
        __builtin_amdgcn_global_load_lds((const unsigned*)(zb + so_ + 16u * NZ * 2u), (LAS unsigned*)(dst_ + 1024), 16, 0, 0); } while (0)
#pragma unroll
    for (int i = 0; i < SEL_D; ++i) SEL_DMA(i);
    unsigned u[128];
#pragma unroll
    for (int ch = 0; ch < 16; ++ch) {
        if (ch < nchunks) {
            SEL_DMA(ch + SEL_D);
            asm volatile("s_waitcnt vmcnt(%0)" :: "n"(2 * SEL_D) : "memory");
            __builtin_amdgcn_s_barrier();
            asm volatile("" ::: "memory");
            const LAS unsigned char* kb = kl + (ch % SEL_NBUF) * 16384 + rbase;
            typedef short s16x2_ __attribute__((ext_vector_type(2)));
            const s16x2_ z2 = (s16x2_){0, 0};
            bf16x8 kfr[3][2]; f32x4 xq[2], yq[2], scq[2];
            kfr[0][0] = *(const LAS bf16x8*)(kb); kfr[0][1] = *(const LAS bf16x8*)(kb + 1024);
            kfr[1][0] = *(const LAS bf16x8*)(kb + 2048); kfr[1][1] = *(const LAS bf16x8*)(kb + 3072);
#pragma unroll
            for (int t = 0; t < 10; ++t) {
                if (t + 2 < 8) { kfr[(t + 2) % 3][0] = *(const LAS bf16x8*)(kb + (2 * t + 4) * 1024); kfr[(t + 2) % 3][1] = *(const LAS bf16x8*)(kb + (2 * t + 5) * 1024); }
                if (t < 8) {
                    xq[t & 1] = __builtin_amdgcn_mfma_f32_16x16x32_bf16(afrag, kfr[t % 3][0], (f32x4){0.f, 0.f, 0.f, 0.f}, 0, 0, 0);
                    yq[t & 1] = __builtin_amdgcn_mfma_f32_16x16x32_bf16(afrag, kfr[t % 3][1], (f32x4){0.f, 0.f, 0.f, 0.f}, 0, 0, 0);
                }
                __builtin_amdgcn_sched_barrier(0);
                if (t >= 1 && t <= 8) {
                    const f32x4 x = xq[(t - 1) & 1], y = yq[(t - 1) & 1];
                    const unsigned bx0 = __builtin_bit_cast(unsigned, __builtin_elementwise_max(__builtin_bit_cast(s16x2_, cvtpk(x[0], x[1])), z2));
                    const unsigned bx1 = __builtin_bit_cast(unsigned, __builtin_elementwise_max(__builtin_bit_cast(s16x2_, cvtpk(x[2], x[3])), z2));
                    const unsigned by0 = __builtin_bit_cast(unsigned, __builtin_elementwise_max(__builtin_bit_cast(s16x2_, cvtpk(y[0], y[1])), z2));
                    const unsigned by1 = __builtin_bit_cast(unsigned, __builtin_elementwise_max(__builtin_bit_cast(s16x2_, cvtpk(y[2], y[3])), z2));
                    scq[(t - 1) & 1] = __builtin_amdgcn_mfma_f32_16x16x32_bf16(wXY, __builtin_bit_cast(bf16x8, (u32x4){bx0, bx1, by0, by1}), (f32x4){0.f, 0.f, 0.f, 0.f}, 0, 0, 0);
                }
                if (t >= 2) {
                    const int j = ch * 8 + t - 2;
                    const unsigned bits = __float_as_uint(scq[(t - 2) & 1][0]);
                    const unsigned ku = bits ^ ((unsigned)((int)bits >> 31) | 0x80000000u);
                    u[j] = ((32 * j + idx) <= tq) ? ku : 0u;
                }
                __builtin_amdgcn_sched_barrier(0);
            }
        } else {
#pragma unroll
            for (int jj = 0; jj < 8; ++jj) u[ch * 8 + jj] = 0u;
        }
    }
#undef SEL_DMA
    asm volatile("s_waitcnt vmcnt(0)" ::: "memory");
    unsigned myw[4] = {0u, 0u, 0u, 0u};
    if (qg < 16) {
#pragma unroll
        for (int jj = 0; jj < 8; ++jj) {
            const unsigned long long bal = __ballot(u[jj] != 0u);
            asm volatile("s_nop 1\n\tv_writelane_b32 %0, %1, %2" : "+v"(myw[0]) : "s"((unsigned)bal), "n"(jj));
            asm volatile("s_nop 1\n\tv_writelane_b32 %0, %1, %2" : "+v"(myw[0]) : "s"((unsigned)(bal >> 32)), "n"(32 + jj));
        }
    } else {
        const int nw = (nchunks + 3) >> 2;
#pragma unroll
        for (int w = 0; w < 4; ++w) {
            if (w < nw) {
#define TR_STAGE(J, M) _Pragma("unroll") for (int k = 0; k < 32; ++k) { if ((k & (J)) == 0) { \
                    const unsigned t_ = ((u[32 * w + k] >> (J)) ^ u[32 * w + k + (J)]) & (M); u[32 * w + k + (J)] ^= t_; u[32 * w + k] ^= (t_ << (J)); } }
#define TR_PERM(J, SA, SB) _Pragma("unroll") for (int k = 0; k < 32; ++k) { if ((k & (J)) == 0) { \
                    const unsigned a_ = u[32 * w + k], b_ = u[32 * w + k + (J)]; u[32 * w + k] = __builtin_amdgcn_perm(b_, a_, (SA)); u[32 * w + k + (J)] = __builtin_amdgcn_perm(b_, a_, (SB)); } }
                TR_PERM(16, 0x05040100u, 0x07060302u) TR_PERM(8, 0x06020400u, 0x07030501u) TR_STAGE(4, 0x0f0f0f0fu) TR_STAGE(2, 0x33333333u) TR_STAGE(1, 0x55555555u)
#undef TR_PERM
#undef TR_STAGE
            }
        }
        unsigned gt[4] = {0u, 0u, 0u, 0u}, eq[4];
#pragma unroll
        for (int w = 0; w < 4; ++w) eq[w] = (w < nw) ? 0xffffffffu : 0u;
        bool done = false, exact = false;
#pragma unroll
        for (int bit = 31; bit >= 0; --bit) {
            if (!__all(done)) {
                int cnt = 0;
#pragma unroll
                for (int w = 0; w < 4; ++w) { if (w < nw) cnt += __popc(gt[w] | (eq[w] & u[32 * w + bit])); }
                cnt = sum32_i(cnt);
                if (!done) {
                    const bool acc = cnt >= 256;
#pragma unroll
                    for (int w = 0; w < 4; ++w) {
                        if (w < nw) { const unsigned t_ = eq[w] & u[32 * w + bit]; gt[w] = acc ? gt[w] : (gt[w] | t_); eq[w] = acc ? t_ : (eq[w] ^ t_); }
                    }
                    if (cnt == 256) { done = true; exact = true; }
                }
            }
        }
        unsigned selw[4];
#pragma unroll
        for (int w = 0; w < 4; ++w) selw[w] = exact ? (gt[w] | eq[w]) : gt[w];
        if (!__all(exact)) {
            int ngt = 0;
#pragma unroll
            for (int w = 0; w < 4; ++w) ngt += __popc(gt[w]);
            ngt = sum32_i(ngt);
            const int need = 256 - ngt;
            int run = 0;
#pragma unroll
            for (int w = 0; w < 4; ++w) {
                if (w < nw) {
#pragma unroll
                    for (int i = 0; i < 32; ++i) {
                        const bool e = (!exact) && ((eq[w] >> i) & 1u);
                        const unsigned long long bq = __ballot(e);
                        const unsigned hm = half ? (unsigned)(bq >> 32) : (unsigned)bq;
                        const int below = __popc(hm & ((1u << idx) - 1u));
                        if (e && (run + below < need)) selw[w] |= (1u << i);
                        run += __popc(hm);
                    }
                }
            }
        }
#pragma unroll
        for (int w = 0; w < 4; ++w) {
            if (w < nw) {
#pragma unroll
                for (int i = 0; i < 32; ++i) {
                    const unsigned long long bal = __ballot((selw[w] >> i) & 1u);
                    asm volatile("s_nop 1\n\tv_writelane_b32 %0, %1, %2" : "+v"(myw[w]) : "s"((unsigned)bal), "n"(i));
                    asm volatile("s_nop 1\n\tv_writelane_b32 %0, %1, %2" : "+v"(myw[w]) : "s"((unsigned)(bal >> 32)), "n"(32 + i));
                }
            }
        }
    }
    unsigned* mrow = F.MASK_() + (rowbase + tq) * 128;
#pragma unroll
    for (int k = 0; k < 4; ++k) mrow[32 * k + idx] = myw[k];
}

template <int VAR>
__device__ __forceinline__ void convpool_item(Frame& F, const Params& P, int layer, int item) {
    int tid_ = F.tid_(); asm volatile("" : "+v"(tid_));
    const int lane = tid_ & 63;
    const int tok0 = item * 128 + F.wave * 16;
    LAS unsigned char* dub = (LAS unsigned char*)F.lds;
#pragma unroll
    for (int i = 0; i < 9; ++i) {
        const int r = 18 * F.wave + 2 * i + (lane >> 5), p = lane & 31;
        int grow = item * 128 - 16 + r; grow = grow < 0 ? 0 : grow;
        __builtin_amdgcn_global_load_lds((const unsigned*)(F.Z_() + (size_t)grow * NZ + ZDU + 8 * (p ^ (r & 15))), (LAS unsigned*)(dub + (18 * F.wave + 2 * i) * 512), 16, 0, 0);
    }
    if (VAR != 2) {
        const int h = lane >> 5, ch = lane & 31;
        const int t0h = tok0 + 8 * h, tp0 = t0h & (SEQ - 1);
        const bf16_t* zb = F.Z_() + (size_t)t0h * NZ + 8 * ch;
        const float* cw = P.conv_w + (size_t)layer * 3 * 256 + 8 * ch;
        bf16x8 rc[10], rx[10], ra[8], rg[8];
#pragma unroll
        for (int i = 0; i < 10; ++i) { const int d = i - 2; const int dd = (tp0 + d >= 0) ? d : 0;
            rc[i] = *(const GAS bf16x8*)(zb + (ptrdiff_t)dd * NZ + ZCC); rx[i] = *(const GAS bf16x8*)(zb + (ptrdiff_t)dd * NZ + ZCX); }
#pragma unroll
        for (int i = 0; i < 8; ++i) { ra[i] = *(const GAS bf16x8*)(zb + (size_t)i * NZ + ZCB); rg[i] = *(const GAS bf16x8*)(zb + (size_t)i * NZ + ZGC); }
        float w0[8], w1[8], w2[8];
        { const f32x4 a0 = *(const GAS f32x4*)(cw), a1 = *(const GAS f32x4*)(cw + 4), b0 = *(const GAS f32x4*)(cw + 256), b1 = *(const GAS f32x4*)(cw + 260), c0 = *(const GAS f32x4*)(cw + 512), c1 = *(const GAS f32x4*)(cw + 516);
#pragma unroll
          for (int e = 0; e < 4; ++e) { w0[e] = a0[e]; w0[4 + e] = a1[e]; w1[e] = b0[e]; w1[4 + e] = b1[e]; w2[e] = c0[e]; w2[4 + e] = c1[e]; } }
        float um2[8], um1[8];
        { float cc[8], cx[8]; unpack8(rc[0], cc); unpack8(rx[0], cx); const float z = (tp0 >= 2) ? 1.f : 0.f;
#pragma unroll
          for (int e = 0; e < 8; ++e) um2[e] = cc[e] * cx[e] * z; }
        { float cc[8], cx[8]; unpack8(rc[1], cc); unpack8(rx[1], cx); const float z = (tp0 >= 1) ? 1.f : 0.f;
#pragma unroll
          for (int e = 0; e < 8; ++e) um1[e] = cc[e] * cx[e] * z; }
#pragma unroll
        for (int i = 0; i < 8; ++i) {
            float cc[8], cx[8], a[8], bq[8], u[8], o[8];
            unpack8(rc[i + 2], cc); unpack8(rx[i + 2], cx); unpack8(ra[i], a); unpack8(rg[i], bq);
#pragma unroll
            for (int e = 0; e < 8; ++e) { u[e] = cc[e] * cx[e]; o[e] = bq[e] * (a[e] * (um2[e] * w0[e] + um1[e] * w1[e] + u[e] * w2[e])); }
            u32x4 w; w[0] = cvtpk(o[0], o[1]); w[1] = cvtpk(o[2], o[3]); w[2] = cvtpk(o[4], o[5]); w[3] = cvtpk(o[6], o[7]);
            *(GAS u32x4*)(F.MIXED_() + (size_t)(t0h + i) * DM + 512 + 8 * ch) = w;
#pragma unroll
            for (int e = 0; e < 8; ++e) { um2[e] = um1[e]; um1[e] = u[e]; }
        }
    }
    const int tk = lane & 15, G = lane >> 4, row = tok0 + tk, tpos = row & (SEQ - 1);
    const bf16_t* zr = F.Z_() + (size_t)row * NZ;
    {
        const int zk[3] = {ZKA, ZKS, ZKW};
#pragma unroll
        for (int ty = 0; ty < 3; ++ty) {
            float f0[8], f1[8]; unpack8(*(const GAS bf16x8*)(zr + zk[ty] + 16 * G), f0); unpack8(*(const GAS bf16x8*)(zr + zk[ty] + 16 * G + 8), f1);
            float ss = 0.f;
#pragma unroll
            for (int e = 0; e < 8; ++e) ss += f0[e] * f0[e] + f1[e] * f1[e];
            ss = sum32x_f(sum16x_f(ss));
            ss = fmaxf(ss, dpp_f<0xB1>(ss)); ss = fmaxf(ss, dpp_f<0x4E>(ss)); ss = fmaxf(ss, dpp_f<0x141>(ss)); ss = fmaxf(ss, dpp_f<0x140>(ss));
            if (lane == 0) F.KP_()[((layer * 8 + (row >> 12)) * 3 + ty) * 256 + (item & 31) * 8 + F.wave] = ss;
        }
    }
    asm volatile("s_waitcnt vmcnt(0)" ::: "memory");
    __syncthreads();
    const int lr = 16 + 16 * F.wave + tk;
    bf16x8 wfr[2][4]; f32x4 scv[4]; s16x4 gtv[4];
#define POOL_LOAD_W(GG) do { _Pragma("unroll") for (int ks = 0; ks < 2; ++ks) _Pragma("unroll") for (int dt = 0; dt < 4; ++dt) \
            wfr[ks][dt] = *(const GAS bf16x8*)(F.PWT_() + (size_t)(layer * 4 + (GG)) * 4096 + (size_t)(16 * dt + tk) * 64 + 32 * ks + 8 * G); \
        _Pragma("unroll") for (int dt = 0; dt < 4; ++dt) { const int dcol = (GG) * 64 + 16 * dt + 4 * G; scv[dt] = *(const GAS f32x4*)(P.pool_scale + (size_t)layer * 256 + dcol); gtv[dt] = *(const GAS s16x4*)(zr + ZGD + dcol); } } while (0)
    POOL_LOAD_W(0);
#pragma unroll
    for (int g = 0; g < (VAR == 3 ? 0 : 4); ++g) {
        const int win = 2 << g;
        const int cntw = (tpos + 1 < win) ? (tpos + 1) : win;
        const float invc = 1.0f / (float)cntw;
        f32x4 acc[4];
#pragma unroll
        for (int dt = 0; dt < 4; ++dt) acc[dt] = (f32x4){0.f, 0.f, 0.f, 0.f};
        u32x4 pwk[2];
#pragma unroll
        for (int ks = 0; ks < 2; ++ks) {
            const int c = g * 8 + 4 * ks + G;
            float sum[8], self[8];
            unpack8(*(const LAS bf16x8*)(dub + lr * 512 + ((c ^ (lr & 15)) << 4)), self);
#pragma unroll
            for (int e = 0; e < 8; ++e) sum[e] = self[e];
#pragma unroll
            for (int j = 1; j < win; ++j) { const bool in = (j <= tpos); const int rr = lr - (in ? j : 0); float f[8]; unpack8(*(const LAS bf16x8*)(dub + rr * 512 + ((c ^ (rr & 15)) << 4)), f); const float wgt = in ? 1.f : 0.f;
#pragma unroll
                for (int e = 0; e < 8; ++e) sum[e] = fmaf(wgt, f[e], sum[e]); }
#pragma unroll
            for (int e = 0; e < 4; ++e) pwk[ks][e] = cvtpk(sum[2 * e] * invc - self[2 * e], sum[2 * e + 1] * invc - self[2 * e + 1]);
        }
#pragma unroll
        for (int ks = 0; ks < 2; ++ks) {
            const bf16x8 pf = __builtin_bit_cast(bf16x8, pwk[ks]);
#pragma unroll
            for (int dt = 0; dt < 4; ++dt) acc[dt] = __builtin_amdgcn_mfma_f32_16x16x32_bf16(wfr[ks][dt], pf, acc[dt], 0, 0, 0);
        }
        u32x2 wo[4];
#pragma unroll
        for (int dt = 0; dt < 4; ++dt) {
            const f32x4 sc = scv[dt]; const s16x4 gt = gtv[dt];
            wo[dt][0] = cvtpk(acc[dt][0] * sc[0] * bf2f((unsigned short)gt[0]), acc[dt][1] * sc[1] * bf2f((unsigned short)gt[1]));
            wo[dt][1] = cvtpk(acc[dt][2] * sc[2] * bf2f((unsigned short)gt[2]), acc[dt][3] * sc[3] * bf2f((unsigned short)gt[3]));
        }
        if (g < 3) POOL_LOAD_W(g + 1);
#pragma unroll
        for (int dt = 0; dt < 4; ++dt) *(GAS u32x2*)(F.MIXED_() + (size_t)row * DM + 768 + g * 64 + 16 * dt + 4 * G) = wo[dt];
    }
#undef POOL_LOAD_W
    __syncthreads();
}

__device__ __forceinline__ int crow(int r, int hi) { return (r & 3) + 8 * (r >> 2) + 4 * hi; }
__device__ __forceinline__ s16x4 vtr(const LAS unsigned char* p) { return __builtin_bit_cast(s16x4, __builtin_amdgcn_ds_read_tr16_b64_v4i16((LAS s16x4*)p)); }

struct AttnCtx {
    int tid, lane, r32, hi, wave, qs, h;
    int b, qb, t;
    unsigned char* lds;
    int st_key, st_chunk;
    unsigned kwoff, vwoff;
    unsigned kroff[2];
    unsigned vbase;
    int vq;
};

__device__ __forceinline__ void attn_ctx_init(AttnCtx& A, Frame& F, int b, int qb) {
    int tid_ = F.tid_(); asm volatile("" : "+v"(tid_));
    A.tid = tid_; A.lane = tid_ & 63; A.r32 = A.lane & 31; A.hi = A.lane >> 5; A.wave = F.wave; A.qs = F.wave >> 2; A.h = F.wave & 3;
    A.b = b; A.qb = qb; A.t = qb * 64 + A.qs * 32 + A.r32; A.lds = F.lds;
    A.st_key = tid_ >> 3; A.st_chunk = tid_ & 7;
    A.kwoff = A.st_key * 128 + ((A.st_chunk ^ ((A.st_key >> 1) & 7)) << 4);
    A.vwoff = A.st_key * 128 + ((A.st_chunk ^ (((A.st_key >> 1) & 1) << 2)) << 4);
    const int i = A.lane & 15, q = i >> 2, p = i & 3, g1 = (A.lane >> 4) & 1;
    A.vq = (q >> 1) & 1;
    A.vbase = (4 * A.hi + q) * 128 + (2 * g1 + (p >> 1)) * 16 + (p & 1) * 8;
}

__device__ __forceinline__ void k_frags(const AttnCtx& A, const LAS unsigned char* kb, bf16x8 (&kf)[8]) {
    const int k0 = A.r32, k1 = 32 + A.r32;
#pragma unroll
    for (int ks = 0; ks < 4; ++ks) {
        kf[2 * ks + 0] = *(const LAS bf16x8*)(kb + k0 * 128 + (((2 * ks + A.hi) ^ ((k0 >> 1) & 7)) << 4));
        kf[2 * ks + 1] = *(const LAS bf16x8*)(kb + k1 * 128 + (((2 * ks + A.hi) ^ ((k1 >> 1) & 7)) << 4));
    }
}
__device__ __forceinline__ void qk_mma(const bf16x8 (&kf)[8], const bf16x8 (&qf)[4], f32x16& p0, f32x16& p1) {
    p0 = (f32x16){0.f}; p1 = (f32x16){0.f};
#pragma unroll
    for (int ks = 0; ks < 4; ++ks) {
        p0 = __builtin_amdgcn_mfma_f32_32x32x16_bf16(kf[2 * ks + 0], qf[ks], p0, 0, 0, 0);
        p1 = __builtin_amdgcn_mfma_f32_32x32x16_bf16(kf[2 * ks + 1], qf[ks], p1, 0, 0, 0);
    }
}
__device__ __forceinline__ void qk_tile(const AttnCtx& A, const LAS unsigned char* kb, const bf16x8 (&qf)[4], f32x16& p0, f32x16& p1) {
    bf16x8 kf[8]; k_frags(A, kb, kf); qk_mma(kf, qf, p0, p1);
}
__device__ __forceinline__ void v_frags(const AttnCtx& A, const LAS unsigned char* vb, bf16x8 (&vf)[8]) {
#pragma unroll
    for (int s = 0; s < 4; ++s)
#pragma unroll
        for (int dt = 0; dt < 2; ++dt) {
            const LAS unsigned char* base = vb + A.vbase + (16 * s) * 128 + ((dt ^ A.vq) * 64);
            const s16x4 lo = vtr(base), hi4 = vtr(base + 8 * 128);
            vf[2 * s + dt] = (bf16x8){lo[0], lo[1], lo[2], lo[3], hi4[0], hi4[1], hi4[2], hi4[3]};
        }
}
__device__ __forceinline__ void p_pack(const f32x16& p0, const f32x16& p1, bf16x8 (&pf)[4]) {
#pragma unroll
    for (int s = 0; s < 4; ++s) {
        const f32x16& pp = (s >> 1) ? p1 : p0; const int rb = 8 * (s & 1);
        u32x4 pw; pw[0] = cvtpk(pp[rb + 0], pp[rb + 1]); pw[1] = cvtpk(pp[rb + 2], pp[rb + 3]); pw[2] = cvtpk(pp[rb + 4], pp[rb + 5]); pw[3] = cvtpk(pp[rb + 6], pp[rb + 7]);
        pf[s] = __builtin_bit_cast(bf16x8, pw);
    }
}
__device__ __forceinline__ void pv_mma(const bf16x8 (&vf)[8], const bf16x8 (&pf)[4], f32x16& o0, f32x16& o1) {
#pragma unroll
    for (int s = 0; s < 4; ++s) {
        o0 = __builtin_amdgcn_mfma_f32_32x32x16_bf16(vf[2 * s + 0], pf[s], o0, 0, 0, 0);
        o1 = __builtin_amdgcn_mfma_f32_32x32x16_bf16(vf[2 * s + 1], pf[s], o1, 0, 0, 0);
    }
}
__device__ __forceinline__ void pv_tile(const AttnCtx& A, const LAS unsigned char* vb, const f32x16& p0, const f32x16& p1, f32x16& o0, f32x16& o1) {
    bf16x8 vf[8], pf[4]; v_frags(A, vb, vf); p_pack(p0, p1, pf); pv_mma(vf, pf, o0, o1);
}
__device__ __forceinline__ float max16(const f32x16& p) {
    float a = fmaxf(fmaxf(p[0], p[1]), fmaxf(p[2], p[3])), b = fmaxf(fmaxf(p[4], p[5]), fmaxf(p[6], p[7]));
    float c = fmaxf(fmaxf(p[8], p[9]), fmaxf(p[10], p[11])), d = fmaxf(fmaxf(p[12], p[13]), fmaxf(p[14], p[15]));
    return fmaxf(fmaxf(a, b), fmaxf(c, d));
}
__device__ __forceinline__ float sum16(const f32x16& p) {
    return (((p[0] + p[1]) + (p[2] + p[3])) + ((p[4] + p[5]) + (p[6] + p[7]))) + (((p[8] + p[9]) + (p[10] + p[11])) + ((p[12] + p[13]) + (p[14] + p[15])));
}

__device__ __forceinline__ float mask_bit(float p, unsigned w, int pos) {
    const unsigned mk = (unsigned)__builtin_amdgcn_sbfe((int)w, pos, 1);
    return __uint_as_float((__float_as_uint(p) & mk) | (0xff800000u & ~mk));
}
template <int MODE>
__device__ __forceinline__ void tile_mask(const AttnCtx& A, f32x16& p0, f32x16& p1, bool active, unsigned w0, unsigned w1, bool blk, int kt, int iq) {
    if (active) {
        if (MODE == 0) {
#pragma unroll
            for (int r = 0; r < 16; ++r) { const int cpos = (r & 3) + 8 * (r >> 2); p0[r] = mask_bit(p0[r], w0, cpos); p1[r] = mask_bit(p1[r], w1, cpos); }
        } else if (MODE == 1) {
            const bool diag = (kt == A.qb);
#pragma unroll
            for (int r = 0; r < 16; ++r) { const int kp = crow(r, A.hi);
                p0[r] = (blk && (!diag || kp <= iq)) ? p0[r] : -INFINITY; p1[r] = (blk && (!diag || (kp + 32) <= iq)) ? p1[r] : -INFINITY; }
        } else {
            const bool diag = (kt == A.qb), tail = (kt == A.qb - 8);
            if (diag || tail) {
#pragma unroll
                for (int r = 0; r < 16; ++r) { const int kp = crow(r, A.hi);
                    const bool v0 = diag ? (kp <= iq) : (kp > iq), v1 = diag ? ((kp + 32) <= iq) : ((kp + 32) > iq);
                    p0[r] = v0 ? p0[r] : -INFINITY; p1[r] = v1 ? p1[r] : -INFINITY; }
            }
        }
    } else {
#pragma unroll
        for (int r = 0; r < 16; ++r) { p0[r] = -INFINITY; p1[r] = -INFINITY; }
    }
}

__device__ __forceinline__ void qk_mma_c(const bf16x8 (&kf)[8], const bf16x8 (&qf)[4], const f32x16& c0, const f32x16& c1, f32x16& p0, f32x16& p1) {
    p0 = __builtin_amdgcn_mfma_f32_32x32x16_bf16(kf[0], qf[0], c0, 0, 0, 0);
    p1 = __builtin_amdgcn_mfma_f32_32x32x16_bf16(kf[1], qf[0], c1, 0, 0, 0);
#pragma unroll
    for (int ks = 1; ks < 4; ++ks) {
        p0 = __builtin_amdgcn_mfma_f32_32x32x16_bf16(kf[2 * ks + 0], qf[ks], p0, 0, 0, 0);
        p1 = __builtin_amdgcn_mfma_f32_32x32x16_bf16(kf[2 * ks + 1], qf[ks], p1, 0, 0, 0);
    }
}
__device__ __forceinline__ float init_bit(float negref, unsigned w, int pos) {
    const unsigned mk = (unsigned)__builtin_amdgcn_sbfe((int)w, pos, 1);
    return __uint_as_float((__float_as_uint(negref) & mk) | (0xff800000u & ~mk));
}
__device__ __forceinline__ float q_norm2(const AttnCtx& A, const bf16x8 (&qf)[4]) {
    float ss = 0.f;
#pragma unroll
    for (int ks = 0; ks < 4; ++ks) { float f[8]; unpack8(qf[ks], f);
#pragma unroll
        for (int e = 0; e < 8; ++e) ss = fmaf(f[e], f[e], ss); }
    return sum32x_f(ss);
}

template <int MODE>
__device__ __forceinline__ void attn_stream(const AttnCtx& A, const bf16_t* Kg, const bf16_t* Vg, int kt0, int kt1, const bf16x8 (&qf)[4], float negref,
                                            f32x16& o0, f32x16& o1, float& lsum, const unsigned* mrow, unsigned long long bm) {
    LAS unsigned char* kbuf = (LAS unsigned char*)A.lds + L_K; LAS unsigned char* vbuf = (LAS unsigned char*)A.lds + L_V;
    LAS unsigned char* mbuf = (LAS unsigned char*)A.lds + L_IMP;
    const int iq = A.qs * 32 + A.r32;
    const int nsteps = (kt1 - kt0 + 2) >> 1;
    const int dkey = 8 * A.wave + (A.lane >> 3), dpc = A.lane & 7;
    const bf16_t* kgl = Kg + (size_t)dkey * NZ + 8 * (dpc ^ ((dkey >> 1) & 7));
    const bf16_t* vgl = Vg + (size_t)dkey * NZ + 8 * (dpc ^ (((dkey >> 1) & 1) << 2));
    const int wofs = A.wave * 1024;
    if (__builtin_amdgcn_readfirstlane(A.wave) >= 4) __builtin_amdgcn_s_setprio(1);
#define ATTN_DMA(STEP) do { const int ka_ = kt0 + 2 * (STEP), kb2_ = ka_ + 1; const int bo_ = ((STEP) & 1) * 16384 + wofs; \
        __builtin_amdgcn_global_load_lds((const unsigned*)(kgl + (size_t)ka_ * 64 * NZ), (LAS unsigned*)(kbuf + bo_), 16, 0, 0); \
        __builtin_amdgcn_global_load_lds((const unsigned*)(vgl + (size_t)ka_ * 64 * NZ), (LAS unsigned*)(vbuf + bo_), 16, 0, 0); \
        { const int kb3_ = kb2_ <= kt1 ? kb2_ : ka_;        \
            __builtin_amdgcn_global_load_lds((const unsigned*)(kgl + (size_t)kb3_ * 64 * NZ), (LAS unsigned*)(kbuf + bo_ + 8192), 16, 0, 0); \
            __builtin_amdgcn_global_load_lds((const unsigned*)(vgl + (size_t)kb3_ * 64 * NZ), (LAS unsigned*)(vbuf + bo_ + 8192), 16, 0, 0); } \
        if (MODE == 0) __builtin_amdgcn_global_load_lds((const unsigned*)(mrow + 2 * ka_), (LAS unsigned*)(mbuf + ((STEP) & 1) * 8192 + wofs), 16, 0, 0); \
    } while (0)
    ATTN_DMA(0);
    for (int s = 0; s < nsteps; ++s) {
        __syncthreads();
        if (s + 1 < nsteps) ATTN_DMA(s + 1);
        const int ktA = kt0 + 2 * s, ktB = ktA + 1; const bool haveB = ktB <= kt1;
        u32x2 cwA = (u32x2){0u, 0u}, cwB = (u32x2){0u, 0u};
        if (MODE == 0) { const u32x4 mw = *(const LAS u32x4*)(mbuf + (s & 1) * 8192 + wofs + 16 * A.lane); cwA[0] = mw[0]; cwA[1] = mw[1]; cwB[0] = haveB ? mw[2] : 0u; cwB[1] = haveB ? mw[3] : 0u; }
        const LAS unsigned char* kb = kbuf + (s & 1) * 16384; const LAS unsigned char* vb = vbuf + (s & 1) * 16384;
        bool blkA = true, blkB = haveB;
        if (MODE == 1) { blkA = (bm >> ktA) & 1ull; blkB = haveB && ((bm >> ktB) & 1ull); }
#define ATTN_CINIT(C0, C1, W0, W1, BLK) do { \
            if (MODE == 0) { _Pragma("unroll") for (int r = 0; r < 16; ++r) { const int cpos = (r & 3) + 8 * (r >> 2); C0[r] = init_bit(negref, (W0), cpos); C1[r] = init_bit(negref, (W1), cpos); } } \
            else { const float base = (BLK) ? negref : -INFINITY; _Pragma("unroll") for (int r = 0; r < 16; ++r) { C0[r] = base; C1[r] = base; } } } while (0)
#define ATTN_SOFT(P0, P1, PF, KT) do { \
            if (MODE == 1) { if ((KT) == A.qb) { _Pragma("unroll") for (int r = 0; r < 16; ++r) { const int kp = crow(r, A.hi); P0[r] = (kp <= iq) ? P0[r] : -INFINITY; P1[r] = ((kp + 32) <= iq) ? P1[r] : -INFINITY; } } } \
            if (MODE == 2) { const bool diag = ((KT) == A.qb), tail = ((KT) == A.qb - 8); if (diag || tail) { _Pragma("unroll") for (int r = 0; r < 16; ++r) { const int kp = crow(r, A.hi); \
                const bool v0 = diag ? (kp <= iq) : (kp > iq), v1 = diag ? ((kp + 32) <= iq) : ((kp + 32) > iq); P0[r] = v0 ? P0[r] : -INFINITY; P1[r] = v1 ? P1[r] : -INFINITY; } } } \
            _Pragma("unroll") for (int r = 0; r < 16; ++r) { P0[r] = fast_exp2(P0[r]); P1[r] = fast_exp2(P1[r]); } \
            lsum += sum16(P0) + sum16(P1); \
            p_pack(P0, P1, PF); } while (0)
        bf16x8 kf[8]; k_frags(A, kb, kf);
        f32x16 pA0, pA1; ATTN_CINIT(pA0, pA1, cwA[0] >> (4 * A.hi), cwA[1] >> (4 * A.hi), blkA);
        __builtin_amdgcn_sched_barrier(0);
        qk_mma_c(kf, qf, pA0, pA1, pA0, pA1);
        f32x16 pB0, pB1; ATTN_CINIT(pB0, pB1, cwB[0] >> (4 * A.hi), cwB[1] >> (4 * A.hi), blkB);
        __builtin_amdgcn_sched_barrier(0);
        k_frags(A, kb + 8192, kf);
        qk_mma_c(kf, qf, pB0, pB1, pB0, pB1);
        bf16x8 pfA[4]; ATTN_SOFT(pA0, pA1, pfA, ktA);
        __builtin_amdgcn_sched_barrier(0);
        bf16x8 vf[8]; v_frags(A, vb, vf);
        pv_mma(vf, pfA, o0, o1);
        bf16x8 pfB[4]; ATTN_SOFT(pB0, pB1, pfB, ktB);
        __builtin_amdgcn_sched_barrier(0);
        v_frags(A, vb + 8192, vf);
        pv_mma(vf, pfB, o0, o1);
#undef ATTN_SOFT
#undef ATTN_CINIT
    }
#undef ATTN_DMA
    __builtin_amdgcn_s_setprio(0);
    __syncthreads();
}

__device__ __forceinline__ void load_q(const AttnCtx& A, const bf16_t* Zq  , bf16x8 (&qf)[4]) {
    const bf16_t* qp = Zq + ((size_t)A.b * SEQ + A.t) * NZ + 64 * A.h + 8 * A.hi;
#pragma unroll
    for (int ks = 0; ks < 4; ++ks) qf[ks] = *(const GAS bf16x8*)(qp + 16 * ks);
}
__device__ __forceinline__ void store_out(const AttnCtx& A, Frame& F, const f32x16& o0, const f32x16& o1, int zgate, int colbase) {
    const size_t row = (size_t)A.b * SEQ + A.t;
#pragma unroll
    for (int dt = 0; dt < 2; ++dt)
#pragma unroll
        for (int k = 0; k < 4; ++k) {
            const int d = 32 * dt + 8 * k + 4 * A.hi;
            const s16x4 gt = *(const GAS s16x4*)(F.Z_() + row * NZ + zgate + 64 * A.h + d);
            const f32x16& o = dt ? o1 : o0;
            u32x2 w; w[0] = cvtpk(o[4 * k + 0] * bf2f((unsigned short)gt[0]), o[4 * k + 1] * bf2f((unsigned short)gt[1]));
            w[1] = cvtpk(o[4 * k + 2] * bf2f((unsigned short)gt[2]), o[4 * k + 3] * bf2f((unsigned short)gt[3]));
            *(GAS u32x2*)(F.MIXED_() + row * DM + colbase + 64 * A.h + d) = w;
        }
}

__device__ __forceinline__ float kmax_load(Frame& F, int layer, int b, int ty, int lane) {
    const f32x4 v = *(const GAS f32x4*)(F.KP_() + ((layer * 8 + b) * 3 + ty) * 256 + 4 * lane);
    float m = fmaxf(fmaxf(v[0], v[1]), fmaxf(v[2], v[3]));
    m = fmaxf(m, dpp_f<0xB1>(m)); m = fmaxf(m, dpp_f<0x4E>(m)); m = fmaxf(m, dpp_f<0x141>(m)); m = fmaxf(m, dpp_f<0x140>(m));
    return max32x_f(max16x_f(m));
}
__device__ __forceinline__ void dsa_attn_item(Frame& F, int layer, int b, int qb) {
    AttnCtx A; attn_ctx_init(A, F, b, qb);
    bf16x8 qf[4]; load_q(A, F.Z_() + ZQA, qf);
    const float kmx = kmax_load(F, layer, b, 0, A.lane);
    const float negref = -sqrtf(q_norm2(A, qf) * kmx);
    f32x16 o0 = (f32x16){0.f}, o1 = (f32x16){0.f}; float ol = 0.f;
    const unsigned* mrow = F.MASK_() + ((size_t)b * SEQ + A.t) * 128;
    attn_stream<0>(A, F.Z_() + (size_t)b * SEQ * NZ + ZKA, F.Z_() + (size_t)b * SEQ * NZ + ZVA, 0, qb, qf, negref, o0, o1, ol, mrow, 0ull);
    const float l = sum32x_f(ol);
    const float il = l > 0.f ? 1.0f / l : 0.f;
#pragma unroll
    for (int r = 0; r < 16; ++r) { o0[r] *= il; o1[r] *= il; }
    store_out(A, F, o0, o1, ZGA, 0);
}

__device__ __forceinline__ void nsa_item(Frame& F, int layer, int b, int qb) {
    AttnCtx A; attn_ctx_init(A, F, b, qb);
    bf16x8 qf[4]; load_q(A, F.Z_() + ZQB, qf);
    const size_t row = (size_t)b * SEQ + A.t;
    const float g_c = F.BGF_()[row * 16 + 3 * A.h + 0], g_s = F.BGF_()[row * 16 + 3 * A.h + 1], g_w = F.BGF_()[row * 16 + 3 * A.h + 2];
    f32x16 out0 = (f32x16){0.f}, out1 = (f32x16){0.f};
    LAS unsigned char* kbuf = (LAS unsigned char*)F.lds + L_K; LAS unsigned char* vbuf = (LAS unsigned char*)F.lds + L_V;
    float* impw = (float*)(F.lds + L_IMP);
    {
        const bf16_t* kc = F.KCMP_() + (size_t)b * 256 * 64; const bf16_t* vc = F.VCMP_() + (size_t)b * 256 * 64;
#pragma unroll
        for (int i = 0; i < 4; ++i) {
            const int key = 64 * i + A.st_key;
            const u32x4 kr = *(const GAS u32x4*)(kc + (size_t)key * 64 + 8 * A.st_chunk), vr = *(const GAS u32x4*)(vc + (size_t)key * 64 + 8 * A.st_chunk);
            *(LAS u32x4*)(kbuf + i * 8192 + A.kwoff) = kr; *(LAS u32x4*)(vbuf + i * 8192 + A.vwoff) = vr;
        }
        __syncthreads();
        const int nmax = (qb * 64 + 63 - 31) >> 4;
        const int ntile = (nmax >> 6) + 1;
        float mx = -1e30f, lsum = 0.f;
        for (int i = 0; i < ntile; ++i) {
            f32x16 p0, p1;
            qk_tile(A, kbuf + i * 8192, qf, p0, p1);
#pragma unroll
            for (int r = 0; r < 16; ++r) { const int n0 = 64 * i + crow(r, A.hi), n1 = n0 + 32;
                p0[r] = (16 * n0 + 31 <= A.t) ? p0[r] : -INFINITY; p1[r] = (16 * n1 + 31 <= A.t) ? p1[r] : -INFINITY; }
            float tm = fmaxf(max16(p0), max16(p1)); tm = fmaxf(tm, xhalf(tm));
            const float mn = fmaxf(mx, tm), alpha = fast_exp2(mx - mn);
#pragma unroll
            for (int r = 0; r < 16; ++r) { p0[r] = fast_exp2(p0[r] - mn); p1[r] = fast_exp2(p1[r] - mn); }
            float rs = sum16(p0) + sum16(p1); rs += xhalf(rs);
            lsum = lsum * alpha + rs; mx = mn;
        }
        const float il = lsum > 0.f ? 1.0f / lsum : 0.f;
        float* ip = impw + ((size_t)A.h * 64 + (A.qs * 32 + A.r32)) * 64;
        float prev_other = 0.f;
        for (int i = 0; i < 4; ++i) {
            if (i < ntile) {
                f32x16 p0, p1;
                qk_tile(A, kbuf + i * 8192, qf, p0, p1);
#pragma unroll
                for (int r = 0; r < 16; ++r) { const int n0 = 64 * i + crow(r, A.hi), n1 = n0 + 32;
                    p0[r] = (16 * n0 + 31 <= A.t) ? fast_exp2(p0[r] - mx) * il : 0.f; p1[r] = (16 * n1 + 31 <= A.t) ? fast_exp2(p1[r] - mx) * il : 0.f; }
#pragma unroll
                for (int rt = 0; rt < 2; ++rt)
#pragma unroll
                    for (int k = 0; k < 4; ++k) {
                        const f32x16& pp = rt ? p1 : p0;
                        const float gs = (pp[4 * k] + pp[4 * k + 1]) + (pp[4 * k + 2] + pp[4 * k + 3]);
                        const float other = xhalf(pp[4 * k + 3]);
                        ip[16 * i + 8 * rt + 2 * k + A.hi] = gs + (A.hi ? other : prev_other);
                        prev_other = other;
                    }
                pv_tile(A, vbuf + i * 8192, p0, p1, out0, out1);
            } else {
#pragma unroll
                for (int j = 0; j < 8; ++j) ip[16 * i + 2 * j + A.hi] = 0.f;
            }
        }
#pragma unroll
        for (int r = 0; r < 16; ++r) { out0[r] *= g_c; out1[r] *= g_c; }
    }
    __syncthreads();
    {
        unsigned long long* bmp = (unsigned long long*)(F.lds + L_BM);
        for (int qg4 = 0; qg4 < 1; ++qg4) {
            const int j = A.lane;
            unsigned key[8], T[8];
#pragma unroll
            for (int k = 0; k < 8; ++k) {
                const int q = F.wave * 8 + k;
                float v = ((impw[(0 * 64 + q) * 64 + j] + impw[(1 * 64 + q) * 64 + j]) + impw[(2 * 64 + q) * 64 + j]) + impw[(3 * 64 + q) * 64 + j];
                if (j == 0 || j == qb) v = INFINITY; else if (j > qb) v = -INFINITY;
                const unsigned bits = __float_as_uint(v);
                key[k] = (bits & 0x80000000u) ? ~bits : (bits | 0x80000000u);
                T[k] = 0u;
            }
#pragma unroll 4
            for (int bit = 31; bit >= 0; --bit) {
#pragma unroll
                for (int k = 0; k < 8; ++k) {
                    const unsigned cand = T[k] | (1u << bit);
                    const int cnt = __popcll(__ballot(key[k] >= cand));
                    T[k] = (cnt >= 16) ? cand : T[k];
                }
            }
#pragma unroll
            for (int k = 0; k < 8; ++k) {
                const int q = F.wave * 8 + k;
                const unsigned long long gtm = __ballot(key[k] > T[k]), eqm = __ballot(key[k] == T[k]);
                const int need = 16 - __popcll(gtm);
                const int below = __popcll(eqm & ((1ull << j) - 1ull));
                const unsigned long long sel = __ballot((j <= qb) && ((key[k] > T[k]) || ((key[k] == T[k]) && below < need)));
                if (A.lane == 0) bmp[q] = sel;
            }
        }
    }
    __syncthreads();
    const unsigned long long bm = ((const unsigned long long*)(F.lds + L_BM))[A.qs * 32 + A.r32];
    LAS float* ow = (LAS float*)((LAS unsigned char*)F.lds + L_IMP) + F.wave * 2048 + A.lane;
#pragma unroll
    for (int r = 0; r < 16; ++r) { ow[r * 64] = out0[r]; ow[(16 + r) * 64] = out1[r]; }
    const float qn2 = q_norm2(A, qf);
    const float kmx_s = kmax_load(F, layer, b, 1, A.lane), kmx_w = kmax_load(F, layer, b, 2, A.lane);
    {
        f32x16 o0 = (f32x16){0.f}, o1 = (f32x16){0.f}; float ol = 0.f;
        const float negref = -sqrtf(qn2 * kmx_s);
        attn_stream<1>(A, F.Z_() + (size_t)b * SEQ * NZ + ZKS, F.Z_() + (size_t)b * SEQ * NZ + ZVS, 0, qb, qf, negref, o0, o1, ol, nullptr, bm);
        const float l = sum32x_f(ol);
        const float sc = (l > 0.f ? 1.0f / l : 0.f) * g_s;
#pragma unroll
        for (int r = 0; r < 16; ++r) { ow[r * 64] += o0[r] * sc; ow[(16 + r) * 64] += o1[r] * sc; }
    }
    {
        f32x16 o0 = (f32x16){0.f}, o1 = (f32x16){0.f}; float ol = 0.f;
        const float negref = -sqrtf(qn2 * kmx_w);
        const int k0 = qb - 8 < 0 ? 0 : qb - 8;
        attn_stream<2>(A, F.Z_() + (size_t)b * SEQ * NZ + ZKW, F.Z_() + (size_t)b * SEQ * NZ + ZVW, k0, qb, qf, negref, o0, o1, ol, nullptr, 0ull);
        const float l = sum32x_f(ol);
        const float sc = (l > 0.f ? 1.0f / l : 0.f) * g_w;
#pragma unroll
        for (int r = 0; r < 16; ++r) { o0[r] = ow[r * 64] + o0[r] * sc; o1[r] = ow[(16 + r) * 64] + o1[r] * sc; }
        store_out(A, F, o0, o1, ZGB, 256);
    }
}

__device__ __forceinline__ void zero_item(Frame& F, int b, int qb, int colbase) {
    const int tid = F.tid_();
    for (int i = tid; i < 64 * 32; i += 512) { const int r = i >> 5, c = i & 31;
        *(GAS u32x4*)(F.MIXED_() + ((size_t)b * SEQ + qb * 64 + r) * DM + colbase + 8 * c) = (u32x4){0u, 0u, 0u, 0u}; }
}

__device__ __forceinline__ void phase_final(Frame& F, const Params& P) {
    const int gw = blockIdx.x * 8 + F.wave, NGW = F.G * 8;
#ifdef ABL_DUMP
    for (int row = gw; row < MROWS; row += NGW) {
        for (int c = F.lane_(); c < DM; c += 64) P.out[(size_t)row * DM + c] = bf2f(F.Z_()[(size_t)row * NZ + ABL_DUMP + (c & 255)]);
    }
    return;
#endif
    for (int row = gw; row < MROWS; row += NGW) {
        const f32x4 a = *(const GAS f32x4*)(F.RS_() + (size_t)row * 4);
        const float ss = (a[0] + a[1]) + (a[2] + a[3]);
        const float rr = 1.0f / sqrtf(ss * (1.0f / 1024.0f) + 1e-6f);
        const u32x2* xb = (const u32x2*)(F.XB_() + (size_t)row * DM) + F.lane_();
        f32x4* xo = (f32x4*)(P.out + (size_t)row * DM) + F.lane_();
        const f32x4* gw4 = (const f32x4*)P.final_norm_w + F.lane_();
#pragma unroll
        for (int j = 0; j < 4; ++j) { const u32x2 w = xb[64 * j]; const f32x4 g = gw4[64 * j];
            xo[64 * j] = (f32x4){__uint_as_float(w[0] << 16) * rr * g[0], __uint_as_float(w[0] & 0xffff0000u) * rr * g[1], __uint_as_float(w[1] << 16) * rr * g[2], __uint_as_float(w[1] & 0xffff0000u) * rr * g[3]}; }
    }
}

#define XB_TMO      128
#define XB_XCNT(j)  (256  + 64 * (j))
#define XB_XSUB(j)  (1280 + 64 * (j))
#define XB_XGEN(j)  (2304 + 64 * (j))
#define XB_TOP      3328
#define XB_TOPGEN   3392
#define XCD_BAR_WORDS 3456
#define XB_SPIN_CAP (1u << 18)

__device__ __forceinline__ unsigned xb_ld(unsigned* p)              { return __hip_atomic_load(p, __ATOMIC_RELAXED, __HIP_MEMORY_SCOPE_AGENT); }
__device__ __forceinline__ unsigned xb_add(unsigned* p, unsigned v) { return __hip_atomic_fetch_add(p, v, __ATOMIC_RELAXED, __HIP_MEMORY_SCOPE_AGENT); }
__device__ __forceinline__ unsigned xb_xcc_id() { return (unsigned)__builtin_amdgcn_s_getreg((3 << 11) | 20) & 0xFu; }
#define XB_SPIN(cond, bar) do { unsigned _sp = 0; while (cond) { __builtin_amdgcn_s_sleep(1); \
    if ((++_sp & 255u) == 0u) { if (xb_ld(&(bar)[XB_TMO])) break; if (_sp > XB_SPIN_CAP) { atomicAdd(&(bar)[XB_TMO], 1u); break; } } } } while (0)

struct XcdBarrier {
    unsigned* bar; unsigned x;
    volatile LAS unsigned* st;
};

__device__ __forceinline__ XcdBarrier xcd_barrier_post(unsigned* bar, volatile LAS unsigned* st) {
    XcdBarrier b; b.bar = bar; b.x = xb_xcc_id(); b.st = st;
    if (threadIdx.x == 0) (void)xb_add(&bar[XB_XCNT(b.x)], 1u);
    return b;
}
__device__ __forceinline__ void xcd_barrier_complete(unsigned* bar, unsigned x, unsigned& nloc, unsigned& nx) {
    const unsigned G = gridDim.x * gridDim.y * gridDim.z;
    unsigned sum, cnt, mine, sp = 0u;
    for (;;) {
        sum = 0u; cnt = 0u; mine = 0u;
#pragma unroll
        for (unsigned j = 0; j < 16; ++j) { const unsigned c = xb_ld(&bar[XB_XCNT(j)]); sum += c; cnt += (c > 0u) ? 1u : 0u; mine = (j == x) ? c : mine; }
        if (sum == G) break;
        __builtin_amdgcn_s_sleep(1);
        if ((++sp & 255u) == 0u) { if (xb_ld(&bar[XB_TMO])) break; if (sp > XB_SPIN_CAP) { atomicAdd(&bar[XB_TMO], 1u); break; } }
    }
    nloc = mine > 0u ? mine : 1u; nx = cnt > 0u ? cnt : 1u;
}

__device__ __forceinline__ void xcd_barrier(const XcdBarrier& b) {
    asm volatile("s_waitcnt vmcnt(0)" ::: "memory");
    __syncthreads();
    if (threadIdx.x == 0) {
        unsigned* bar = b.bar;
        __builtin_amdgcn_s_waitcnt(0);
        unsigned nloc = b.st[0], nx = b.st[1];
        if (nloc == 0u) { xcd_barrier_complete(bar, b.x, nloc, nx); b.st[0] = nloc; b.st[1] = nx; }
        const unsigned old = xb_add(&bar[XB_XSUB(b.x)], 1u);
        const unsigned gen = old / nloc;
        if (old + 1u == (gen + 1u) * nloc) {
            __builtin_amdgcn_fence(__ATOMIC_RELEASE, "agent");
            asm volatile("s_waitcnt vmcnt(0)" ::: "memory");
            const unsigned og = xb_add(&bar[XB_TOP], 1u);
            const unsigned tg = og / nx;
            if (og + 1u == (tg + 1u) * nx) xb_add(&bar[XB_TOPGEN], 1u);
            else XB_SPIN(xb_ld(&bar[XB_TOPGEN]) == tg, bar);
            __builtin_amdgcn_fence(__ATOMIC_ACQUIRE, "agent");
            xb_add(&bar[XB_XGEN(b.x)], 1u);
            asm volatile("s_waitcnt vmcnt(0)" ::: "memory");
        } else {
            XB_SPIN(xb_ld(&bar[XB_XGEN(b.x)]) == gen, bar);
            __builtin_amdgcn_fence(__ATOMIC_ACQUIRE, "agent");
            asm volatile("s_waitcnt vmcnt(0)" ::: "memory");
        }
    }
    __syncthreads();
}

template <int SUB>
__device__ __forceinline__ void run_phase(Frame& F, const Params& Q, int layer, unsigned char* lds) {
        constexpr int sub = SUB;
        if (sub == 0) {
            pg8::Gemm g{F.XB_(), F.WIT_() + (size_t)layer * NZ * DM, MROWS, NZ, DM};
            pg8::StaticOrder S; S.init(MROWS, NZ, F.G, (int)blockIdx.x);
            EpiIn E{F.Z_(), F.RS_(), F.CS_(), F.WIF_(), F.BGF_(), lds};
            pg8::gemm_phase<EpiIn, pg8::StaticOrder, true, true>((PG8_LAS unsigned char*)lds, g, S, E, F.wave);
#if defined(PROBE_DUP) && PROBE_DUP == 1
            __syncthreads();
            pg8::gemm_phase<EpiIn, pg8::StaticOrder, true, true>((PG8_LAS unsigned char*)lds, g, S, E, F.wave);
#endif
        } else if (sub == 1) {
            const int qbase = 32 * layer;
            for (int it = (int)blockIdx.x; it < 256; it += F.G) { compress_item(F, Q, layer, it); __syncthreads(); }
            for (int it = (int)blockIdx.x; it < 256; it += F.G) convpool_item<0>(F, Q, layer, it);
#ifndef ABL_NO_A
            { int b, it; while (next_item_batch(F, qbase + 8, 128, b, it)) {
_Pragma("nounroll")
                for (int k = 0; k < 2; ++k) { select_item(F, b, 255 - 2 * it - k); __syncthreads(); } } }
#endif
#if defined(PROBE_DUP) && PROBE_DUP == 7
            __syncthreads();
            for (;;) { const int it = next_item(F, qbase + 2); if (it >= 256) break; compress_item(F, Q, layer, it); }
            { int b, it; while (next_item_batch(F, qbase + 24, 256, b, it)) select_item(F, b, 255 - it); }
            for (;;) { const int it = next_item(F, qbase + 3); if (it >= 256) break; convpool_item<0>(F, Q, layer, it); }
#endif
#if defined(PROBE_DUP) && PROBE_DUP == 12
            { int b, it; while (next_item_batch(F, qbase + 24, 256, b, it)) select_item(F, b, 255 - it); }
#endif
#if defined(PROBE_DUP) && PROBE_DUP == 2
            { int b, it; while (next_item_batch(F, qbase + 24, 256, b, it)) select_item(F, b, 255 - it); }
#endif
#if defined(PROBE_DUP) && PROBE_DUP == 3
            for (;;) { const int it = next_item(F, qbase + 2); if (it >= 256) break; compress_item(F, Q, layer, it); }
#endif
#if defined(PROBE_DUP) && PROBE_DUP == 13
            { int acc_ = 0; for (int k = 0; k < 16; ++k) acc_ += next_item(F, qbase + 24 + (k & 7)); if (acc_ == 0x7fffffff) F.KMAX_()[127] = 1u; }
#endif
#if defined(PROBE_DUP) && PROBE_DUP == 11
            for (;;) { const int it = next_item(F, qbase + 3); if (it >= 256) break; convpool_item<PROBE_VAR>(F, Q, layer, it); }
#endif
        } else if (sub == 2) {
            const int qbase = 32 * layer;
            { int b, it;
              while (next_item_batch(F, qbase + 16, 128, b, it)) {
                const int qb = 63 - (it >> 1);
                if ((it & 1) == 0) nsa_item(F, layer, b, qb); else dsa_attn_item(F, layer, b, qb);
              } }
#if defined(PROBE_DUP) && (PROBE_DUP == 4 || PROBE_DUP == 5)
            __syncthreads();
            { int b, it;
              while (next_item_batch(F, qbase + 24, 64, b, it)) {
                const int qb = 63 - it;
                if (PROBE_DUP == 5) nsa_item(F, layer, b, qb); else dsa_attn_item(F, layer, b, qb);
              } }
#endif
#if defined(PROBE_DUP) && PROBE_DUP == 6
            __syncthreads();
            { int b, it;
              while (next_item_batch(F, qbase + 24, 128, b, it)) {
                const int qb = 63 - (it >> 1);
                if ((it & 1) == 0) nsa_item(F, layer, b, qb); else dsa_attn_item(F, layer, b, qb);
              } }
#endif
        } else {
            pg8::Gemm g{F.MIXED_(), F.WOT_() + (size_t)layer * DM * DM, MROWS, DM, DM};
            pg8::StaticOrder S; S.init(MROWS, DM, F.G, (int)blockIdx.x);
            EpiOut E{F.XB_(), F.RS_(), lds};
            pg8::gemm_phase<EpiOut, pg8::StaticOrder, true, true>((PG8_LAS unsigned char*)lds, g, S, E, F.wave);
#if defined(PROBE_DUP) && PROBE_DUP == 8
            __syncthreads();
            EpiOut E2{F.Z_() + (size_t)64 * 1024 * 1024, F.BGF_(), lds};
            pg8::gemm_phase<EpiOut, pg8::StaticOrder, true, true>((PG8_LAS unsigned char*)lds, g, S, E2, F.wave);
#endif
        }
}

template <bool COOP>
__global__ void __launch_bounds__(512, 2) fwd_kernel(Params P) {
    extern __shared__ __attribute__((aligned(16))) unsigned char lds[];
    Frame F;
    F.lds = lds; F.wave = __builtin_amdgcn_readfirstlane((int)(threadIdx.x >> 6)); F.G = gridDim.x;
    F.ws = P.ws;
    XcdBarrier bar; bar.bar = nullptr; bar.x = 0; bar.st = nullptr;
    if (COOP) {
        volatile LAS unsigned* misc = (volatile LAS unsigned*)((LAS unsigned char*)lds + MISC_OFF);
        if (threadIdx.x < 64) misc[threadIdx.x] = 0u;
        { unsigned* c = F.ctl_(); for (int i = (int)blockIdx.x * 512 + (int)threadIdx.x; i < (int)(CTL_BYTES / 4); i += (int)gridDim.x * 512) c[i] = 0u; }
        __syncthreads();
    }
#define GRID_SYNC() do { if (COOP) { xcd_barrier(bar); } } while (0)
#if defined(PROBE_DUP) && PROBE_DUP == 14
#define PROBE_XSYNC GRID_SYNC()
#else
#define PROBE_XSYNC (void)0
#endif

    if (COOP) {
        phase_prologue(F, P);
#if defined(PROBE_DUP) && PROBE_DUP == 9
        __syncthreads(); phase_prologue(F, P);
#endif
        cg::this_grid().sync();
        bar = xcd_barrier_post(F.ctl_() + 12288, (volatile LAS unsigned*)((LAS unsigned char*)lds + MISC_OFF) + 8);
#define RUN_PHASE(LAYER, SUB) do { Params Q = P; \
            asm volatile("" : "+s"(Q.x), "+s"(Q.norm_w), "+s"(Q.conv_w), "+s"(Q.pe_cmp), "+s"(Q.pool_scale), "+s"(Q.out), "+s"(Q.ws)); F.ws = Q.ws; \
            run_phase<SUB>(F, Q, LAYER, lds); GRID_SYNC(); PROBE_XSYNC; } while (0)
#define RUN_LAYER(LAYER) do { RUN_PHASE(LAYER, 0); RUN_PHASE(LAYER, 1); RUN_PHASE(LAYER, 2); RUN_PHASE(LAYER, 3); } while (0)
        RUN_LAYER(0); RUN_LAYER(1); RUN_LAYER(2); RUN_LAYER(3);
#undef RUN_LAYER
#undef RUN_PHASE
        phase_final(F, P);
    } else {
        int ph = P.ph_lo;
        if (ph == 0) { phase_prologue(F, P); ++ph; }
        for (; ph < P.ph_hi && ph < NPHASE - 1; ++ph) {
            int ph_ = ph; asm volatile("" : "+s"(ph_));
            Params Q = P;
            asm volatile("" : "+s"(Q.x), "+s"(Q.norm_w), "+s"(Q.conv_w), "+s"(Q.pe_cmp), "+s"(Q.pool_scale), "+s"(Q.out), "+s"(Q.ws));
            F.ws = Q.ws;
            const int layer = (ph_ - 1) >> 2, sub = (ph_ - 1) & 3;
            if (sub == 0) run_phase<0>(F, Q, layer, lds); else if (sub == 1) run_phase<1>(F, Q, layer, lds); else if (sub == 2) run_phase<2>(F, Q, layer, lds); else run_phase<3>(F, Q, layer, lds);
        }
        if (ph == NPHASE - 1 && ph < P.ph_hi) phase_final(F, P);
    }
}

#ifndef N_LAUNCH_MODE
#define N_LAUNCH_MODE 0
#endif
#if N_LAUNCH_MODE == 0
template __global__ void fwd_kernel<true>(Params);
#else
template __global__ void fwd_kernel<false>(Params);
#endif
extern "C" void kernel_launch(void* const* d_in, const int* in_sizes, int n_in, void* d_out, int out_size, void* d_ws, size_t ws_size, hipStream_t stream) {
    static int grid = 0;
    if (grid == 0) {
        if (n_in != 11 || out_size != MROWS * DM || ws_size < WS_END) { fprintf(stderr, "kernel_launch: unexpected shapes (n_in %d out %d ws %zu)\n", n_in, out_size, ws_size); grid = -1; return; }
        int dev = 0, cus = 0, per_cu = 0;
        hipGetDevice(&dev); hipDeviceGetAttribute(&cus, hipDeviceAttributeMultiprocessorCount, dev);
#if N_LAUNCH_MODE == 0
#define FWD_K fwd_kernel<true>
#else
#define FWD_K fwd_kernel<false>
#endif
        hipFuncSetAttribute((const void*)FWD_K, hipFuncAttributeMaxDynamicSharedMemorySize, LDS_BYTES);
        hipOccupancyMaxActiveBlocksPerMultiprocessor(&per_cu, (const void*)FWD_K, 512, LDS_BYTES);
        (void)hipGetLastError();
        if (per_cu < 1) { fprintf(stderr, "kernel_launch: occupancy query says %d blocks/CU\n", per_cu); per_cu = 1; }
        grid = cus;
    }
    if (grid < 0) return;
#if N_LAUNCH_MODE != 0
    hipMemsetAsync((char*)d_ws + WS_CTL, 0, CTL_BYTES, stream);
#endif
    Params p{};
    p.x = (const float*)d_in[0]; p.norm_w = (const float*)d_in[1]; p.w_in = (const float*)d_in[2]; p.w_out = (const float*)d_in[3]; p.conv_w = (const float*)d_in[4];
    p.pe_cmp = (const float*)d_in[5]; p.w_cmp_k = (const float*)d_in[6]; p.w_cmp_v = (const float*)d_in[7]; p.pool_w = (const float*)d_in[8]; p.pool_scale = (const float*)d_in[9];
    p.final_norm_w = (const float*)d_in[10]; p.out = (float*)d_out; p.ws = (unsigned char*)d_ws;
#if N_LAUNCH_MODE == 0
    p.ph_lo = 0; p.ph_hi = NPHASE;
    void* args[] = {&p};
    hipError_t e = hipLaunchCooperativeKernel((const void*)fwd_kernel<true>, dim3(grid), dim3(512), args, LDS_BYTES, stream);
    if (e != hipSuccess) fprintf(stderr, "cooperative launch failed: %s (grid %d)\n", hipGetErrorString(e), grid);
#else
    for (int ph = 0; ph < NPHASE; ++ph) {
#ifdef ABL_DUMP
        if (ph >= 2 && ph < NPHASE - 1) continue;
#endif
        p.ph_lo = ph; p.ph_hi = ph + 1;
        hipLaunchKernelGGL(fwd_kernel<false>, dim3(grid), dim3(512), LDS_BYTES, stream, p);
    }
#endif
}
```
